# Optimizing an MI355X kernel written in HIP

```python
import math
import jax
import jax.numpy as jnp
from jax import lax
import numpy as np

D_MODEL = 1024
BATCH = 4
SEQ = 8192
DEPTH = 1

MEM_LEN = 256
EPS = 1e-6
NEG_INF = -1e30
BIG = 1e30

GLA_HEADS = 4
GLA_DK = 64
GLA_DV = 128
GLA_RANK = 16
GLA_TAU = 16.0
GLA_CHUNK = 64

NSA_HEADS = 8
NSA_KV_GROUPS = 2
NSA_HPG = NSA_HEADS // NSA_KV_GROUPS
NSA_DH = 64
CMP_BLOCK = 32
CMP_STRIDE = 16
CMP_HIDDEN = 128
SLC_BLOCK = 64
SLC_TOPK = 16
WINDOW = 512
Q_BLOCK = 128

REL_BUCKETS = 32
REL_MAX_DIST = 2048

XA_HEADS = 4
XA_DH = D_MODEL // XA_HEADS

PEER_HEADS = 8
PEER_NKEYS = 128
PEER_EXPERTS = PEER_NKEYS * PEER_NKEYS
PEER_TOPK = 16
PEER_DKEY = 128
PEER_TOKEN_CHUNK = 128

IN_SIZES = (GLA_HEADS * GLA_DK, GLA_HEADS * GLA_DK, GLA_HEADS * GLA_DV, GLA_HEADS * GLA_DV, GLA_RANK,
            NSA_HEADS * NSA_DH,
            NSA_KV_GROUPS * NSA_DH, NSA_KV_GROUPS * NSA_DH,
            NSA_KV_GROUPS * NSA_DH, NSA_KV_GROUPS * NSA_DH,
            NSA_KV_GROUPS * NSA_DH, NSA_KV_GROUPS * NSA_DH,
            NSA_HEADS * 3)
IN_COLS = sum(IN_SIZES)

kernel_name = 'hybrid_gla_nsa_peer_block'


def rms_norm(x, g):
    xf = x.astype(jnp.float32)
    y = xf * lax.rsqrt(jnp.mean(xf * xf, axis=-1, keepdims=True) + EPS)
    return (y * g.astype(jnp.float32)).astype(x.dtype)


def _masked_softmax(s, mask):
    s = jnp.where(mask, s.astype(jnp.float32), NEG_INF)
    p = jax.nn.softmax(s, axis=-1)
    return p * jnp.any(mask, axis=-1, keepdims=True)


def _t5_bucket(dist):
    n = jnp.maximum(dist, 0)
    max_exact = REL_BUCKETS // 2
    nf = jnp.maximum(n, 1).astype(jnp.float32)
    log_ratio = jnp.log(nf / max_exact) / math.log(REL_MAX_DIST / max_exact)
    large = max_exact + (log_ratio * (REL_BUCKETS - max_exact)).astype(jnp.int32)
    large = jnp.minimum(large, REL_BUCKETS - 1)
    return jnp.where(n < max_exact, n, large)


def _head_bias(dist, rel_bias):
    b = jnp.moveaxis(rel_bias[_t5_bucket(dist)], -1, 0)
    return b.reshape((NSA_KV_GROUPS, NSA_HPG) + dist.shape).astype(jnp.float32)


def _split_cols(z):
    offs = np.cumsum(np.array(IN_SIZES))[:-1].tolist()
    return jnp.split(z, offs, axis=-1)


def _gla_chunked(q, k, v, log_a):
    B, T, H, dk = q.shape
    dv = v.shape[-1]
    C = GLA_CHUNK
    nc = T // C

    def to_chunks(a):
        return a.astype(jnp.float32).reshape(B, nc, C, H, a.shape[-1]).transpose(1, 0, 3, 2, 4)

    qc, kc, vc, ac = to_chunks(q), to_chunks(k), to_chunks(v), to_chunks(log_a)
    causal = jnp.tril(jnp.ones((C, C), dtype=bool))[..., None]

    def step(S, inp):
        qi, ki, vi, ai = inp
        b = jnp.cumsum(ai, axis=-2)
        diff = b[..., :, None, :] - b[..., None, :, :]
        decay = jnp.exp(jnp.where(causal, diff, NEG_INF))
        A = jnp.einsum('bhtd,bhsd,bhtsd->bhts', qi, ki, decay)
        o = jnp.einsum('bhts,bhsv->bhtv', A, vi) + jnp.einsum('bhtd,bhdv->bhtv', qi * jnp.exp(b), S)
        b_last = b[..., -1:, :]
        S_new = jnp.exp(b_last[..., 0, :])[..., None] * S + jnp.einsum(
            'bhsd,bhsv->bhdv', ki * jnp.exp(b_last - b), vi)
        return S_new, o

    S0 = jnp.zeros((B, H, dk, dv), jnp.float32)
    _, o = lax.scan(step, S0, (qc, kc, vc, ac))
    return o.transpose(1, 0, 3, 2, 4).reshape(B, T, H, dv)


def gla_mixer(gq, gk, gv, gr, glr, gate_w2, gate_b, out_norm):
    B, T, _ = gq.shape
    q = gq.reshape(B, T, GLA_HEADS, GLA_DK) * (GLA_DK ** -0.5)
    k = gk.reshape(B, T, GLA_HEADS, GLA_DK)
    v = gv.reshape(B, T, GLA_HEADS, GLA_DV)
    log_a = jax.nn.log_sigmoid((glr @ gate_w2 + gate_b).astype(jnp.float32)) / GLA_TAU
    log_a = log_a.reshape(B, T, GLA_HEADS, GLA_DK)
    o = _gla_chunked(q, k, v, log_a)
    o = rms_norm(o, out_norm).reshape(B, T, GLA_HEADS * GLA_DV)
    return (o * jax.nn.silu(gr.astype(jnp.float32))).astype(gq.dtype)


def _compress(kv, pos, w1, w2):
    B, T, G, dh = kv.shape
    n_cmp = (T - CMP_BLOCK) // CMP_STRIDE + 1
    idx = jnp.arange(n_cmp)[:, None] * CMP_STRIDE + jnp.arange(CMP_BLOCK)[None, :]
    blocks = kv[:, idx] + pos[None, None, :, None, :]
    blocks = blocks.transpose(0, 3, 1, 2, 4).reshape(B, G, n_cmp, CMP_BLOCK * dh)
    return jax.nn.gelu(blocks @ w1) @ w2


def _slc_importance(p_grp, n_slc):
    n_cmp = p_grp.shape[-1]
    ratio = SLC_BLOCK // CMP_STRIDE
    back = CMP_BLOCK // CMP_STRIDE - 1
    pad_end = max(ratio * n_slc - n_cmp, 0)
    pp = jnp.pad(p_grp, [(0, 0)] * (p_grp.ndim - 1) + [(back, pad_end)])
    base = jnp.arange(n_slc) * ratio + back
    imp = 0.0
    for r in range(-back, ratio):
        lo = CMP_STRIDE * r
        overlap = min(lo + CMP_BLOCK, SLC_BLOCK) - max(lo, 0)
        imp = imp + (overlap / CMP_BLOCK) * pp[..., base + r]
    return imp


def nsa_mixer(nq, kc, vc, ks, vs, kw, vw, ng, rel_bias, pos_k, pos_v, ck_w1, ck_w2, cv_w1, cv_w2):
    B, T, _ = nq.shape
    G, HPG, dh = NSA_KV_GROUPS, NSA_HPG, NSA_DH
    n_cmp = (T - CMP_BLOCK) // CMP_STRIDE + 1
    n_slc = T // SLC_BLOCK
    n_sel = min(SLC_TOPK, n_slc)
    n_qblk = T // Q_BLOCK
    kv_shape = (B, T, G, dh)

    q = (nq.reshape(B, T, G, HPG, dh) * (dh ** -0.5)).transpose(0, 2, 3, 1, 4)
    gates = jax.nn.sigmoid(ng.astype(jnp.float32)).reshape(B, T, G, HPG, 3).transpose(0, 2, 3, 1, 4)

    k_cmp = _compress(kc.reshape(kv_shape), pos_k, ck_w1, ck_w2)
    v_cmp = _compress(vc.reshape(kv_shape), pos_v, cv_w1, cv_w2)
    k_slc = ks.reshape(kv_shape).transpose(0, 2, 1, 3).reshape(B, G, n_slc, SLC_BLOCK, dh)
    v_slc = vs.reshape(kv_shape).transpose(0, 2, 1, 3).reshape(B, G, n_slc, SLC_BLOCK, dh)
    pad = ((0, 0), (0, 0), (WINDOW, 0), (0, 0))
    k_win = jnp.pad(kw.reshape(kv_shape).transpose(0, 2, 1, 3), pad)
    v_win = jnp.pad(vw.reshape(kv_shape).transpose(0, 2, 1, 3), pad)

    qi = jnp.arange(Q_BLOCK)
    kj = jnp.arange(WINDOW + Q_BLOCK)
    dist_w = qi[:, None] + WINDOW - kj[None, :]
    band = (dist_w >= 0) & (dist_w < WINDOW)
    bias_w = _head_bias(dist_w, rel_bias)
    cmp_end = jnp.arange(n_cmp) * CMP_STRIDE + (CMP_BLOCK - 1)
    slc_ids = jnp.arange(n_slc)
    bidx = jnp.arange(B)[:, None, None, None]
    gidx = jnp.arange(G)[None, :, None, None]
    table_g = rel_bias.reshape(REL_BUCKETS, G, HPG).transpose(1, 0, 2)

    def block(i):
        s0 = i * Q_BLOCK
        t = s0 + qi
        qb = lax.dynamic_slice_in_dim(q, s0, Q_BLOCK, axis=3)
        gb = lax.dynamic_slice_in_dim(gates, s0, Q_BLOCK, axis=3)

        dist_c = t[:, None] - cmp_end[None, :]
        s_c = jnp.einsum('bghqd,bgnd->bghqn', qb, k_cmp) + _head_bias(dist_c, rel_bias)
        p_c = _masked_softmax(s_c, dist_c >= 0)
        o_c = jnp.einsum('bghqn,bgnd->bghqd', p_c.astype(v_cmp.dtype), v_cmp)

        imp = _slc_importance(p_c.sum(axis=2), n_slc)
        cur = (t // SLC_BLOCK)[:, None]
        forced = (slc_ids == 0) | (slc_ids == cur) | (slc_ids == cur - 1)
        visible = (slc_ids * SLC_BLOCK)[None, :] <= t[:, None]
        imp = jnp.where(forced, BIG, jnp.where(visible, imp, NEG_INF))
        _, sel = lax.top_k(imp, n_sel)
        k_sel = k_slc[bidx, gidx, sel].reshape(B, G, Q_BLOCK, n_sel * SLC_BLOCK, dh)
        v_sel = v_slc[bidx, gidx, sel].reshape(B, G, Q_BLOCK, n_sel * SLC_BLOCK, dh)
        kpos = (sel[..., None] * SLC_BLOCK + jnp.arange(SLC_BLOCK)).reshape(B, G, Q_BLOCK, -1)
        dist_s = t[:, None] - kpos
        bias_s = jnp.moveaxis(table_g[gidx, _t5_bucket(dist_s)], -1, 2).astype(jnp.float32)
        s_s = jnp.einsum('bghqd,bgqkd->bghqk', qb, k_sel) + bias_s
        p_s = _masked_softmax(s_s, (dist_s >= 0)[:, :, None])
        o_s = jnp.einsum('bghqk,bgqkd->bghqd', p_s.astype(v_sel.dtype), v_sel)

        k_w = lax.dynamic_slice_in_dim(k_win, s0, WINDOW + Q_BLOCK, axis=2)
        v_w = lax.dynamic_slice_in_dim(v_win, s0, WINDOW + Q_BLOCK, axis=2)
        valid_w = band & ((s0 - WINDOW + kj) >= 0)[None, :]
        s_w = jnp.einsum('bghqd,bgkd->bghqk', qb, k_w) + bias_w
        p_w = _masked_softmax(s_w, valid_w)
        o_w = jnp.einsum('bghqk,bgkd->bghqd', p_w.astype(v_w.dtype), v_w)

        o = gb[..., 0:1] * o_c + gb[..., 1:2] * o_s + gb[..., 2:3] * o_w
        return o.astype(nq.dtype)

    o = lax.map(block, jnp.arange(n_qblk))
    return o.transpose(1, 0, 4, 2, 3, 5).reshape(B, T, NSA_HEADS * dh)


def cross_attn(hn, memn, wq, wk, wv, wo):
    B, T, _ = hn.shape
    M = memn.shape[1]
    q = (hn @ wq).reshape(B, T, XA_HEADS, XA_DH) * (XA_DH ** -0.5)
    k = (memn @ wk).reshape(B, M, XA_HEADS, XA_DH)
    v = (memn @ wv).reshape(B, M, XA_HEADS, XA_DH)
    s = jnp.einsum('bqhd,bmhd->bhqm', q, k).astype(jnp.float32)
    p = jax.nn.softmax(s, axis=-1).astype(v.dtype)
    o = jnp.einsum('bhqm,bmhd->bqhd', p, v).reshape(B, T, XA_HEADS * XA_DH)
    return o @ wo


def peer_ffn(hn, wq, subkeys, down, up):
    B, T, D = hn.shape
    N = B * T
    H, K = PEER_HEADS, PEER_TOPK
    xt = hn.reshape(N, D)
    q = (xt @ wq).reshape(N, H, 2, PEER_DKEY // 2)
    s = jnp.einsum('nhpd,hpkd->nhpk', q, subkeys).astype(jnp.float32)
    s_half, i_half = lax.top_k(s, K)
    cand_s = (s_half[:, :, 0, :, None] + s_half[:, :, 1, None, :]).reshape(N, H, K * K)
    cand_i = (i_half[:, :, 0, :, None] * PEER_NKEYS + i_half[:, :, 1, None, :]).reshape(N, H, K * K)
    top_s, pos = lax.top_k(cand_s, K)
    eidx = jnp.take_along_axis(cand_i, pos, axis=-1)
    gate = jax.nn.softmax(top_s, axis=-1)
    n_chunks = N // PEER_TOKEN_CHUNK

    def chunk(args):
        xc, ec, gc = args
        u = down[ec]
        act = jax.nn.gelu(jnp.einsum('cd,chkd->chk', xc, u).astype(jnp.float32)) * gc
        return jnp.einsum('chk,chkd->cd', act.astype(up.dtype), up[ec])

    y = lax.map(chunk, (xt.reshape(n_chunks, PEER_TOKEN_CHUNK, D),
                        eidx.reshape(n_chunks, PEER_TOKEN_CHUNK, H, K),
                        gate.reshape(n_chunks, PEER_TOKEN_CHUNK, H, K)))
    return y.reshape(B, T, D).astype(hn.dtype)


def setup_inputs(seed: int = 0) -> dict:
    key = jax.random.key(seed)
    ks = jax.random.split(key, 32)
    f32 = jnp.float32
    L, D = DEPTH, D_MODEL

    def nrm(k, shape, scale):
        return jax.random.normal(k, shape, f32) * scale

    def gain(k, shape):
        return 1.0 + 0.02 * jax.random.normal(k, shape, f32)

    return {
        'x': nrm(ks[0], (BATCH, SEQ, D), 1.0),
        'mem': nrm(ks[1], (BATCH, MEM_LEN, D), 1.0),
        'rel_bias': nrm(ks[2], (REL_BUCKETS, NSA_HEADS), 0.5),
        'norm_mix': gain(ks[3], (L, D)),
        'w_in': nrm(ks[4], (L, D, IN_COLS), D ** -0.5),
        'gla_gate_w2': nrm(ks[5], (L, GLA_RANK, GLA_HEADS * GLA_DK), GLA_RANK ** -0.5),
        'gla_gate_b': nrm(ks[6], (L, GLA_HEADS * GLA_DK), 0.1),
        'gla_out_norm': gain(ks[7], (L, GLA_DV)),
        'cmp_pos_k': nrm(ks[8], (L, CMP_BLOCK, NSA_DH), 0.1),
        'cmp_pos_v': nrm(ks[9], (L, CMP_BLOCK, NSA_DH), 0.1),
        'cmp_k_w1': nrm(ks[10], (L, CMP_BLOCK * NSA_DH, CMP_HIDDEN), (CMP_BLOCK * NSA_DH) ** -0.5),
        'cmp_k_w2': nrm(ks[11], (L, CMP_HIDDEN, NSA_DH), CMP_HIDDEN ** -0.5),
        'cmp_v_w1': nrm(ks[12], (L, CMP_BLOCK * NSA_DH, CMP_HIDDEN), (CMP_BLOCK * NSA_DH) ** -0.5),
        'cmp_v_w2': nrm(ks[13], (L, CMP_HIDDEN, NSA_DH), CMP_HIDDEN ** -0.5),
        'w_out': nrm(ks[14], (L, D, D), D ** -0.5),
        'norm_xattn': gain(ks[15], (L, D)),
        'norm_mem': gain(ks[16], (L, D)),
        'xa_wq': nrm(ks[17], (L, D, D), D ** -0.5),
        'xa_wk': nrm(ks[18], (L, D, D), D ** -0.5),
        'xa_wv': nrm(ks[19], (L, D, D), D ** -0.5),
        'xa_wo': nrm(ks[20], (L, D, D), D ** -0.5),
        'norm_ffn': gain(ks[21], (L, D)),
        'peer_wq': nrm(ks[22], (L, D, PEER_HEADS * PEER_DKEY), D ** -0.5),
        'peer_subkeys': nrm(ks[23], (L, PEER_HEADS, 2, PEER_NKEYS, PEER_DKEY // 2), (PEER_DKEY // 2) ** -0.5),
        'peer_down': nrm(ks[24], (L, PEER_EXPERTS, D), D ** -0.5),
        'peer_up': nrm(ks[25], (L, PEER_EXPERTS, D), PEER_HEADS ** -0.5),
        'norm_final': gain(ks[26], (D,)),
    }


def reference(x, mem, rel_bias, norm_mix, w_in, gla_gate_w2, gla_gate_b, gla_out_norm,
              cmp_pos_k, cmp_pos_v, cmp_k_w1, cmp_k_w2, cmp_v_w1, cmp_v_w2, w_out,
              norm_xattn, norm_mem, xa_wq, xa_wk, xa_wv, xa_wo,
              norm_ffn, peer_wq, peer_subkeys, peer_down, peer_up, norm_final):
    h = x
    for l in range(DEPTH):
        hn = rms_norm(h, norm_mix[l])
        (gq, gk, gv, gr, glr, nq, kc, vc, ks_, vs_, kw, vw, ng) = _split_cols(hn @ w_in[l])
        o_gla = gla_mixer(gq, gk, gv, gr, glr, gla_gate_w2[l], gla_gate_b[l], gla_out_norm[l])
        o_nsa = nsa_mixer(nq, kc, vc, ks_, vs_, kw, vw, ng, rel_bias,
                          cmp_pos_k[l], cmp_pos_v[l], cmp_k_w1[l], cmp_k_w2[l], cmp_v_w1[l], cmp_v_w2[l])
        h = h + jnp.concatenate([o_gla, o_nsa], axis=-1) @ w_out[l]
        h = h + cross_attn(rms_norm(h, norm_xattn[l]), rms_norm(mem, norm_mem[l]),
                           xa_wq[l], xa_wk[l], xa_wv[l], xa_wo[l])
        h = h + peer_ffn(rms_norm(h, norm_ffn[l]), peer_wq[l], peer_subkeys[l], peer_down[l], peer_up[l])
    return rms_norm(h, norm_final)
```

```cpp
#include <hip/hip_runtime.h>
#include <hip/hip_cooperative_groups.h>
#include <cstdio>
#include <cstdint>
namespace cg = cooperative_groups;

#ifndef EN_NSA
#define EN_NSA 1
#endif
#ifndef EN_SLC
#define EN_SLC 1.f
#endif
#ifndef EN_WIN
#define EN_WIN 1.f
#endif
#ifndef EN_XATTN
#define EN_XATTN 1
#endif
#ifndef EN_PEER
#define EN_PEER 1
#endif

#define LAS __attribute__((address_space(3)))
#define DI __device__ __forceinline__
typedef unsigned short bf16_t;
typedef short bf16x8 __attribute__((ext_vector_type(8)));
typedef short s16x4 __attribute__((ext_vector_type(4)));
typedef float f32x2 __attribute__((ext_vector_type(2)));
typedef float f32x4 __attribute__((ext_vector_type(4)));
typedef float f32x16 __attribute__((ext_vector_type(16)));
typedef unsigned u32x2 __attribute__((ext_vector_type(2)));
typedef unsigned u32x4 __attribute__((ext_vector_type(4)));
typedef __bf16 bf16x2_t __attribute__((ext_vector_type(2)));
typedef short v4i16_t __attribute__((ext_vector_type(4)));

constexpr int NB = 4, T = 8192, NTOK = NB * T, DM = 1024;
constexpr int ZP = 3072;
constexpr int C_GQ = 0, C_GK = 256, C_GV = 512, C_GR = 1024, C_GLR = 1536, C_NQ = 1552, C_KC = 2064, C_VC = 2192,
              C_KS = 2320, C_VS = 2448, C_KW = 2576, C_VW = 2704, C_NG = 2832, IN_COLS = 2856;
constexpr float EPS = 1e-6f;
constexpr int NTHREADS = 512, NWAVES = 8;
constexpr int LDS_BYTES = 147456;
constexpr int LDSCTL_OFF = 139264;

constexpr size_t MiB = 1u << 20;
constexpr size_t WS_CTL = 0;
constexpr size_t WS_XL = 256 * 1024;
constexpr size_t WS_BUCK = 1 * MiB;
constexpr size_t WS_C1 = 1 * MiB + 16 * 1024;
constexpr size_t WS_W2T = 1 * MiB + 32 * 1024;
constexpr size_t WS_SK = 1 * MiB + 128 * 1024;
constexpr size_t WS_DL = 1 * MiB + 512 * 1024;
constexpr size_t WS_KCMP = 2 * MiB;
constexpr size_t WS_VCMP = 2 * MiB + 512 * 1024;
constexpr size_t WS_W1T = 3 * MiB;
constexpr size_t WS_WIN = 4 * MiB;
constexpr size_t WS_WOUT = 10 * MiB, WS_XWQ = 12 * MiB, WS_XWK = 14 * MiB, WS_XWV = 16 * MiB, WS_XWO = 18 * MiB, WS_PWQ = 20 * MiB;
constexpr size_t WS_MEMN = 22 * MiB, WS_KX = 24 * MiB, WS_VXT = 26 * MiB;
constexpr size_t WS_PDOWN8 = 32 * MiB, WS_PUP8 = 48 * MiB;
constexpr size_t WS_DSC = 1 * MiB + 64 * 1024, WS_USC = 1 * MiB + 384 * 1024;
constexpr size_t WS_SSP = 28 * MiB;
constexpr size_t WS_PART = 256 * MiB;
constexpr size_t WS_HN = 96 * MiB;
constexpr size_t WS_GU = 96 * MiB;
constexpr size_t WS_Z = 160 * MiB;
constexpr size_t WS_QX = 160 * MiB, WS_XP = 224 * MiB, WS_OX = 288 * MiB;
constexpr size_t WS_QP = 160 * MiB, WS_EIDX = 224 * MiB, WS_ACTH = 232 * MiB, WS_GATE = 240 * MiB;
constexpr size_t WS_OCAT = 352 * MiB;
constexpr size_t WS_GS = 416 * MiB;
constexpr size_t WS_MT = 448 * MiB;
constexpr size_t WS_VWT = 456 * MiB;
constexpr size_t WS_GQ = 464 * MiB, WS_GK = 480 * MiB;
constexpr size_t WS_END = 496 * MiB;

DI unsigned f2bf(float f) { unsigned u = __builtin_bit_cast(unsigned, f); return (u + 0x7fffu + ((u >> 16) & 1u)) >> 16; }
DI float bf2f(unsigned short b) { return __builtin_bit_cast(float, (unsigned)b << 16); }
DI float bflo(unsigned w) { return __builtin_bit_cast(float, w << 16); }
DI float bfhi(unsigned w) { return __builtin_bit_cast(float, w & 0xffff0000u); }
DI unsigned cvtpk(float lo, float hi) { f32x2 v = {lo, hi}; bf16x2_t b = __builtin_convertvector(v, bf16x2_t); return __builtin_bit_cast(unsigned, b); }
DI float wave_sum(float v) {
#pragma unroll
  for (int o = 1; o < 64; o <<= 1) v += __shfl_xor(v, o);
  return v;
}
DI int crow(int r, int hi) { return (r & 3) + 8 * (r >> 2) + 4 * hi; }
DI s16x4 vtr(const LAS unsigned char* p) { return __builtin_bit_cast(s16x4, __builtin_amdgcn_ds_read_tr16_b64_v4i16((LAS v4i16_t*)p)); }
DI bf16x8 cat8(s16x4 a, s16x4 b) { return __builtin_shufflevector(a, b, 0, 1, 2, 3, 4, 5, 6, 7); }
#define MFMA32(a, b, c) __builtin_amdgcn_mfma_f32_32x32x16_bf16((a), (b), (c), 0, 0, 0)
DI bf16x8 pack8(const f32x16& x, int s) {
  u32x4 p; p[0] = cvtpk(x[8 * s], x[8 * s + 1]); p[1] = cvtpk(x[8 * s + 2], x[8 * s + 3]); p[2] = cvtpk(x[8 * s + 4], x[8 * s + 5]); p[3] = cvtpk(x[8 * s + 6], x[8 * s + 7]);
  return __builtin_bit_cast(bf16x8, p);
}
DI float gelu_tanh(float x) {
  const float y = 0.7978845608028654f * (x + 0.044715f * x * x * x);
  const float e = __expf(2.f * y);
  const float th = 1.f - 2.f / (1.f + e);
  return 0.5f * x * (1.f + th);
}
DI float sigmoidf_(float x) { return 1.f / (1.f + __expf(-x)); }

DI void sort16_desc(int (&x)[16]) {
#define CE_(a, b) { const int h_ = max(x[a], x[b]); const int l_ = min(x[a], x[b]); x[a] = h_; x[b] = l_; }
  CE_(0,1); CE_(2,3); CE_(0,2); CE_(1,3); CE_(1,2); CE_(4,5); CE_(6,7); CE_(4,6); CE_(5,7); CE_(5,6); CE_(0,4); CE_(2,6); CE_(2,4); CE_(1,5); CE_(3,7); CE_(3,5); CE_(1,2); CE_(3,4); CE_(5,6); CE_(8,9); CE_(10,11); CE_(8,10); CE_(9,11); CE_(9,10); CE_(12,13); CE_(14,15); CE_(12,14); CE_(13,15); CE_(13,14); CE_(8,12); CE_(10,14); CE_(10,12); CE_(9,13); CE_(11,15); CE_(11,13); CE_(9,10); CE_(11,12); CE_(13,14); CE_(0,8); CE_(4,12); CE_(4,8); CE_(2,10); CE_(6,14); CE_(6,10); CE_(2,4); CE_(6,8); CE_(10,12); CE_(1,9); CE_(5,13); CE_(5,9); CE_(3,11); CE_(7,15); CE_(7,11); CE_(3,5); CE_(7,9); CE_(11,13); CE_(1,2); CE_(3,4); CE_(5,6); CE_(7,8); CE_(9,10); CE_(11,12); CE_(13,14);
#undef CE_
}
DI void merge16_top(int (&a)[16], const int (&b)[16]) {
  int c[16];
#pragma unroll
  for (int i = 0; i < 16; ++i) c[i] = max(a[i], b[15 - i]);
#pragma unroll
  for (int st = 8; st >= 1; st >>= 1)
#pragma unroll
    for (int i = 0; i < 16; ++i) if ((i & st) == 0) { const int x = c[i], y = c[i + st]; c[i] = max(x, y); c[i + st] = min(x, y); }
#pragma unroll
  for (int i = 0; i < 16; ++i) a[i] = c[i];
}

struct Params {
  const float* in[27];
  float* out;
  unsigned char* ws;
  int pad0, pad1;
};
enum { I_X = 0, I_MEM, I_RELB, I_NMIX, I_WIN, I_GW2, I_GB, I_GON, I_POSK, I_POSV, I_CKW1, I_CKW2, I_CVW1, I_CVW2, I_WOUT, I_NXA, I_NMEM,
       I_XWQ, I_XWK, I_XWV, I_XWO, I_NFFN, I_PWQ, I_PSK, I_PDOWN, I_PUP, I_NFIN };

namespace pg8 {
constexpr int BM = 256, BK = 64, HALF = 128, HTB = HALF * BK * 2, STAGE_BYTES = 8 * HTB;
DI int lds_byte(int r, int c) { const int st = (r >> 4) * 2 + (c >> 5), rr = r & 15, cc = c & 31, ob = rr * 64 + cc * 2; return st * 1024 + (ob ^ (((ob >> 9) & 1) << 5)); }
DI void stage_rc(int b, int& R, int& C) { const int st = b / 1024, sb = b % 1024, swz = sb ^ (((sb >> 9) & 1) << 5); R = (st >> 1) * 16 + swz / 64; C = (st & 1) * 32 + (swz % 64) / 2; }
DI int perm32(int rho) { const int n = rho >> 4, i = rho & 15; return 8 * (i >> 2) + 4 * n + (i & 3); }
struct Unit { const char* a; const char* b; int pm, pn; };
DI const char* uni_ptr(const char* p) { const unsigned long long v = (unsigned long long)p; const unsigned lo = __builtin_amdgcn_readfirstlane((unsigned)v), hi = __builtin_amdgcn_readfirstlane((unsigned)(v >> 32)); return (const char*)(((unsigned long long)hi << 32) | lo); }

template <class Epi, class Sched>
DI void gemm_phase(LAS unsigned char* lds, const int K, const int lda, const int ldb, const Sched& S, const Epi& E) {
  constexpr bool ALIGN_EPI = true;
  int tid_ = threadIdx.x; asm volatile("" : "+v"(tid_));
  const int tid = tid_, wid = __builtin_amdgcn_readfirstlane(tid >> 6), lane = tid & 63, wr = wid >> 2, wc = wid & 3, fr = lane & 15, fq = lane >> 4;
  const int nt = K / BK;
  unsigned voffA[2], voffB[2];
#pragma unroll
  for (int i = 0; i < 2; ++i) { int R, C; stage_rc(tid * 16 + i * 8192, R, C); const int Rb = Epi::PERM ? ((R & ~31) + perm32(R & 31)) : R;
    voffA[i] = (unsigned)(R * lda + C) * 2u; voffB[i] = (unsigned)(Rb * ldb + C) * 2u; }
  const size_t kstep = (size_t)(BK * 2);
  const size_t hstepA = (size_t)HALF * lda * 2, hstepB = (size_t)HALF * ldb * 2;
  const unsigned ldsw = (unsigned)wid * 1024u;
  const int aoff = lds_byte(wr * 64 + fr, fq * 8), boff = lds_byte(wc * 32 + fr, fq * 8);
#define PG8_SA(b, h) (((b) * 2 + (h)) * HTB)
#define PG8_SB(b, h) ((4 + (b) * 2 + (h)) * HTB)
#define PG8_STAGE(bufoff, gbase, voff) do { _Pragma("unroll") for (int _i = 0; _i < 2; ++_i) \
        __builtin_amdgcn_global_load_lds((const unsigned*)((const char*)(gbase) + (voff)[_i]), (LAS unsigned*)(lds + (bufoff) + ldsw + _i * 8192), 16, 0, 0); } while (0)
#define PG8_LDA(dst, b, h) do { _Pragma("unroll") for (int m = 0; m < 4; ++m) _Pragma("unroll") for (int k = 0; k < 2; ++k) dst[m][k] = *(const LAS bf16x8*)(lds + PG8_SA(b, h) + aoff + m * 2048 + k * 1024); } while (0)
#define PG8_LDB(dst, b, h) do { _Pragma("unroll") for (int n = 0; n < 2; ++n) _Pragma("unroll") for (int k = 0; k < 2; ++k) dst[n][k] = *(const LAS bf16x8*)(lds + PG8_SB(b, h) + boff + n * 2048 + k * 1024); } while (0)
#define PG8_MMA(ai, bj, At, Bt) do { __builtin_amdgcn_s_setprio(1); _Pragma("unroll") for (int m = 0; m < 4; ++m) _Pragma("unroll") for (int n = 0; n < 2; ++n) _Pragma("unroll") for (int k = 0; k < 2; ++k) \
        acc[ai][bj][m][n] = __builtin_amdgcn_mfma_f32_16x16x32_bf16(Bt[n][k], At[m][k], acc[ai][bj][m][n], 0, 0, 0); __builtin_amdgcn_s_setprio(0); } while (0)
#define PG8_WAIT_V(n) asm volatile("s_waitcnt vmcnt(" #n ")" ::: "memory")
#define PG8_WAIT_L(n) asm volatile("s_waitcnt lgkmcnt(" #n ")" ::: "memory")
#define PG8_BAR __builtin_amdgcn_s_barrier()
#define PG8_SCHED __builtin_amdgcn_sched_barrier(0)
  __syncthreads();
  Unit cur, nxt; int ui = 0;
  if (!S.next(0, cur)) return;
  f32x4 acc[2][2][4][2];
#pragma unroll
  for (int a = 0; a < 2; ++a)
#pragma unroll
    for (int b = 0; b < 2; ++b)
#pragma unroll
      for (int m = 0; m < 4; ++m)
#pragma unroll
        for (int n = 0; n < 2; ++n) acc[a][b][m][n] = (f32x4){0.f, 0.f, 0.f, 0.f};
  bf16x8 At[4][2], B0[2][2], B1[2][2];
  const char* cA = uni_ptr(cur.a); const char* cB = uni_ptr(cur.b);
  PG8_STAGE(PG8_SB(0, 0), cB, voffB); PG8_STAGE(PG8_SB(0, 1), cB + hstepB, voffB); PG8_STAGE(PG8_SA(0, 0), cA, voffA); PG8_STAGE(PG8_SA(0, 1), cA + hstepA, voffA);
  if (wr == 1) PG8_BAR;
  PG8_WAIT_V(2); PG8_BAR;
  PG8_STAGE(PG8_SB(1, 0), cB + kstep, voffB); PG8_STAGE(PG8_SA(1, 0), cA + kstep, voffA); PG8_STAGE(PG8_SB(1, 1), cB + hstepB + kstep, voffB);
  PG8_WAIT_V(6); PG8_BAR;
  for (;;) {
    const bool has_next = S.next(ui + 1, nxt);
    const char* nA = has_next ? uni_ptr(nxt.a) : cA; const char* nB = has_next ? uni_ptr(nxt.b) : cB;
#pragma unroll 1
    for (int t = 0; t < nt; t += 2) {
      const bool last = (t == nt - 2);
      const char* a1 = cA + (size_t)(t + 1) * kstep;
      const char* a2 = last ? nA : cA + (size_t)(t + 2) * kstep; const char* b2 = last ? nB : cB + (size_t)(t + 2) * kstep;
      const char* a3 = a2 + kstep; const char* b3 = b2 + kstep;
      PG8_LDB(B0, 0, 0); PG8_LDB(B1, 0, 1); PG8_SCHED; PG8_LDA(At, 0, 0); PG8_STAGE(PG8_SA(1, 1), a1 + hstepA, voffA);
      PG8_WAIT_V(8); PG8_WAIT_L(0); PG8_BAR; PG8_MMA(0, 0, At, B0); PG8_MMA(0, 1, At, B1); PG8_BAR; PG8_SCHED;
      PG8_LDA(At, 0, 1); PG8_STAGE(PG8_SB(0, 0), b2, voffB); PG8_STAGE(PG8_SB(0, 1), b2 + hstepB, voffB); PG8_STAGE(PG8_SA(0, 0), a2, voffA);
      PG8_WAIT_V(8); PG8_WAIT_L(0); PG8_BAR; PG8_MMA(1, 0, At, B0); PG8_MMA(1, 1, At, B1); PG8_BAR; PG8_SCHED;
      PG8_LDB(B0, 1, 0); PG8_LDB(B1, 1, 1); PG8_SCHED; PG8_LDA(At, 1, 0); PG8_STAGE(PG8_SA(0, 1), a2 + hstepA, voffA);
      PG8_WAIT_V(8); PG8_WAIT_L(0); PG8_BAR; PG8_MMA(0, 0, At, B0); PG8_MMA(0, 1, At, B1); PG8_BAR; PG8_SCHED;
      PG8_LDA(At, 1, 1); PG8_STAGE(PG8_SB(1, 0), b3, voffB); PG8_STAGE(PG8_SB(1, 1), b3 + hstepB, voffB); PG8_STAGE(PG8_SA(1, 0), a3, voffA);
      PG8_WAIT_V(8); PG8_WAIT_L(0); PG8_BAR; PG8_MMA(1, 0, At, B0); PG8_MMA(1, 1, At, B1); PG8_BAR; PG8_SCHED;
    }
    if constexpr (ALIGN_EPI) { if (wr == 0) PG8_BAR; }
    E(acc, cur, wr, wc, fr, fq);
    if (!has_next) break;
#pragma unroll
    for (int a = 0; a < 2; ++a)
#pragma unroll
      for (int b = 0; b < 2; ++b)
#pragma unroll
        for (int m = 0; m < 4; ++m)
#pragma unroll
          for (int n = 0; n < 2; ++n) acc[a][b][m][n] = (f32x4){0.f, 0.f, 0.f, 0.f};
    cur = nxt; cA = nA; cB = nB; ++ui;
    if constexpr (ALIGN_EPI) { if (wr == 1) PG8_BAR; }
  }
  PG8_WAIT_V(0);
  if constexpr (!ALIGN_EPI) { if (wr == 0) PG8_BAR; }
  PG8_BAR;
#undef PG8_SA
#undef PG8_SB
#undef PG8_STAGE
#undef PG8_LDA
#undef PG8_LDB
#undef PG8_MMA
#undef PG8_WAIT_V
#undef PG8_WAIT_L
#undef PG8_BAR
#undef PG8_SCHED
}

struct EpiBf16 {
  static constexpr bool PERM = true;
  bf16_t* O; int ldc; int coloff;
  DI void operator()(const f32x4 (&acc)[2][2][4][2], const Unit& u, int wr, int wc, int fr, int fq) const {
    const int row0 = u.pm * BM + wr * 64 + fr; const int col0 = coloff + u.pn * BM + wc * 32 + 8 * fq;
#pragma unroll
    for (int ai = 0; ai < 2; ++ai)
#pragma unroll
      for (int m = 0; m < 4; ++m) { bf16_t* rowp = O + (size_t)(row0 + ai * HALF + m * 16) * ldc + col0;
#pragma unroll
        for (int bj = 0; bj < 2; ++bj) { const f32x4 v0 = acc[ai][bj][m][0], v1 = acc[ai][bj][m][1];
          u32x4 w; w.x = cvtpk(v0[0], v0[1]); w.y = cvtpk(v0[2], v0[3]); w.z = cvtpk(v1[0], v1[1]); w.w = cvtpk(v1[2], v1[3]);
          *(u32x4*)(rowp + bj * HALF) = w; } }
  }
};
struct EpiRes {
  static constexpr bool PERM = false;
  const float* ResF; bf16_t* HB; float* SSP;
  DI void operator()(const f32x4 (&acc)[2][2][4][2], const Unit& u, int wr, int wc, int fr, int fq) const {
    const int row0 = u.pm * BM + wr * 64 + fr; const int col0 = u.pn * BM + wc * 32 + 4 * fq;
#pragma unroll
    for (int ai = 0; ai < 2; ++ai)
#pragma unroll
      for (int m = 0; m < 4; ++m) { const int row = row0 + ai * HALF + m * 16; const size_t off = (size_t)row * DM + col0; float ss = 0.f;
#pragma unroll
        for (int bj = 0; bj < 2; ++bj)
#pragma unroll
          for (int n = 0; n < 2; ++n) { f32x4 r;
            if (ResF) r = *(const f32x4*)(ResF + off + bj * HALF + n * 16);
            else { const u32x2 rb = *(const u32x2*)(HB + off + bj * HALF + n * 16); r = (f32x4){bflo(rb.x), bfhi(rb.x), bflo(rb.y), bfhi(rb.y)}; }
            const f32x4 o = r + acc[ai][bj][m][n];
            u32x2 w; w.x = cvtpk(o[0], o[1]); w.y = cvtpk(o[2], o[3]); *(u32x2*)(HB + off + bj * HALF + n * 16) = w;
            const float q0 = bflo(w.x), q1 = bfhi(w.x), q2 = bflo(w.y), q3 = bfhi(w.y);
            ss += (q0 * q0 + q1 * q1) + (q2 * q2 + q3 * q3); }
        ss += __shfl_xor(ss, 16); ss += __shfl_xor(ss, 32);
        if (fq == 0) SSP[(size_t)row * 16 + u.pn * 4 + wc] = ss; }
  }
};
DI float row_rstd(const float* SSP, int row) {
  const f32x4* p = (const f32x4*)(SSP + (size_t)row * 16); const f32x4 a = p[0], b = p[1], c = p[2], d = p[3];
  const float s = ((a[0] + a[1]) + (a[2] + a[3])) + ((b[0] + b[1]) + (b[2] + b[3])) + ((c[0] + c[1]) + (c[2] + c[3])) + ((d[0] + d[1]) + (d[2] + d[3]));
  return rsqrtf(s * (1.f / DM) + EPS);
}
struct EpiBf16RS {
  static constexpr bool PERM = true;
  bf16_t* O; const float* SSP;
  DI void operator()(const f32x4 (&acc)[2][2][4][2], const Unit& u, int wr, int wc, int fr, int fq) const {
    const int row0 = u.pm * BM + wr * 64 + fr; const int col0 = u.pn * BM + wc * 32 + 8 * fq;
#pragma unroll
    for (int ai = 0; ai < 2; ++ai)
#pragma unroll
      for (int m = 0; m < 4; ++m) { const int row = row0 + ai * HALF + m * 16; bf16_t* rowp = O + (size_t)row * DM + col0; const float rs = row_rstd(SSP, row);
#pragma unroll
        for (int bj = 0; bj < 2; ++bj) { const f32x4 v0 = acc[ai][bj][m][0] * rs, v1 = acc[ai][bj][m][1] * rs;
          u32x4 w; w.x = cvtpk(v0[0], v0[1]); w.y = cvtpk(v0[2], v0[3]); w.z = cvtpk(v1[0], v1[1]); w.w = cvtpk(v1[2], v1[3]);
          *(u32x4*)(rowp + bj * HALF) = w; } }
  }
};
struct EpiSoftmax {
  static constexpr bool PERM = true;
  bf16_t* P; const float* SSP; LAS float* xch;
  DI void operator()(f32x4 (&acc)[2][2][4][2], const Unit& u, int wr, int wc, int fr, int fq) const {
    const int row0 = u.pm * BM + wr * 64 + fr; const int col0 = u.pn * BM + wc * 32 + 8 * fq;
#pragma unroll
    for (int ai = 0; ai < 2; ++ai)
#pragma unroll
      for (int m = 0; m < 4; ++m) { const int row = row0 + ai * HALF + m * 16; const float rs = row_rstd(SSP, row) * 1.4426950408889634f; float s = 0.f;
#pragma unroll
        for (int bj = 0; bj < 2; ++bj)
#pragma unroll
          for (int n = 0; n < 2; ++n) { f32x4 v = acc[ai][bj][m][n] * rs;
#pragma unroll
            for (int q = 0; q < 4; ++q) v[q] = __builtin_amdgcn_exp2f(v[q]);
            acc[ai][bj][m][n] = v; s += (v[0] + v[1]) + (v[2] + v[3]); }
        s += __shfl_xor(s, 16); s += __shfl_xor(s, 32);
        if (fq == 0) xch[(wr * 64 + ai * HALF + m * 16 + fr) * 4 + wc] = s; }
    asm volatile("s_waitcnt lgkmcnt(0)" ::: "memory"); __builtin_amdgcn_s_barrier(); asm volatile("" ::: "memory");
#pragma unroll
    for (int ai = 0; ai < 2; ++ai)
#pragma unroll
      for (int m = 0; m < 4; ++m) { const int rl = wr * 64 + ai * HALF + m * 16 + fr; const f32x4 ps = *(const LAS f32x4*)(xch + rl * 4); const float inv = 1.f / ((ps[0] + ps[1]) + (ps[2] + ps[3]));
        bf16_t* rowp = P + (size_t)(row0 + ai * HALF + m * 16) * DM + col0;
#pragma unroll
        for (int bj = 0; bj < 2; ++bj) { const f32x4 v0 = acc[ai][bj][m][0] * inv, v1 = acc[ai][bj][m][1] * inv;
          u32x4 w; w.x = cvtpk(v0[0], v0[1]); w.y = cvtpk(v0[2], v0[3]); w.z = cvtpk(v1[0], v1[1]); w.w = cvtpk(v1[2], v1[3]);
          *(u32x4*)(rowp + bj * HALF) = w; } }
    asm volatile("s_waitcnt lgkmcnt(0)" ::: "memory"); __builtin_amdgcn_s_barrier(); asm volatile("" ::: "memory");
  }
};

struct PlainOrder {
  const char* A; const char* Bt; size_t tstepA, tstepB; int nM, nN, nwg, G, c;
  DI void init(const void* A_, const void* Bt_, int M, int N, int lda, int ldb, int G_, int c_) { A = (const char*)A_; Bt = (const char*)Bt_; tstepA = (size_t)BM * lda * 2; tstepB = (size_t)BM * ldb * 2; nM = M / BM; nN = N / BM; nwg = nM * nN; G = G_; c = c_; }
  DI bool next(int i, Unit& u) const {
    const long L = (long)i * G + c; if (L >= nwg) return false;
    int wgid = (int)L; { const int q = nwg / 8, r = nwg % 8, xcd = wgid % 8, off = wgid / 8; wgid = (xcd < r ? xcd * (q + 1) : r * (q + 1) + (xcd - r) * q) + off; }
    constexpr int WGM = 8;
    const int nig = WGM * nN, gid = wgid / nig, fm = gid * WGM, gsz = (nM - fm) < WGM ? (nM - fm) : WGM;
    u.pm = fm + ((wgid % nig) % gsz); u.pn = (wgid % nig) / gsz; u.a = A + (size_t)u.pm * tstepA; u.b = Bt + (size_t)u.pn * tstepB; return true;
  }
};
struct XaBatchOrder {
  const char* A; const char* Bb; int G, c;
  DI bool next(int i, Unit& u) const { const int L = i * G + c; if (L >= 512) return false; u.pm = L >> 2; u.pn = L & 3; const int b = u.pm >> 5;
    u.a = A + (size_t)u.pm * 256 * DM * 2; u.b = Bb + ((size_t)(b * 1024 + u.pn * 256) * DM) * 2; return true; }
};
struct FoldOrder {
  const char* KX; const char* WQO; const char* WOT; const char* VX; int G, c;
  DI bool next(int i, Unit& u) const { const int L = i * G + c; if (L >= 128) return false; const int t = L >> 6, b = (L >> 4) & 3, h = (L >> 2) & 3, q = L & 3;
    if (t == 0) { u.pm = b * 4 + h; u.pn = q; u.a = KX + ((size_t)(b * 256) * DM + h * 256) * 2; u.b = WQO + ((size_t)(q * 256) * DM + h * 256) * 2; }
    else { u.pm = 16 + b * 4 + q; u.pn = h; u.a = WOT + ((size_t)(q * 256) * DM + h * 256) * 2; u.b = VX + ((size_t)(b * 256) * DM + h * 256) * 2; }
    return true; }
};
struct MemProjOrder {
  const char* MEMN; const char* WKT; const char* WVT; int G, c;
  DI bool next(int i, Unit& u) const { const int L = i * G + c; if (L >= 32) return false; const int t = L >> 4, m = (L >> 2) & 3, n = L & 3;
    u.pm = t * 4 + m; u.pn = n; u.a = MEMN + (size_t)(m * 256) * DM * 2; u.b = (t ? WVT : WKT) + (size_t)(n * 256) * DM * 2; return true; }
};
}

struct Ctx {
  LAS unsigned char* lds;
  int tid, lane, wave, G, gw, NGW;
  const float* const* in;
  float* H;
  unsigned char* ws;
};
DI Ctx fresh(const Ctx& F) { Ctx R = F; int t = threadIdx.x; asm volatile("" : "+v"(t)); R.tid = t; R.lane = t & 63; R.wave = __builtin_amdgcn_readfirstlane(t >> 6); R.gw = blockIdx.x * NWAVES + R.wave; return R; }

DI void transpose_item(const float* W, int K, int Nsrc, int ldw, bf16_t* WT, int nblk, LAS float* scr, int item, int lane, int mode, const float* kgain = nullptr) {
  const int kb = item / nblk, nb = item % nblk, k0 = 64 * kb, n0 = 32 * nb;
  const int ncol = n0 + (lane & 31);
  float sc = 1.f;
  if (mode == 1) { if (ncol < 256) sc = 0.125f; else if (ncol >= C_NQ && ncol < C_NQ + 512) sc = 0.125f * 1.4426950408889634f; }
  if (mode == 2) sc = 0.0625f;
#pragma unroll 8
  for (int i = 0; i < 32; ++i) { const int kk = 2 * i + (lane >> 5); const float gk = kgain ? kgain[k0 + kk] : 1.f; scr[kk * 33 + (lane & 31)] = ncol < Nsrc ? W[(size_t)(k0 + kk) * ldw + ncol] * (sc * gk) : 0.f; }
  asm volatile("s_waitcnt lgkmcnt(0)" ::: "memory");
  const int c = lane & 7;
#pragma unroll
  for (int j = 0; j < 4; ++j) { const int n = (lane >> 3) + 8 * j; const LAS float* s = scr + (8 * c) * 33 + n;
    u32x4 o; o.x = cvtpk(s[0 * 33], s[1 * 33]); o.y = cvtpk(s[2 * 33], s[3 * 33]); o.z = cvtpk(s[4 * 33], s[5 * 33]); o.w = cvtpk(s[6 * 33], s[7 * 33]);
    *(u32x4*)(WT + (size_t)(n0 + n) * K + k0 + 8 * c) = o; }
  asm volatile("s_waitcnt lgkmcnt(0)" ::: "memory");
}
DI void rms_row_bf16(const float* xrow, const float* g, bf16_t* orow, int lane) {
  const f32x4* xr = (const f32x4*)xrow + lane;
  f32x4 v[4]; float s = 0.f;
#pragma unroll
  for (int j = 0; j < 4; ++j) { v[j] = xr[64 * j]; s += (v[j].x * v[j].x + v[j].y * v[j].y) + (v[j].z * v[j].z + v[j].w * v[j].w); }
  const float r = rsqrtf(wave_sum(s) * (1.f / DM) + EPS);
  u32x2* o8 = (u32x2*)orow + lane;
#pragma unroll
  for (int j = 0; j < 4; ++j) { const f32x4 gg = ((const f32x4*)g)[lane + 64 * j]; u32x2 w; w.x = cvtpk(v[j].x * r * gg.x, v[j].y * r * gg.y); w.y = cvtpk(v[j].z * r * gg.z, v[j].w * r * gg.w); o8[64 * j] = w; }
}
DI void cvt_row_fp8(const float* xrow, unsigned char* orow, float* inv_scale, int lane, const float* cgain = nullptr) {
  const f32x4* xr = (const f32x4*)xrow + lane; unsigned* o4 = (unsigned*)orow + lane;
  f32x4 v[4]; float mx = 0.f;
#pragma unroll
  for (int j = 0; j < 4; ++j) { v[j] = xr[64 * j]; if (cgain) v[j] = v[j] * ((const f32x4*)cgain)[lane + 64 * j]; mx = fmaxf(mx, fmaxf(fmaxf(fabsf(v[j].x), fabsf(v[j].y)), fmaxf(fabsf(v[j].z), fabsf(v[j].w)))); }
#pragma unroll
  for (int o = 1; o < 64; o <<= 1) mx = fmaxf(mx, __shfl_xor(mx, o));
  const float sc = mx > 0.f ? 256.f / mx : 1.f;
#pragma unroll
  for (int j = 0; j < 4; ++j) { int w = 0; w = __builtin_amdgcn_cvt_pk_fp8_f32(v[j].x * sc, v[j].y * sc, w, false); w = __builtin_amdgcn_cvt_pk_fp8_f32(v[j].z * sc, v[j].w * sc, w, true); o4[64 * j] = (unsigned)w; }
  if (lane == 0) *inv_scale = mx > 0.f ? mx * (1.f / 256.f) : 1.f;
}
DI void cvt_row_bf16(const float* xrow, bf16_t* orow, int lane) {
  const f32x4* xr = (const f32x4*)xrow + lane; u32x2* o8 = (u32x2*)orow + lane;
#pragma unroll
  for (int j = 0; j < 4; ++j) { const f32x4 v = xr[64 * j]; u32x2 w; w.x = cvtpk(v.x, v.y); w.y = cvtpk(v.z, v.w); o8[64 * j] = w; }
}

DI void rms_rows4_bf16(const float* x, const float* g, bf16_t* o, const int (&rows)[4], int lane) {
  f32x4 v[4][4];
#pragma unroll
  for (int q = 0; q < 4; ++q) { const f32x4* xr = (const f32x4*)(x + (size_t)rows[q] * DM) + lane;
#pragma unroll
    for (int j = 0; j < 4; ++j) v[q][j] = xr[64 * j]; }
#pragma unroll
  for (int q = 0; q < 4; ++q) { float s = 0.f;
#pragma unroll
    for (int j = 0; j < 4; ++j) s += (v[q][j].x * v[q][j].x + v[q][j].y * v[q][j].y) + (v[q][j].z * v[q][j].z + v[q][j].w * v[q][j].w);
    const float r = rsqrtf(wave_sum(s) * (1.f / DM) + EPS);
    u32x2* o8 = (u32x2*)(o + (size_t)rows[q] * DM) + lane;
#pragma unroll
    for (int j = 0; j < 4; ++j) { const f32x4 gg = ((const f32x4*)g)[lane + 64 * j]; u32x2 w; w.x = cvtpk(v[q][j].x * r * gg.x, v[q][j].y * r * gg.y); w.y = cvtpk(v[q][j].z * r * gg.z, v[q][j].w * r * gg.w); o8[64 * j] = w; } }
}
DI void cvt_rows4_fp8(const float* x, unsigned char* o, float* inv_scale, const int (&rows)[4], int lane, const float* cgain) {
  f32x4 v[4][4];
#pragma unroll
  for (int q = 0; q < 4; ++q) { const f32x4* xr = (const f32x4*)(x + (size_t)rows[q] * DM) + lane;
#pragma unroll
    for (int j = 0; j < 4; ++j) v[q][j] = xr[64 * j]; }
#pragma unroll
  for (int q = 0; q < 4; ++q) { float mx = 0.f;
#pragma unroll
    for (int j = 0; j < 4; ++j) { if (cgain) v[q][j] = v[q][j] * ((const f32x4*)cgain)[lane + 64 * j]; mx = fmaxf(mx, fmaxf(fmaxf(fabsf(v[q][j].x), fabsf(v[q][j].y)), fmaxf(fabsf(v[q][j].z), fabsf(v[q][j].w)))); }
#pragma unroll
    for (int o_ = 1; o_ < 64; o_ <<= 1) mx = fmaxf(mx, __shfl_xor(mx, o_));
    const float sc = mx > 0.f ? 256.f / mx : 1.f;
#pragma unroll
    for (int j = 0; j < 4; ++j) { int w = 0; w = __builtin_amdgcn_cvt_pk_fp8_f32(v[q][j].x * sc, v[q][j].y * sc, w, false); w = __builtin_amdgcn_cvt_pk_fp8_f32(v[q][j].z * sc, v[q][j].w * sc, w, true);
      const int col = 4 * (lane + 64 * j); *(unsigned*)(o + ((size_t)(col >> 7) * 16384 + rows[q]) * 128 + (col & 127)) = (unsigned)w; }
    if (lane == 0) inv_scale[rows[q]] = mx > 0.f ? mx * (1.f / 256.f) : 1.f; }
}

DI void prologue(const Ctx& F0) {
  const Ctx F = fresh(F0);
  LAS float* scr = (LAS float*)(F.lds + F.wave * 16384);
  unsigned char* ws = F.ws;
  constexpr int I_IN = 16 * 96, I_SQ = 16 * 32, I_W1 = 32 * 4, I_W2 = 2 * 2;
  constexpr int NT_ITEMS = I_IN + 5 * I_SQ + 2 * I_W1 + 2 * I_W2;
  for (int it = F.gw; it < NT_ITEMS; it += F.NGW) {
    int r = it;
    if (r < I_IN) { transpose_item(F.in[I_WIN], 1024, IN_COLS, IN_COLS, (bf16_t*)(ws + WS_WIN), 96, scr, r, F.lane, 1); continue; } r -= I_IN;
    if (r < I_SQ) { transpose_item(F.in[I_WOUT], 1024, 1024, 1024, (bf16_t*)(ws + WS_WOUT), 32, scr, r, F.lane, 0); continue; } r -= I_SQ;
    if (r < I_SQ) { transpose_item(F.in[I_XWK], 1024, 1024, 1024, (bf16_t*)(ws + WS_XWK), 32, scr, r, F.lane, 0); continue; } r -= I_SQ;
    if (r < I_SQ) { transpose_item(F.in[I_XWV], 1024, 1024, 1024, (bf16_t*)(ws + WS_XWV), 32, scr, r, F.lane, 0); continue; } r -= I_SQ;
    if (r < I_SQ) { transpose_item(F.in[I_XWO], 1024, 1024, 1024, (bf16_t*)(ws + WS_XWO), 32, scr, r, F.lane, 0); continue; } r -= I_SQ;
    if (r < I_SQ) { transpose_item(F.in[I_PWQ], 1024, 1024, 1024, (bf16_t*)(ws + WS_PWQ), 32, scr, r, F.lane, 0, F.in[I_NFFN]); continue; } r -= I_SQ;
    if (r < I_W1) { transpose_item(F.in[I_CKW1], 2048, 128, 128, (bf16_t*)(ws + WS_W1T), 4, scr, r, F.lane, 0); continue; } r -= I_W1;
    if (r < I_W1) { transpose_item(F.in[I_CVW1], 2048, 128, 128, (bf16_t*)(ws + WS_W1T) + 128 * 2048, 4, scr, r, F.lane, 0); continue; } r -= I_W1;
    if (r < I_W2) { transpose_item(F.in[I_CKW2], 128, 64, 64, (bf16_t*)(ws + WS_W2T), 2, scr, r, F.lane, 0); continue; } r -= I_W2;
    transpose_item(F.in[I_CVW2], 128, 64, 64, (bf16_t*)(ws + WS_W2T) + 64 * 128, 2, scr, r, F.lane, 0);
  }
#pragma unroll 1
  for (int r0 = F.gw; r0 < NTOK; r0 += 4 * F.NGW) { const int rows[4] = {r0, min(r0 + F.NGW, NTOK - 1), min(r0 + 2 * F.NGW, NTOK - 1), min(r0 + 3 * F.NGW, NTOK - 1)};
    rms_rows4_bf16(F.in[I_X], F.in[I_NMIX], (bf16_t*)(ws + WS_HN), rows, F.lane); }
#pragma unroll 1
  for (int r0 = F.gw; r0 < 16384; r0 += 4 * F.NGW) { const int rows[4] = {r0, min(r0 + F.NGW, 16383), min(r0 + 2 * F.NGW, 16383), min(r0 + 3 * F.NGW, 16383)};
    cvt_rows4_fp8(F.in[I_PDOWN], ws + WS_PDOWN8, (float*)(ws + WS_DSC), rows, F.lane, F.in[I_NFFN]);
    cvt_rows4_fp8(F.in[I_PUP], ws + WS_PUP8, (float*)(ws + WS_USC), rows, F.lane, nullptr); }
  constexpr int R_MEM = 1024, R_WQ = 1024, R_SK = 128, R_C1 = 256, R_BK = 8;
  constexpr int NR_ITEMS = R_MEM + R_WQ + R_SK + R_C1 + R_BK;
  for (int it = F.gw; it < NR_ITEMS; it += F.NGW) {
    int r = it;
    if (r < R_MEM) { rms_row_bf16(F.in[I_MEM] + (size_t)r * DM, F.in[I_NMEM], (bf16_t*)(ws + WS_MEMN) + (size_t)r * DM, F.lane); continue; } r -= R_MEM;
    if (r < R_WQ) {
      const float sck = F.in[I_NXA][r] * 0.0625f; const f32x4* xr = (const f32x4*)(F.in[I_XWQ] + (size_t)r * DM) + F.lane; u32x2* o8 = (u32x2*)((bf16_t*)(ws + WS_XWQ) + (size_t)r * DM) + F.lane;
#pragma unroll
      for (int j = 0; j < 4; ++j) { const f32x4 v = xr[64 * j] * sck; u32x2 w; w.x = cvtpk(v.x, v.y); w.y = cvtpk(v.z, v.w); o8[64 * j] = w; }
      continue; } r -= R_WQ;
    if (r < R_SK) { cvt_row_bf16(F.in[I_PSK] + (size_t)r * 1024, (bf16_t*)(ws + WS_SK) + (size_t)r * 1024, F.lane); continue; } r -= R_SK;
    if (r < R_C1) {
      const int kv = r >> 7, hid = r & 127; const float* pos = F.in[kv ? I_POSV : I_POSK]; const float* w1 = F.in[kv ? I_CVW1 : I_CKW1];
      float s = 0.f;
      for (int i = F.lane; i < 2048; i += 64) s += pos[i] * w1[(size_t)i * 128 + hid];
      s = wave_sum(s);
      if (F.lane == 0) ((float*)(ws + WS_C1))[kv * 128 + hid] = s;
      continue; } r -= R_C1;
    {
      unsigned char* bk = ws + WS_BUCK;
      for (int i = F.lane; i < 1024; i += 64) { const int d = r * 1024 + i;
        int b = d;
        if (d >= 16) { b = 16; const int thr[15] = {22, 30, 40, 54, 73, 99, 134, 182, 246, 332, 450, 609, 825, 1117, 1513};
#pragma unroll
          for (int k = 0; k < 15; ++k) b += (d >= thr[k]) ? 1 : 0; }
        bk[d] = (unsigned char)b; }
    }
  }
}

constexpr int GL_LA = 0, GL_SEG = 16384, GL_GLR = 18432, GL_W2 = 22528, GL_BIAS = 26624, GL_QT = 27648, GL_KT = 35840, GL_KTT = 44032, GL_V = 52224, GL_O = 68608;
constexpr int G0_STRIDE = 68608;
constexpr int G1_QT = 0, G1_KT = 8192, G1_V = 16384, G1_O = 32768, G1_STRIDE = 66560;
template <int MODE>
DI void gla_pair(const Ctx& F, const int ua, const int ub) {
  const int tid = F.tid, lane = F.lane, w = F.wave;
  const bf16_t* Z = (const bf16_t*)(F.ws + WS_Z);
  const int t = tid >> 3, c8 = tid & 7;
  const int r32 = lane & 31, hi = lane >> 5, i16 = lane & 15, g16 = lane >> 4;
  const int un[2] = {ua, ub};
  __syncthreads();
  if constexpr (MODE == 0) {
    u32x4 q8[2], k8[2];
#pragma unroll
    for (int s = 0; s < 2; ++s) {
      const int unit = un[s], c = unit & 127, h = (unit >> 7) & 3, b = unit >> 9; const size_t m0 = (size_t)b * T + (size_t)c * 64;
      LAS unsigned char* L = F.lds + s * G0_STRIDE;
      const bf16_t* zrow = Z + (m0 + t) * ZP;
      q8[s] = *(const u32x4*)(zrow + C_GQ + h * 64 + c8 * 8); k8[s] = *(const u32x4*)(zrow + C_GK + h * 64 + c8 * 8);
      const u32x4 v0 = *(const u32x4*)(zrow + C_GV + h * 128 + c8 * 8), v1 = *(const u32x4*)(zrow + C_GV + h * 128 + 64 + c8 * 8);
      *(LAS u32x4*)(L + GL_V + t * 256 + c8 * 16) = v0; *(LAS u32x4*)(L + GL_V + t * 256 + 128 + c8 * 16) = v1;
      if (tid < 128) { const int tt = tid >> 1, hf = tid & 1; const u32x4 g = *(const u32x4*)(Z + (m0 + tt) * ZP + C_GLR + hf * 8);
        LAS float* o = (LAS float*)(L + GL_GLR) + tt * 16 + hf * 8; o[0] = bflo(g.x); o[1] = bfhi(g.x); o[2] = bflo(g.y); o[3] = bfhi(g.y); o[4] = bflo(g.z); o[5] = bfhi(g.z); o[6] = bflo(g.w); o[7] = bfhi(g.w); }
      if (tid < 256) { const int r = tid >> 4, c4 = tid & 15; *(LAS f32x4*)((LAS float*)(L + GL_W2) + r * 64 + c4 * 4) = *(const f32x4*)(F.in[I_GW2] + r * 256 + h * 64 + c4 * 4); }
      if (tid < 64) ((LAS float*)(L + GL_BIAS))[tid] = F.in[I_GB][h * 64 + tid];
    }
    __syncthreads();
#pragma unroll
    for (int s = 0; s < 2; ++s) {
      LAS unsigned char* L = F.lds + s * G0_STRIDE;
      LAS float* LA = (LAS float*)(L + GL_LA); const LAS float* GLR = (const LAS float*)(L + GL_GLR); const LAS float* W2 = (const LAS float*)(L + GL_W2); const LAS float* BIAS = (const LAS float*)(L + GL_BIAS);
      float z[8];
#pragma unroll
      for (int j = 0; j < 8; ++j) z[j] = BIAS[c8 * 8 + j];
#pragma unroll
      for (int r = 0; r < 16; ++r) { const float g = GLR[t * 16 + r];
#pragma unroll
        for (int j = 0; j < 8; ++j) z[j] += g * W2[r * 64 + c8 * 8 + j]; }
#pragma unroll
      for (int j = 0; j < 8; ++j) { const float zz = z[j]; const float ls = fminf(zz, 0.f) - __logf(1.f + __expf(-fabsf(zz))); LA[t * 64 + c8 * 8 + j] = ls * (1.f / 16.f); }
    }
    __syncthreads();
    {
      const int d = tid & 63, seg = tid >> 6; float v[2][8];
#pragma unroll
      for (int s = 0; s < 2; ++s) { LAS unsigned char* L = F.lds + s * G0_STRIDE; const LAS float* LA = (const LAS float*)(L + GL_LA); float run = 0.f;
#pragma unroll
        for (int i = 0; i < 8; ++i) { run += LA[(seg * 8 + i) * 64 + d]; v[s][i] = run; }
        ((LAS float*)(L + GL_SEG))[seg * 64 + d] = run; }
      __syncthreads();
#pragma unroll
      for (int s = 0; s < 2; ++s) { LAS unsigned char* L = F.lds + s * G0_STRIDE; LAS float* LA = (LAS float*)(L + GL_LA); const LAS float* SEG = (const LAS float*)(L + GL_SEG); float off = 0.f;
#pragma unroll
        for (int q = 0; q < 8; ++q) off += (q < seg) ? SEG[q * 64 + d] : 0.f;
#pragma unroll
        for (int i = 0; i < 8; ++i) LA[(seg * 8 + i) * 64 + d] = v[s][i] + off; }
    }
    __syncthreads();
#pragma unroll
    for (int s = 0; s < 2; ++s) {
      const int unit = un[s]; LAS unsigned char* L = F.lds + s * G0_STRIDE; const LAS float* LA = (const LAS float*)(L + GL_LA);
      float bb[8];
#pragma unroll
      for (int j = 0; j < 8; ++j) bb[j] = LA[t * 64 + c8 * 8 + j];
      const unsigned qw[4] = {q8[s].x, q8[s].y, q8[s].z, q8[s].w}, kw[4] = {k8[s].x, k8[s].y, k8[s].z, k8[s].w};
      u32x4 qo, ko; unsigned kk16[8];
#pragma unroll
      for (int p = 0; p < 4; ++p) {
        const float e0 = __expf(bb[2 * p]), e1 = __expf(bb[2 * p + 1]);
        const unsigned qp = cvtpk(bflo(qw[p]) * e0, bfhi(qw[p]) * e1), kp = cvtpk(bflo(kw[p]) / e0, bfhi(kw[p]) / e1);
        qo[p] = qp; ko[p] = kp; kk16[2 * p] = kp & 0xffffu; kk16[2 * p + 1] = kp >> 16;
      }
      *(u32x4*)((bf16_t*)(F.ws + WS_GQ) + (size_t)unit * 4096 + t * 64 + c8 * 8) = qo;
      *(u32x4*)((bf16_t*)(F.ws + WS_GK) + (size_t)unit * 4096 + t * 64 + c8 * 8) = ko;
#pragma unroll
      for (int j = 0; j < 8; ++j) { const int d = c8 * 8 + j; *(LAS unsigned short*)(L + GL_KTT + d * 128 + (((t >> 3) ^ (d & 7)) << 4) + (t & 7) * 2) = (unsigned short)kk16[j]; }
    }
    __syncthreads();
#pragma unroll
    for (int s = 0; s < 2; ++s) {
      const int unit = un[s]; LAS unsigned char* L = F.lds + s * G0_STRIDE;
      const int dvt = w >> 1, dt = w & 1; f32x16 acc = {}; const int dcol = 32 * dt + r32;
#pragma unroll
      for (int ks = 0; ks < 4; ++ks) {
        const LAS unsigned char* vp = L + GL_V + (16 * ks + 8 * hi + (i16 >> 2)) * 256 + (32 * dvt + 16 * (g16 & 1) + 4 * (i16 & 3)) * 2;
        const bf16x8 a = cat8(vtr(vp), vtr(vp + 4 * 256));
        const bf16x8 bfr = *(const LAS bf16x8*)(L + GL_KTT + dcol * 128 + (((2 * ks + hi) ^ (dcol & 7)) << 4));
        acc = MFMA32(a, bfr, acc);
      }
      float* U = (float*)(F.ws + WS_GU) + (size_t)unit * 8192;
#pragma unroll
      for (int r = 0; r < 16; ++r) U[(32 * dvt + crow(r, hi)) * 64 + dcol] = acc[r];
      if (tid < 64) ((float*)(F.ws + WS_DL))[unit * 64 + tid] = __expf(((const LAS float*)(L + GL_LA))[63 * 64 + tid]);
    }
  } else {
    u32x4 gr0[2], gr1[2]; bf16x8 sf[2][4];
#pragma unroll
    for (int s = 0; s < 2; ++s) {
      const int unit = un[s], c = unit & 127, h = (unit >> 7) & 3, b = unit >> 9; const size_t m0 = (size_t)b * T + (size_t)c * 64;
      LAS unsigned char* L = F.lds + s * G1_STRIDE;
      const bf16_t* zrow = Z + (m0 + t) * ZP;
      const u32x4 qo = *(const u32x4*)((const bf16_t*)(F.ws + WS_GQ) + (size_t)unit * 4096 + t * 64 + c8 * 8);
      const u32x4 ko = *(const u32x4*)((const bf16_t*)(F.ws + WS_GK) + (size_t)unit * 4096 + t * 64 + c8 * 8);
      const u32x4 v0 = *(const u32x4*)(zrow + C_GV + h * 128 + c8 * 8), v1 = *(const u32x4*)(zrow + C_GV + h * 128 + 64 + c8 * 8);
      const int seg = tid & 7;
      gr0[s] = *(const u32x4*)(zrow + C_GR + h * 128 + seg * 16); gr1[s] = *(const u32x4*)(zrow + C_GR + h * 128 + seg * 16 + 8);
      const bf16_t* S = (const bf16_t*)(F.ws + WS_GS) + (size_t)unit * 8192;
#pragma unroll
      for (int kd = 0; kd < 4; ++kd) sf[s][kd] = *(const bf16x8*)(S + (32 * (w >> 1) + r32) * 64 + 16 * kd + 8 * hi);
      const int swz = (c8 ^ (t & 7)) << 4;
      *(LAS u32x4*)(L + G1_QT + t * 128 + swz) = qo; *(LAS u32x4*)(L + G1_KT + t * 128 + swz) = ko;
      *(LAS u32x4*)(L + G1_V + t * 256 + c8 * 16) = v0; *(LAS u32x4*)(L + G1_V + t * 256 + 128 + c8 * 16) = v1;
    }
    __syncthreads();
#pragma unroll
    for (int s = 0; s < 2; ++s) {
      const int unit = un[s], c = unit & 127; LAS unsigned char* L = F.lds + s * G1_STRIDE;
      const int dvt = w >> 1, tt = w & 1; f32x16 o = {}; const int tcol = 32 * tt + r32;
      for (int st = 0; st <= tt; ++st) {
        f32x16 x = {}; const int srow = 32 * st + r32;
#pragma unroll
        for (int kd = 0; kd < 4; ++kd) {
          const bf16x8 a = *(const LAS bf16x8*)(L + G1_KT + srow * 128 + (((2 * kd + hi) ^ (srow & 7)) << 4));
          const bf16x8 bfr = *(const LAS bf16x8*)(L + G1_QT + tcol * 128 + (((2 * kd + hi) ^ (tcol & 7)) << 4));
          x = MFMA32(a, bfr, x);
        }
        if (st == tt) {
#pragma unroll
          for (int r = 0; r < 16; ++r) if (crow(r, hi) > r32) x[r] = 0.f;
        }
#pragma unroll
        for (int ks2 = 0; ks2 < 2; ++ks2) {
          const LAS unsigned char* vp = L + G1_V + (32 * st + 16 * ks2 + 4 * hi + (i16 >> 2)) * 256 + (32 * dvt + 16 * (g16 & 1) + 4 * (i16 & 3)) * 2;
          const bf16x8 a = cat8(vtr(vp), vtr(vp + 8 * 256));
          o = MFMA32(a, pack8(x, ks2), o);
        }
      }
      if (c > 0) {
#pragma unroll
        for (int kd = 0; kd < 4; ++kd) {
          const bf16x8 bfr = *(const LAS bf16x8*)(L + G1_QT + tcol * 128 + (((2 * kd + hi) ^ (tcol & 7)) << 4));
          o = MFMA32(sf[s][kd], bfr, o);
        }
      }
      LAS float* OL = (LAS float*)(L + G1_O);
#pragma unroll
      for (int r = 0; r < 16; ++r) OL[tcol * 129 + 32 * dvt + crow(r, hi)] = o[r];
    }
    __syncthreads();
#pragma unroll
    for (int s = 0; s < 2; ++s) {
      const int unit = un[s], c = unit & 127, h = (unit >> 7) & 3, b = unit >> 9; const size_t m0 = (size_t)b * T + (size_t)c * 64;
      const LAS float* OL = (const LAS float*)(F.lds + s * G1_STRIDE + G1_O);
      const int seg = tid & 7; float v[16]; float ss = 0.f;
#pragma unroll
      for (int j = 0; j < 16; ++j) { v[j] = OL[t * 129 + seg * 16 + j]; ss += v[j] * v[j]; }
      ss += __shfl_xor(ss, 1); ss += __shfl_xor(ss, 2); ss += __shfl_xor(ss, 4);
      const float rs = rsqrtf(ss * (1.f / 128.f) + EPS);
      const unsigned gw_[8] = {gr0[s].x, gr0[s].y, gr0[s].z, gr0[s].w, gr1[s].x, gr1[s].y, gr1[s].z, gr1[s].w};
      const float* on = F.in[I_GON] + seg * 16;
      unsigned ow[8];
#pragma unroll
      for (int p = 0; p < 8; ++p) { const float ga = bflo(gw_[p]), gb = bfhi(gw_[p]);
        const float oa = v[2 * p] * rs * on[2 * p] * (ga * sigmoidf_(ga)), ob = v[2 * p + 1] * rs * on[2 * p + 1] * (gb * sigmoidf_(gb)); ow[p] = cvtpk(oa, ob); }
      bf16_t* dst = (bf16_t*)(F.ws + WS_OCAT) + (m0 + t) * DM + h * 128 + seg * 16;
      *(u32x4*)dst = (u32x4){ow[0], ow[1], ow[2], ow[3]}; *(u32x4*)(dst + 8) = (u32x4){ow[4], ow[5], ow[6], ow[7]};
    }
  }
}
template <int MODE>
DI void gla_phase(const Ctx& F0) {
  const Ctx F = fresh(F0);
  const int bx = blockIdx.x, G = F.G;
  const int nu = bx < 2048 ? (2048 - bx + G - 1) / G : 0;
#pragma unroll 1
  for (int i = 0; i < nu; i += 2) gla_pair<MODE>(F, bx + i * G, bx + (i + 1 < nu ? i + 1 : i) * G);
}
DI void gla_scan(const Ctx& F0) {
  const Ctx F = fresh(F0);
  const float* U = (const float*)(F.ws + WS_GU); const float* DL = (const float*)(F.ws + WS_DL); bf16_t* GS = (bf16_t*)(F.ws + WS_GS);
  for (int e = blockIdx.x * NTHREADS + F.tid; e < 16 * 8192; e += F.G * NTHREADS) {
    const int bh = e >> 13, rem = e & 8191, d = e & 63;
    float S = 0.f;
#pragma unroll 8
    for (int c = 0; c < 128; ++c) { const size_t unit = (size_t)bh * 128 + c;
      GS[unit * 8192 + rem] = (bf16_t)f2bf(S);
      S = DL[unit * 64 + d] * (S + U[unit * 8192 + rem]); }
  }
}

DI void nsa_compress_unit(const Ctx& F0, const int wt) {
  const Ctx F = fresh(F0);
  const int lane = F.lane, w = F.wave, r32 = lane & 31, hi = lane >> 5;
  const int kv = wt >> 7, nt = wt & 127, bg = nt >> 4, n0 = (nt & 15) * 32, b = bg >> 1, g = bg & 1;
  const bf16_t* Z = (const bf16_t*)(F.ws + WS_Z);
  const bf16_t* W1T = (const bf16_t*)(F.ws + WS_W1T) + (size_t)kv * 128 * 2048;
  const bf16_t* W2T = (const bf16_t*)(F.ws + WS_W2T) + (size_t)kv * 64 * 128;
  const float* C1 = (const float*)(F.ws + WS_C1) + kv * 128;
  const int col0 = (kv ? C_VC : C_KC) + g * 64;
  const int n = n0 + r32;
  LAS float* RED = (LAS float*)F.lds;
  __syncthreads();
  f32x16 acc[4] = {};
#pragma unroll
  for (int ll = 0; ll < 4; ++ll) {
    const int l = 4 * w + ll;
    int trow = 16 * n + l; trow = trow > T - 1 ? T - 1 : trow;
    const bf16_t* src = Z + ((size_t)b * T + trow) * ZP + col0 + 8 * hi;
#pragma unroll
    for (int q = 0; q < 4; ++q) {
      const int ks = 4 * l + q;
      const bf16x8 bfr = *(const bf16x8*)(src + 16 * q);
#pragma unroll
      for (int ht = 0; ht < 4; ++ht) { const bf16x8 a = *(const bf16x8*)(W1T + (size_t)(32 * ht + r32) * 2048 + 16 * ks + 8 * hi); acc[ht] = MFMA32(a, bfr, acc[ht]); }
    }
  }
#pragma unroll
  for (int ht = 0; ht < 4; ++ht)
#pragma unroll
    for (int r = 0; r < 16; ++r) RED[w * 4096 + (ht * 16 + r) * 64 + lane] = acc[ht][r];
  __syncthreads();
  if (w == 0) {
    bf16x8 pb[4][2];
#pragma unroll
    for (int ht = 0; ht < 4; ++ht) {
#pragma unroll
      for (int r = 0; r < 16; ++r) { float sm = 0.f;
#pragma unroll
        for (int ww = 0; ww < 8; ++ww) sm += RED[ww * 4096 + (ht * 16 + r) * 64 + lane];
        acc[ht][r] = gelu_tanh(sm + C1[32 * ht + crow(r, hi)]); }
      pb[ht][0] = pack8(acc[ht], 0); pb[ht][1] = pack8(acc[ht], 1);
    }
    bf16_t* OUT = (bf16_t*)(F.ws + (kv ? WS_VCMP : WS_KCMP)) + ((size_t)bg * 512 + n) * 64;
#pragma unroll
    for (int dt = 0; dt < 2; ++dt) {
      f32x16 o = {};
#pragma unroll
      for (int ht = 0; ht < 4; ++ht)
#pragma unroll
        for (int ks2 = 0; ks2 < 2; ++ks2) {
          const bf16_t* wp = W2T + (size_t)(32 * dt + r32) * 128 + 32 * ht + 16 * ks2 + 4 * hi;
          const u32x2 lo = *(const u32x2*)wp, hi2 = *(const u32x2*)(wp + 8);
          const u32x4 aw = {lo.x, lo.y, hi2.x, hi2.y};
          o = MFMA32(__builtin_bit_cast(bf16x8, aw), pb[ht][ks2], o);
        }
#pragma unroll
      for (int rr = 0; rr < 4; ++rr) { u32x2 wv; wv.x = cvtpk(o[4 * rr], o[4 * rr + 1]); wv.y = cvtpk(o[4 * rr + 2], o[4 * rr + 3]); *(u32x2*)(OUT + 32 * dt + 8 * rr + 4 * hi) = wv; }
    }
  }
  __syncthreads();
}

constexpr int NS_K = 0, NS_V = 32768, NS_IMP = 65536, NS_MASK = 99328, NS_BUCK = 100352, NS_BIAS = 108544, NS_THR = 109056, NS_WB = 109184;
constexpr int IMP_P = 132;
constexpr int NS_X3 = NS_IMP;
struct TileSrc { const bf16_t* k; const bf16_t* v; int pitch; };
DI void ns_load(u32x4& kr, u32x4& vr, const TileSrc& s, int row0, int tid) {
  const int key = tid >> 3, c8 = tid & 7;
  kr = *(const u32x4*)(s.k + (size_t)(row0 + key) * s.pitch + c8 * 8);
  vr = *(const u32x4*)(s.v + (size_t)(row0 + key) * s.pitch + c8 * 8);
}
DI void ns_store(LAS unsigned char* L, int buf, const u32x4& kr, const u32x4& vr, int tid) {
  const int key = tid >> 3, c8 = tid & 7;
  *(LAS u32x4*)(L + NS_K + buf * 8192 + key * 128 + ((c8 ^ ((key >> 1) & 7)) << 4)) = kr;
  *(LAS u32x4*)(L + NS_V + buf * 8192 + key * 128 + ((c8 * 16) ^ (((key >> 1) & 1) << 6))) = vr;
}
DI void ns_qk(f32x16& p0, f32x16& p1, const LAS unsigned char* Kb, const bf16x8 (&qf)[4], int r32, int hi) {
  p0 = (f32x16){}; p1 = (f32x16){};
#pragma unroll
  for (int ks = 0; ks < 4; ++ks) {
    const bf16x8 a0 = *(const LAS bf16x8*)(Kb + r32 * 128 + (((2 * ks + hi) ^ ((r32 >> 1) & 7)) << 4));
    const bf16x8 a1 = *(const LAS bf16x8*)(Kb + (32 + r32) * 128 + (((2 * ks + hi) ^ ((r32 >> 1) & 7)) << 4));
    p0 = MFMA32(a0, qf[ks], p0); p1 = MFMA32(a1, qf[ks], p1);
  }
}
DI void ns_pv(f32x16 (&o)[2], const LAS unsigned char* Vb, const f32x16& p0, const f32x16& p1, int lane) {
  const int hi = lane >> 5, i16 = lane & 15, g16 = lane >> 4;
#pragma unroll
  for (int ks = 0; ks < 4; ++ks) {
    const bf16x8 pb = pack8(ks < 2 ? p0 : p1, ks & 1);
#pragma unroll
    for (int dt = 0; dt < 2; ++dt) {
      const int vrow = 16 * ks + 4 * hi + (i16 >> 2);
      const LAS unsigned char* vp = Vb + vrow * 128 + (((32 * dt + 16 * (g16 & 1) + 4 * (i16 & 3)) * 2) ^ (((vrow >> 1) & 1) << 6));
      o[dt] = MFMA32(cat8(vtr(vp), vtr(vp + 8 * 128)), pb, o[dt]);
    }
  }
}
DI void ns_dma(LAS unsigned char* L, int kslot_off, int vslot_off, const TileSrc& s, int row0, int lane, int w) {
  const int row = 8 * w + (lane >> 3), pc = lane & 7;
  const bf16_t* kp = s.k + (size_t)(row0 + row) * s.pitch + ((pc ^ ((row >> 1) & 7)) << 3);
  const bf16_t* vp = s.v + (size_t)(row0 + row) * s.pitch + ((pc ^ (((row >> 1) & 1) << 2)) << 3);
  __builtin_amdgcn_global_load_lds((const unsigned*)kp, (LAS unsigned*)(L + kslot_off + w * 1024), 16, 0, 0);
  __builtin_amdgcn_global_load_lds((const unsigned*)vp, (LAS unsigned*)(L + vslot_off + w * 1024), 16, 0, 0);
}
DI float ns_bias(const LAS unsigned char* L, int hd, int dist) {
  const int dc = dist < 0 ? 0 : dist;
  const int bk = *(const LAS unsigned char*)(L + NS_BUCK + dc);
  return ((const LAS float*)(L + NS_BIAS))[bk * 4 + hd];
}
DI float ex2(float x) { return __builtin_amdgcn_exp2f(x); }

DI void nsa_unit(const Ctx& F0, const int bg, const int tile) {
  const Ctx F = fresh(F0);
  const int tid = F.tid, lane = F.lane, w = F.wave, r32 = lane & 31, hi = lane >> 5;
  const int b = bg >> 1, g = bg & 1, t0 = tile * 64, cur = tile;
  LAS unsigned char* L = F.lds;
  const bf16_t* Z = (const bf16_t*)(F.ws + WS_Z);
  const int tokl = r32 >> 2, hd = r32 & 3, head = g * 4 + hd;
  const int t = t0 + 8 * w + tokl;
  const size_t mrow = (size_t)b * T + t;
  __syncthreads();
  for (int i = tid; i < 2048; i += NTHREADS) ((LAS unsigned*)(L + NS_BUCK))[i] = ((const unsigned*)(F.ws + WS_BUCK))[i];
  if (tid < 128) ((LAS float*)(L + NS_BIAS))[tid] = F.in[I_RELB][(tid >> 2) * 8 + g * 4 + (tid & 3)] * 1.4426950408889634f;
  if (tid < 32) { const int thr[32] = {0, 1, 2, 3, 4, 5, 6, 7, 8, 9, 10, 11, 12, 13, 14, 15, 16, 22, 30, 40, 54, 73, 99, 134, 182, 246, 332, 450, 609, 825, 1117, 1513};
    int v = 0;
#pragma unroll
    for (int k = 0; k < 32; ++k) v = (tid == k) ? thr[k] : v;
    ((LAS int*)(L + NS_THR))[tid] = v; }
  __syncthreads();
  for (int i = tid; i < 4 * 576; i += NTHREADS) { const int hh = i / 576, d = i - hh * 576; ((LAS float*)(L + NS_WB))[hh * 577 + d] = ((const LAS float*)(L + NS_BIAS))[(int)*(const LAS unsigned char*)(L + NS_BUCK + d) * 4 + hh]; }
  bf16x8 qf[4];
#pragma unroll
  for (int ks = 0; ks < 4; ++ks) qf[ks] = *(const bf16x8*)(Z + mrow * ZP + C_NQ + head * 64 + 16 * ks + 8 * hi);
  float gate[3];
#pragma unroll
  for (int i = 0; i < 3; ++i) gate[i] = sigmoidf_(bf2f(Z[mrow * ZP + C_NG + head * 3 + i]));
  f32x16 tot[2] = {};
  u32x4 kr, vr;

  const int nmax = (t0 + 32) >> 4;
  const int nct = (nmax >> 6) + 1;
  TileSrc sc; sc.k = (const bf16_t*)(F.ws + WS_KCMP) + (size_t)bg * 512 * 64; sc.v = (const bf16_t*)(F.ws + WS_VCMP) + (size_t)bg * 512 * 64; sc.pitch = 64;
  float m_c = -1e30f, l_c = 0.f;
  u32x4 kr2 = {}, vr2 = {};
  ns_load(kr, vr, sc, 0, tid); ns_store(L, 0, kr, vr, tid); ns_load(kr, vr, sc, nct > 1 ? 64 : 0, tid); __syncthreads();
  auto step1 = [&](const int ci, u32x4& kA, u32x4& vA, u32x4& kB, u32x4& vB) {
    ns_load(kB, vB, sc, 64 * (ci + 2 < nct ? ci + 2 : nct - 1), tid);
    f32x16 p0, p1; ns_qk(p0, p1, L + NS_K + (ci & 1) * 8192, qf, r32, hi);
    float mt = -1e30f;
    if (t0 + 8 * w - 31 - 16 * (64 * ci + 63) >= 1513) {
      const float b31 = ((const LAS float*)(L + NS_BIAS))[31 * 4 + hd];
#pragma unroll
      for (int r = 0; r < 16; ++r) { p0[r] += b31; p1[r] += b31; mt = fmaxf(mt, fmaxf(p0[r], p1[r])); }
    } else {
#pragma unroll
    for (int hf = 0; hf < 2; ++hf)
#pragma unroll
      for (int r = 0; r < 16; ++r) { const int n = 64 * ci + 32 * hf + crow(r, hi); const int dist = t - 16 * n - 31;
        float s = (hf ? p1[r] : p0[r]) + ns_bias(L, hd, dist); s = dist >= 0 ? s : -INFINITY; if (hf) p1[r] = s; else p0[r] = s; mt = fmaxf(mt, s); }
    }
    const float mn = fmaxf(m_c, mt); float sum = 0.f;
#pragma unroll
    for (int r = 0; r < 16; ++r) sum += ex2(p0[r] - mn) + ex2(p1[r] - mn);
    l_c = l_c * ex2(m_c - mn) + sum; m_c = mn;
    ns_store(L, (ci + 1) & 1, kA, vA, tid);
    __syncthreads();
  };
  for (int ci = 0; ci < nct; ci += 2) { step1(ci, kr, vr, kr2, vr2); if (ci + 1 < nct) step1(ci + 1, kr2, vr2, kr, vr); }
  { const float mo = __shfl_xor(m_c, 32), lo = __shfl_xor(l_c, 32); const float mn = fmaxf(m_c, mo); l_c = l_c * ex2(m_c - mn) + lo * ex2(mo - mn); m_c = mn; }
  const float inv_lc = l_c > 0.f ? 1.f / l_c : 0.f;
  {
    f32x16 oc[2] = {};
    float carry = 0.f;
    LAS float* IMP = (LAS float*)(L + NS_IMP);
    ns_load(kr, vr, sc, 0, tid); ns_store(L, 0, kr, vr, tid); ns_load(kr, vr, sc, nct > 1 ? 64 : 0, tid); __syncthreads();
    auto step2 = [&](const int ci, u32x4& kA, u32x4& vA, u32x4& kB, u32x4& vB) {
      ns_load(kB, vB, sc, 64 * (ci + 2 < nct ? ci + 2 : nct - 1), tid);
      f32x16 p0, p1; ns_qk(p0, p1, L + NS_K + (ci & 1) * 8192, qf, r32, hi);
      if (t0 + 8 * w - 31 - 16 * (64 * ci + 63) >= 1513) {
        const float bm = ((const LAS float*)(L + NS_BIAS))[31 * 4 + hd] - m_c;
#pragma unroll
        for (int r = 0; r < 16; ++r) { p0[r] = ex2(p0[r] + bm) * inv_lc; p1[r] = ex2(p1[r] + bm) * inv_lc; }
      } else {
#pragma unroll
      for (int hf = 0; hf < 2; ++hf)
#pragma unroll
        for (int r = 0; r < 16; ++r) { const int n = 64 * ci + 32 * hf + crow(r, hi); const int dist = t - 16 * n - 31;
          const float s = (hf ? p1[r] : p0[r]) + ns_bias(L, hd, dist); const float p = dist >= 0 ? ex2(s - m_c) * inv_lc : 0.f; if (hf) p1[r] = p; else p0[r] = p; }
      }
      ns_pv(oc, L + NS_V + (ci & 1) * 8192, p0, p1, lane);
      float x[2][4];
#pragma unroll
      for (int rr = 0; rr < 4; ++rr) { x[0][rr] = __shfl_xor(p0[4 * rr + 3], 32); x[1][rr] = __shfl_xor(p1[4 * rr + 3], 32); }
#pragma unroll
      for (int hf = 0; hf < 2; ++hf)
#pragma unroll
        for (int rr = 0; rr < 4; ++rr) {
          const f32x16& pp = hf ? p1 : p0;
          float part = pp[4 * rr] + pp[4 * rr + 1] + pp[4 * rr + 2] + 0.5f * pp[4 * rr + 3];
          const float prev_lo = rr > 0 ? x[hf][rr > 0 ? rr - 1 : 0] : (hf ? x[0][3] : carry);
          const float cross = hi ? x[hf][rr] : prev_lo;
          part += 0.5f * cross;
          part += __shfl_xor(part, 1); part += __shfl_xor(part, 2);
          if (hd == 0) IMP[(8 * w + tokl) * IMP_P + 16 * ci + 8 * hf + 2 * rr + hi] = part;
        }
      carry = x[1][3];
      ns_store(L, (ci + 1) & 1, kA, vA, tid);
      __syncthreads();
    };
    for (int ci = 0; ci < nct; ci += 2) { step2(ci, kr, vr, kr2, vr2); if (ci + 1 < nct) step2(ci + 1, kr2, vr2, kr, vr); }
#pragma unroll
    for (int dt = 0; dt < 2; ++dt)
#pragma unroll
      for (int r = 0; r < 16; ++r) tot[dt][r] = gate[0] * oc[dt][r];
  }
  {
    const int tk = 8 * w + (lane >> 3), seg = lane & 7;
    unsigned m0 = 0, m1 = 0, m2 = 0, m3 = 0;
    auto setbit = [&](int j) { const unsigned bit = 1u << (j & 31); const int wd = j >> 5; m0 |= wd == 0 ? bit : 0u; m1 |= wd == 1 ? bit : 0u; m2 |= wd == 2 ? bit : 0u; m3 |= wd == 3 ? bit : 0u; };
    if (cur <= 15) { m0 = (2u << cur) - 1u; }
    else {
      const LAS float* IMP = (const LAS float*)(L + NS_IMP) + tk * IMP_P + 16 * seg;
      int top[16];
#pragma unroll
      for (int i = 0; i < 16; ++i) { const int j = 16 * seg + i; const int key = (int)((__float_as_uint(IMP[i]) & ~127u) | (unsigned)(127 - j)); top[i] = (j >= 1 && j <= cur - 2) ? key : -1; }
      sort16_desc(top);
#pragma unroll
      for (int o = 1; o < 8; o <<= 1) { int oth[16];
#pragma unroll
        for (int i = 0; i < 16; ++i) oth[i] = __shfl_xor(top[i], o);
        merge16_top(top, oth); }
      setbit(0); setbit(cur); setbit(cur - 1);
#pragma unroll
      for (int i = 0; i < 13; ++i) setbit(127 - (top[i] & 127));
    }
    if (seg == 0) *(LAS u32x4*)(L + NS_MASK + tk * 16) = (u32x4){m0, m1, m2, m3};
  }
  __syncthreads();
  const u32x4 mk = *(const LAS u32x4*)(L + NS_MASK + (8 * w + tokl) * 16);

  {
    TileSrc ss; ss.k = Z + (size_t)b * T * ZP + C_KS + g * 64; ss.v = Z + (size_t)b * T * ZP + C_VS + g * 64; ss.pitch = ZP;
    float m_s = -1e30f, l_s = 0.f; f32x16 os[2] = {};
    const int npair = (cur >> 1) + 1;
    auto selbit = [&](int j) -> bool { const unsigned wsel = (j >> 5) == 0 ? mk.x : ((j >> 5) == 1 ? mk.y : ((j >> 5) == 2 ? mk.z : mk.w)); return ((wsel >> (j & 31)) & 1u) != 0u; };
    auto bias_mask = [&](f32x16& p0, f32x16& p1, const int j, const bool sel) -> float {
      float mt = -1e30f;
      const int dmin = t0 + 8 * w - (64 * j + 63), dmax = t0 + 8 * w + 7 - 64 * j;
      if (dmin >= 246) {
        const int blo = *(const LAS unsigned char*)(L + NS_BUCK + dmin), bhi = *(const LAS unsigned char*)(L + NS_BUCK + dmax);
        float b_lo = ((const LAS float*)(L + NS_BIAS))[blo * 4 + hd], b_hi = ((const LAS float*)(L + NS_BIAS))[bhi * 4 + hd];
        b_lo = sel ? b_lo : -INFINITY; b_hi = sel ? b_hi : -INFINITY;
        if (blo == bhi) {
#pragma unroll
          for (int r = 0; r < 16; ++r) { p0[r] += b_lo; p1[r] += b_lo; mt = fmaxf(mt, fmaxf(p0[r], p1[r])); }
        } else {
          const int thr = ((const LAS int*)(L + NS_THR))[bhi]; const int db = t - 64 * j - 4 * hi;
#pragma unroll
          for (int r = 0; r < 16; ++r) { const int d0 = db - ((r & 3) + 8 * (r >> 2));
            p0[r] += (d0 >= thr) ? b_hi : b_lo; p1[r] += (d0 - 32 >= thr) ? b_hi : b_lo; mt = fmaxf(mt, fmaxf(p0[r], p1[r])); }
        }
      } else {
#pragma unroll
        for (int hf = 0; hf < 2; ++hf)
#pragma unroll
          for (int r = 0; r < 16; ++r) { const int dist = t - (64 * j + 32 * hf + crow(r, hi));
            float sv = (hf ? p1[r] : p0[r]) + ns_bias(L, hd, dist); sv = (sel && dist >= 0) ? sv : -INFINITY; if (hf) p1[r] = sv; else p0[r] = sv; mt = fmaxf(mt, sv); }
      }
      return mt;
    };
    auto new_max = [&](float mt) {
      mt = fmaxf(mt, __shfl_xor(mt, 32));
      if (__any(mt > m_s)) {
        const float mn = fmaxf(m_s, mt), al = ex2(m_s - mn); l_s *= al; m_s = mn;
#pragma unroll
        for (int dt = 0; dt < 2; ++dt)
#pragma unroll
          for (int r = 0; r < 16; ++r) os[dt][r] *= al;
      }
    };
    auto expsum = [&](f32x16& p0, f32x16& p1) { float sum = 0.f;
#pragma unroll
      for (int r = 0; r < 16; ++r) { p0[r] = ex2(p0[r] - m_s); p1[r] = ex2(p1[r] - m_s); sum += p0[r] + p1[r]; }
      l_s += sum; };
    auto kslot = [&](int pp, int idx) -> int { const int q = pp % 3; return (q == 2 ? NS_X3 : NS_K + q * 16384) + idx * 8192; };
    auto vslot = [&](int pp, int idx) -> int { const int q = pp % 3; return (q == 2 ? NS_X3 + 16384 : NS_V + q * 16384) + idx * 8192; };
    auto issue = [&](int pp) { const int ja = 2 * pp <= cur ? 2 * pp : cur, jb = 2 * pp + 1 <= cur ? 2 * pp + 1 : cur;
      ns_dma(L, kslot(pp, 0), vslot(pp, 0), ss, 64 * ja, lane, w); ns_dma(L, kslot(pp, 1), vslot(pp, 1), ss, 64 * jb, lane, w); };
    issue(0); issue(1);
    for (int pp = 0; pp < npair; ++pp) {
      const int ja = 2 * pp, jb = ja + 1;
      asm volatile("s_waitcnt vmcnt(4) ; NSA_SLC_WAIT" ::: "memory");
      __builtin_amdgcn_s_barrier();
      asm volatile("" ::: "memory");
      issue(pp + 2);
      const int ka = kslot(pp, 0), kb = kslot(pp, 1), va = vslot(pp, 0), vb = vslot(pp, 1);
      const bool sela = selbit(ja), selb = (jb <= cur) && selbit(jb);
      const bool needa = __any(sela), needb = __any(selb);
      if (needa && needb) {
        f32x16 pa0, pa1, pb0, pb1;
        ns_qk(pa0, pa1, L + ka, qf, r32, hi); ns_qk(pb0, pb1, L + kb, qf, r32, hi);
        const float mta = bias_mask(pa0, pa1, ja, sela), mtb = bias_mask(pb0, pb1, jb, selb);
        new_max(fmaxf(mta, mtb));
        expsum(pa0, pa1); ns_pv(os, L + va, pa0, pa1, lane);
        expsum(pb0, pb1); ns_pv(os, L + vb, pb0, pb1, lane);
      } else if (needa || needb) {
        const int j1 = needa ? ja : jb, k1 = needa ? ka : kb, v1 = needa ? va : vb; const bool sel1 = needa ? sela : selb;
        f32x16 p0, p1; ns_qk(p0, p1, L + k1, qf, r32, hi);
        new_max(bias_mask(p0, p1, j1, sel1));
        expsum(p0, p1); ns_pv(os, L + v1, p0, p1, lane);
      }
      asm volatile("s_waitcnt lgkmcnt(0)" ::: "memory");
    }
    asm volatile("s_waitcnt vmcnt(0)" ::: "memory");
    __syncthreads();
    l_s += __shfl_xor(l_s, 32);
    const float sc_ = gate[1] / l_s;
#pragma unroll
    for (int dt = 0; dt < 2; ++dt)
#pragma unroll
      for (int r = 0; r < 16; ++r) tot[dt][r] += EN_SLC * sc_ * os[dt][r];
  }
  {
    TileSrc sw; sw.k = Z + (size_t)b * T * ZP + C_KW + g * 64; sw.v = Z + (size_t)b * T * ZP + C_VW + g * 64; sw.pitch = ZP;
    const int j0 = cur >= 8 ? cur - 8 : 0;
    float m_w = -1e30f, l_w = 0.f; f32x16 ow[2] = {};
    ns_load(kr, vr, sw, 64 * j0, tid); ns_store(L, 0, kr, vr, tid); ns_load(kr, vr, sw, 64 * (j0 < cur ? j0 + 1 : j0), tid); __syncthreads();
    auto step = [&](const int j, u32x4& kA, u32x4& vA, u32x4& kB, u32x4& vB) {
      const int bi = (j - j0) & 1;
      ns_load(kB, vB, sw, 64 * (j + 2 <= cur ? j + 2 : cur), tid);
      f32x16 p0, p1; ns_qk(p0, p1, L + NS_K + bi * 8192, qf, r32, hi);
      float mt = -1e30f;
      { const LAS float* WB = (const LAS float*)(L + NS_WB) + hd * 577; const int db = t - 64 * j - 4 * hi;
#pragma unroll
        for (int r = 0; r < 16; ++r) { const unsigned d0 = (unsigned)(db - ((r & 3) + 8 * (r >> 2))), d1 = d0 - 32u;
          const float s0 = p0[r] + WB[d0 < 575u ? d0 : 575u], s1 = p1[r] + WB[d1 < 575u ? d1 : 575u];
          p0[r] = d0 < 512u ? s0 : -INFINITY; p1[r] = d1 < 512u ? s1 : -INFINITY; mt = fmaxf(mt, fmaxf(p0[r], p1[r])); } }
      mt = fmaxf(mt, __shfl_xor(mt, 32));
      if (__any(mt > m_w)) {
        const float mn = fmaxf(m_w, mt), al = ex2(m_w - mn); l_w *= al; m_w = mn;
#pragma unroll
        for (int dt = 0; dt < 2; ++dt)
#pragma unroll
          for (int r = 0; r < 16; ++r) ow[dt][r] *= al;
      }
      { float sum = 0.f;
#pragma unroll
        for (int r = 0; r < 16; ++r) { p0[r] = ex2(p0[r] - m_w); p1[r] = ex2(p1[r] - m_w); sum += p0[r] + p1[r]; }
        l_w += sum; }
      ns_pv(ow, L + NS_V + bi * 8192, p0, p1, lane);
      ns_store(L, bi ^ 1, kA, vA, tid);
      __syncthreads();
    };
    for (int j = j0; j <= cur; j += 2) { step(j, kr, vr, kr2, vr2); if (j + 1 <= cur) step(j + 1, kr2, vr2, kr, vr); }
    l_w += __shfl_xor(l_w, 32);
    const float sc_ = gate[2] / l_w;
#pragma unroll
    for (int dt = 0; dt < 2; ++dt)
#pragma unroll
      for (int r = 0; r < 16; ++r) tot[dt][r] += EN_WIN * sc_ * ow[dt][r];
  }
  bf16_t* dst = (bf16_t*)(F.ws + WS_OCAT) + mrow * DM + 512 + head * 64;
#pragma unroll
  for (int dt = 0; dt < 2; ++dt)
#pragma unroll
    for (int rr = 0; rr < 4; ++rr) { u32x2 wv; wv.x = cvtpk(tot[dt][4 * rr], tot[dt][4 * rr + 1]); wv.y = cvtpk(tot[dt][4 * rr + 2], tot[dt][4 * rr + 3]); *(u32x2*)(dst + 32 * dt + 8 * rr + 4 * hi) = wv; }
}

DI int ordkey(float f) { const int s = __builtin_bit_cast(int, f); return s ^ ((s >> 31) & 0x7fffffff); }
DI float unordkey(int k) { const int s = k ^ ((k >> 31) & 0x7fffffff); return __builtin_bit_cast(float, s); }
DI void ins16(int (&top)[16], int v) {
#pragma unroll
  for (int i = 0; i < 16; ++i) { const int h = max(top[i], v); v = min(top[i], v); top[i] = h; }
}
DI void merge_pair(int (&a)[16]) {
  int c[16];
#pragma unroll
  for (int i = 0; i < 16; ++i) c[i] = max(a[i], __shfl_xor(a[15 - i], 32));
#pragma unroll
  for (int st = 8; st >= 1; st >>= 1)
#pragma unroll
    for (int i = 0; i < 16; ++i) if ((i & st) == 0) { const int x = c[i], y = c[i + st]; c[i] = max(x, y); c[i + st] = min(x, y); }
#pragma unroll
  for (int i = 0; i < 16; ++i) a[i] = c[i];
}
DI void peer_key_tile(int (&g)[16], const bf16_t* SKhp, const bf16x8 (&qf)[4], int kt, int r32, int hi) {
  f32x16 acc = {};
#pragma unroll
  for (int ks = 0; ks < 4; ++ks) { const bf16x8 a = *(const bf16x8*)(SKhp + (size_t)(32 * kt + r32) * 64 + 16 * ks + 8 * hi); acc = MFMA32(a, qf[ks], acc); }
#pragma unroll
  for (int r = 0; r < 16; ++r) { const int kidx = 32 * kt + crow(r, hi); g[r] = (ordkey(acc[r]) & ~127) | (127 - kidx); }
  sort16_desc(g);
}
DI void peer_half_topk(int (&lst)[16], const bf16_t* SKhp, const bf16_t* qrow, int r32, int hi) {
  bf16x8 qf[4];
#pragma unroll
  for (int ks = 0; ks < 4; ++ks) qf[ks] = *(const bf16x8*)(qrow + 16 * ks + 8 * hi);
  int g1[16];
  peer_key_tile(lst, SKhp, qf, 0, r32, hi); peer_key_tile(g1, SKhp, qf, 1, r32, hi); merge16_top(lst, g1);
  { int g2[16]; peer_key_tile(g1, SKhp, qf, 2, r32, hi); peer_key_tile(g2, SKhp, qf, 3, r32, hi); merge16_top(g1, g2); }
  merge16_top(lst, g1);
  merge_pair(lst);
}
constexpr int PS_IDX = 0;
DI void peer_select_unit(const Ctx& F0, const int u) {
  const Ctx F = fresh(F0);
  const int lane = F.lane, w = F.wave, r32 = lane & 31, hi = lane >> 5;
  const int tok = (u >> 1) * 256 + 32 * w + r32, hg = u & 1;
  const bf16_t* QP = (const bf16_t*)(F.ws + WS_QP) + (size_t)tok * DM;
  const bf16_t* SK = (const bf16_t*)(F.ws + WS_SK);
  LAS unsigned char* IDX = F.lds + PS_IDX + F.tid * 32;
  unsigned short* EI = (unsigned short*)(F.ws + WS_EIDX) + (size_t)tok * 128; float* GT = (float*)(F.ws + WS_GATE) + (size_t)tok * 128;
  __syncthreads();
  for (int pair = 0; pair < 2; ++pair) {
    const int hA = 4 * hg + 2 * pair;
    int l00[16], l01[16], l10[16], l11[16];
    peer_half_topk(l00, SK + (size_t)((hA * 2 + 0) * 128) * 64, QP + hA * 128, r32, hi);
    peer_half_topk(l01, SK + (size_t)((hA * 2 + 1) * 128) * 64, QP + hA * 128 + 64, r32, hi);
    peer_half_topk(l10, SK + (size_t)(((hA + 1) * 2 + 0) * 128) * 64, QP + (hA + 1) * 128, r32, hi);
    peer_half_topk(l11, SK + (size_t)(((hA + 1) * 2 + 1) * 128) * 64, QP + (hA + 1) * 128 + 64, r32, hi);
    const int hsel = hA + hi;
    float fa[16], fb[16];
#pragma unroll
    for (int i = 0; i < 16; ++i) { const int ka = hi ? l10[i] : l00[i], kb = hi ? l11[i] : l01[i];
      fa[i] = unordkey(ka & ~127); fb[i] = unordkey(kb & ~127); IDX[i] = (unsigned char)(127 - (ka & 127)); IDX[16 + i] = (unsigned char)(127 - (kb & 127)); }
    auto cand = [&](int i, int j) -> int { return (ordkey(fa[i] + fb[j]) & ~255) | (255 - (i * 16 + j)); };
    const int NEG = (int)0x80000000;
    int top[16], c1[16];
#pragma unroll
    for (int j = 0; j < 16; ++j) top[j] = cand(0, j);
    { int k = 0;
#pragma unroll
      for (int j = 0; j < 8; ++j) c1[k++] = cand(1, j);
#pragma unroll
      for (int j = 0; j < 5; ++j) c1[k++] = cand(2, j);
      c1[13] = NEG; c1[14] = NEG; c1[15] = NEG; }
    sort16_desc(c1); merge16_top(top, c1);
    c1[0] = cand(3, 0); c1[1] = cand(3, 1); c1[2] = cand(3, 2); c1[3] = cand(3, 3); c1[4] = cand(4, 0); c1[5] = cand(4, 1); c1[6] = cand(4, 2);
    c1[7] = cand(5, 0); c1[8] = cand(5, 1); c1[9] = cand(6, 0); c1[10] = cand(6, 1); c1[11] = cand(7, 0); c1[12] = cand(7, 1); c1[13] = NEG; c1[14] = NEG; c1[15] = NEG;
    sort16_desc(c1); merge16_top(top, c1);
#pragma unroll
    for (int i = 0; i < 8; ++i) { c1[i] = cand(8 + i, 0); c1[8 + i] = NEG; }
    merge16_top(top, c1);
    float sc[16]; float mx = -INFINITY;
#pragma unroll
    for (int k = 0; k < 16; ++k) { sc[k] = unordkey(top[k] & ~255); mx = fmaxf(mx, sc[k]); }
    float sum = 0.f;
#pragma unroll
    for (int k = 0; k < 16; ++k) { sc[k] = __expf(sc[k] - mx); sum += sc[k]; }
    const float inv = 1.f / sum;
    asm volatile("s_waitcnt lgkmcnt(0)" ::: "memory");
#pragma unroll
    for (int k = 0; k < 16; ++k) { const int cid = 255 - (top[k] & 255); const int e = (int)IDX[cid >> 4] * 128 + (int)IDX[16 + (cid & 15)];
      EI[hsel * 16 + k] = (unsigned short)e; GT[hsel * 16 + k] = sc[k] * inv; }
  }
}

DI void fp8x16_to_f32(const u32x4& w, float (&f)[16]) {
#pragma unroll
  for (int q = 0; q < 4; ++q) { const f32x2 lo = __builtin_amdgcn_cvt_pk_f32_fp8((int)w[q], false), hi = __builtin_amdgcn_cvt_pk_f32_fp8((int)w[q], true); f[4 * q] = lo.x; f[4 * q + 1] = lo.y; f[4 * q + 2] = hi.x; f[4 * q + 3] = hi.y; }
}
DI void treduce16(const float (&v)[16], int sel, int s, float (&w2)[2]) {
  float w8[8], w4[4];
  { const bool up = (sel & 4) != 0;
#pragma unroll
    for (int i = 0; i < 8; ++i) { const float keep = up ? v[i + 8] : v[i], send = up ? v[i] : v[i + 8]; w8[i] = keep + __shfl_xor(send, 4 * s); } }
  { const bool up = (sel & 2) != 0;
#pragma unroll
    for (int i = 0; i < 4; ++i) { const float keep = up ? w8[i + 4] : w8[i], send = up ? w8[i] : w8[i + 4]; w4[i] = keep + __shfl_xor(send, 2 * s); } }
  { const bool up = (sel & 1) != 0;
#pragma unroll
    for (int i = 0; i < 2; ++i) { const float keep = up ? w4[i + 2] : w4[i], send = up ? w4[i] : w4[i + 2]; w2[i] = keep + __shfl_xor(send, s); } }
}
struct PeerIds { unsigned ep[8]; };
struct PeerRows { u32x4 d[16]; unsigned ap[8]; u32x4 xa, xb; unsigned h; };
DI void peer_load_ids(const Ctx& F, int tok, int g, PeerIds& I) {
  const unsigned short* EI = (const unsigned short*)(F.ws + WS_EIDX) + (size_t)tok * 128 + 16 * g;
  const u32x4 a = *(const u32x4*)EI, b = *(const u32x4*)(EI + 8); I.ep[0] = a.x; I.ep[1] = a.y; I.ep[2] = a.z; I.ep[3] = a.w; I.ep[4] = b.x; I.ep[5] = b.y; I.ep[6] = b.z; I.ep[7] = b.w;
}
DI unsigned peer_eid(const PeerIds& I, int i) { return (i & 1) ? (I.ep[i >> 1] >> 16) : (I.ep[i >> 1] & 0xffffu); }
DI float peer_act(const PeerRows& R, int i) { return (i & 1) ? bfhi(R.ap[i >> 1]) : bflo(R.ap[i >> 1]); }
template <int PASS> DI void peer_load_rows(const Ctx& F, const unsigned char* TB, unsigned lo, int slice, int tok, int g, int c, const PeerIds& I, PeerRows& R) {
#pragma unroll
  for (int i = 0; i < 16; ++i) R.d[i] = *(const u32x4*)(TB + ((peer_eid(I, i) << 7) | lo));
  if (PASS == 0) { const bf16_t* xn = (const bf16_t*)(F.ws + WS_HN) + (size_t)tok * DM + 128 * slice + 16 * c; R.xa = *(const u32x4*)xn; R.xb = *(const u32x4*)(xn + 8); }
  else { const bf16_t* AC = (const bf16_t*)(F.ws + WS_ACTH) + (size_t)tok * 128 + 16 * g;
    const u32x4 a = *(const u32x4*)AC, b = *(const u32x4*)(AC + 8); R.ap[0] = a.x; R.ap[1] = a.y; R.ap[2] = a.z; R.ap[3] = a.w; R.ap[4] = b.x; R.ap[5] = b.y; R.ap[6] = b.z; R.ap[7] = b.w;
    R.h = *(const unsigned*)((const bf16_t*)(F.ws + WS_HN) + (size_t)tok * DM + 128 * slice + 16 * c + 2 * g); }
}
template <int PASS> DI void peer_compute(const Ctx& F, int slice, int tok, int g, int c, const PeerRows& R) {
  float acc[16]; float w2[2];
  if (PASS == 0) {
    float x[16];
    { const unsigned xw[8] = {R.xa.x, R.xa.y, R.xa.z, R.xa.w, R.xb.x, R.xb.y, R.xb.z, R.xb.w};
#pragma unroll
      for (int q = 0; q < 8; ++q) { x[2 * q] = bflo(xw[q]); x[2 * q + 1] = bfhi(xw[q]); } }
    float dep = 0.f;
#pragma unroll
    for (int i = 0; i < 16; ++i) { u32x4 w = R.d[i]; asm volatile("" : "+v"(w.x), "+v"(w.y), "+v"(w.z), "+v"(w.w) : "v"(dep));
      float f[16]; fp8x16_to_f32(w, f); float a = 0.f, b = 0.f;
#pragma unroll
      for (int j = 0; j < 8; ++j) { a += f[2 * j] * x[2 * j]; b += f[2 * j + 1] * x[2 * j + 1]; }
      acc[i] = a + b; dep = acc[i]; }
    treduce16(acc, c, 1, w2);
    *(f32x2*)((float*)(F.ws + WS_PART) + ((size_t)slice * NTOK + tok) * 128 + 16 * g + 2 * c) = (f32x2){w2[0], w2[1]};
  } else {
#pragma unroll
    for (int j = 0; j < 16; ++j) acc[j] = 0.f;
#pragma unroll
    for (int i = 0; i < 16; ++i) { u32x4 w = R.d[i]; asm volatile("" : "+v"(w.x), "+v"(w.y), "+v"(w.z), "+v"(w.w) : "v"(acc[15]));
      float f[16]; fp8x16_to_f32(w, f);
      const float ai = peer_act(R, i);
#pragma unroll
      for (int j = 0; j < 16; ++j) acc[j] += ai * f[j]; }
    treduce16(acc, g, 8, w2);
    *(unsigned*)((bf16_t*)(F.ws + WS_HN) + (size_t)tok * DM + 128 * slice + 16 * c + 2 * g) = cvtpk(bflo(R.h) + w2[0], bfhi(R.h) + w2[1]);
  }
}
constexpr int PEER_NBIG = (NTOK * 3 / 4) / 32, PEER_NSMALL = (NTOK / 4) / 8;
template <int PASS>
DI void peer_sliced_pass(const Ctx& F0, unsigned* cnt) {
  const Ctx F = fresh(F0);
  const int lane = F.lane, g = lane >> 3, c = lane & 7;
  const unsigned xcc = (unsigned)__builtin_amdgcn_s_getreg((3 << 11) | 20) & 7u;
  for (int s = 0; s < 8; ++s) {
    const int slice = (int)((xcc + (unsigned)s) & 7u);
    const unsigned char* TB = F.ws + (PASS == 0 ? WS_PDOWN8 : WS_PUP8) + (size_t)slice * 16384 * 128; const unsigned lo = (unsigned)(16 * c);
    for (;;) {
      unsigned ch = 0;
      if (lane == 0) ch = atomicAdd(cnt + 64 * slice, 1u);
      const int chunk = __builtin_amdgcn_readfirstlane((int)ch);
      if (chunk >= PEER_NBIG + PEER_NSMALL) break;
      const int tok0 = chunk < PEER_NBIG ? chunk * 32 : PEER_NBIG * 32 + (chunk - PEER_NBIG) * 8;
      const int nch = chunk < PEER_NBIG ? 32 : 8;
      PeerIds E0, E1; PeerRows RA, RB;
      peer_load_ids(F, tok0, g, E0);
      peer_load_ids(F, tok0 + 1, g, E1);
      peer_load_rows<PASS>(F, TB, lo, slice, tok0, g, c, E0, RA);
#pragma unroll 1
      for (int i = 0; i < nch; i += 2) {
        const int t0 = tok0 + i, t1 = t0 + 1, t2 = (i + 2 < nch) ? t0 + 2 : t0, t3 = (i + 3 < nch) ? t0 + 3 : t1;
        peer_load_rows<PASS>(F, TB, lo, slice, t1, g, c, E1, RB);
        peer_load_ids(F, t2, g, E0);
        peer_compute<PASS>(F, slice, t0, g, c, RA);
        peer_load_rows<PASS>(F, TB, lo, slice, t2, g, c, E0, RA);
        peer_load_ids(F, t3, g, E1);
        peer_compute<PASS>(F, slice, t1, g, c, RB);
      }
    }
  }
}
DI void peer_computeA_lds(LAS float* part_row, int g, int c, const PeerRows& R) {
  float acc[16]; float w2[2]; float x[16];
  { const unsigned xw[8] = {R.xa.x, R.xa.y, R.xa.z, R.xa.w, R.xb.x, R.xb.y, R.xb.z, R.xb.w};
#pragma unroll
    for (int q = 0; q < 8; ++q) { x[2 * q] = bflo(xw[q]); x[2 * q + 1] = bfhi(xw[q]); } }
  float dep = 0.f;
#pragma unroll
  for (int i = 0; i < 16; ++i) { u32x4 w = R.d[i]; asm volatile("" : "+v"(w.x), "+v"(w.y), "+v"(w.z), "+v"(w.w) : "v"(dep));
    float f[16]; fp8x16_to_f32(w, f); float a = 0.f, b = 0.f;
#pragma unroll
    for (int j = 0; j < 8; ++j) { a += f[2 * j] * x[2 * j]; b += f[2 * j + 1] * x[2 * j + 1]; }
    acc[i] = a + b; dep = acc[i]; }
  treduce16(acc, c, 1, w2);
  LAS f32x2* pp = (LAS f32x2*)(part_row + 16 * g + 2 * c);
  const f32x2 o = *pp; *pp = (f32x2){o.x + w2[0], o.y + w2[1]};
}
DI void peer_load_rowsC_lds(const Ctx& F, const unsigned char* TB, unsigned lo, int slice, int tok, const LAS unsigned* act_row, int g, int c, const PeerIds& I, PeerRows& R) {
#pragma unroll
  for (int i = 0; i < 16; ++i) R.d[i] = *(const u32x4*)(TB + ((peer_eid(I, i) << 7) | lo));
#pragma unroll
  for (int k = 0; k < 8; ++k) R.ap[k] = act_row[8 * g + k];
  R.h = *(const unsigned*)((const bf16_t*)(F.ws + WS_HN) + (size_t)tok * DM + 128 * slice + 16 * c + 2 * g);
}
DI void final_norm_token(const Ctx& F, const int tok);
DI void peer_fused_phase(const Ctx& F0) {
  const Ctx F = fresh(F0);
  const int lane = F.lane, g = lane >> 3, c = lane & 7, w = F.wave;
  const unsigned xcc = (unsigned)__builtin_amdgcn_s_getreg((3 << 11) | 20) & 7u;
  LAS float* PARTS = (LAS float*)(F.lds + w * 8192);
  LAS unsigned* ACTS = (LAS unsigned*)(F.lds + 65536 + w * 4096);
  const unsigned lo = (unsigned)(16 * c);
  __syncthreads();
#pragma unroll 1
  for (int grp = F.gw; grp < NTOK / 16; grp += F.NGW) {
    const int tok0 = grp * 16;
#pragma unroll
    for (int i = 0; i < 32; ++i) PARTS[i * 64 + lane] = 0.f;
    {
      auto tbl = [&](int q) -> const unsigned char* { return F.ws + WS_PDOWN8 + (size_t)((xcc + (unsigned)(q >> 4)) & 7u) * 16384 * 128; };
      auto slc = [&](int q) -> int { return (int)((xcc + (unsigned)(q >> 4)) & 7u); };
      PeerIds E0, E1; PeerRows RA, RB;
      peer_load_ids(F, tok0, g, E0); peer_load_ids(F, tok0 + 1, g, E1);
      peer_load_rows<0>(F, tbl(0), lo, slc(0), tok0, g, c, E0, RA);
#pragma unroll 1
      for (int q = 0; q < 128; q += 2) {
        const int q2 = q + 2 < 128 ? q + 2 : q, q3 = q + 3 < 128 ? q + 3 : q + 1;
        peer_load_rows<0>(F, tbl(q + 1), lo, slc(q + 1), tok0 + ((q + 1) & 15), g, c, E1, RB);
        peer_load_ids(F, tok0 + (q2 & 15), g, E0);
        peer_computeA_lds(PARTS + (q & 15) * 128, g, c, RA);
        peer_load_rows<0>(F, tbl(q2), lo, slc(q2), tok0 + (q2 & 15), g, c, E0, RA);
        peer_load_ids(F, tok0 + (q3 & 15), g, E1);
        peer_computeA_lds(PARTS + ((q + 1) & 15) * 128, g, c, RB);
      }
    }
    {
      const float* DSC = (const float*)(F.ws + WS_DSC); const float* USC = (const float*)(F.ws + WS_USC);
#pragma unroll 1
      for (int ti = 0; ti < 16; ++ti) { const int tok = tok0 + ti; const int p0 = 16 * g + 2 * c;
        const unsigned ee = *(const unsigned*)((const unsigned short*)(F.ws + WS_EIDX) + (size_t)tok * 128 + p0); const unsigned e0 = ee & 0xffffu, e1 = ee >> 16;
        const f32x2 gt = *(const f32x2*)((const float*)(F.ws + WS_GATE) + (size_t)tok * 128 + p0);
        const f32x2 sd = *(const LAS f32x2*)(PARTS + ti * 128 + p0);
        const float rs = pg8::row_rstd((const float*)(F.ws + WS_SSP), tok);
        ACTS[ti * 64 + 8 * g + c] = cvtpk(gelu_tanh(sd.x * rs * DSC[e0]) * gt.x * USC[e0], gelu_tanh(sd.y * rs * DSC[e1]) * gt.y * USC[e1]); }
    }
    {
      auto tbl = [&](int q) -> const unsigned char* { return F.ws + WS_PUP8 + (size_t)((xcc + (unsigned)(q >> 4)) & 7u) * 16384 * 128; };
      auto slc = [&](int q) -> int { return (int)((xcc + (unsigned)(q >> 4)) & 7u); };
      PeerIds E0, E1; PeerRows RA, RB;
      peer_load_ids(F, tok0, g, E0); peer_load_ids(F, tok0 + 1, g, E1);
      peer_load_rowsC_lds(F, tbl(0), lo, slc(0), tok0, ACTS, g, c, E0, RA);
#pragma unroll 1
      for (int q = 0; q < 128; q += 2) {
        const int q2 = q + 2 < 128 ? q + 2 : q, q3 = q + 3 < 128 ? q + 3 : q + 1;
        peer_load_rowsC_lds(F, tbl(q + 1), lo, slc(q + 1), tok0 + ((q + 1) & 15), ACTS + ((q + 1) & 15) * 64, g, c, E1, RB);
        peer_load_ids(F, tok0 + (q2 & 15), g, E0);
        peer_compute<1>(F, slc(q), tok0 + (q & 15), g, c, RA);
        peer_load_rowsC_lds(F, tbl(q2), lo, slc(q2), tok0 + (q2 & 15), ACTS + (q2 & 15) * 64, g, c, E0, RA);
        peer_load_ids(F, tok0 + (q3 & 15), g, E1);
        peer_compute<1>(F, slc(q + 1), tok0 + ((q + 1) & 15), g, c, RB);
      }
    }
    asm volatile("s_waitcnt vmcnt(0)" ::: "memory");
    __builtin_amdgcn_fence(__ATOMIC_ACQUIRE, "agent");
#pragma unroll 1
    for (int ti = 0; ti < 16; ++ti) final_norm_token(F, tok0 + ti);
  }
}
DI void peer_act_pass(const Ctx& F0) {
  const Ctx F = fresh(F0);
  const float* PT = (const float*)(F.ws + WS_PART); const u32x2* EI = (const u32x2*)(F.ws + WS_EIDX); const f32x4* GT = (const f32x4*)(F.ws + WS_GATE);
  const float* DSC = (const float*)(F.ws + WS_DSC); const float* USC = (const float*)(F.ws + WS_USC); u32x2* AH = (u32x2*)(F.ws + WS_ACTH);
  for (size_t i = (size_t)blockIdx.x * NTHREADS + F.tid; i < (size_t)NTOK * 32; i += (size_t)F.G * NTHREADS) {
    f32x4 s = {0.f, 0.f, 0.f, 0.f};
#pragma unroll
    for (int x = 0; x < 8; ++x) s += *(const f32x4*)(PT + (size_t)x * NTOK * 128 + 4 * i);
    const u32x2 ee = EI[i]; const unsigned e0 = ee.x & 0xffffu, e1 = ee.x >> 16, e2 = ee.y & 0xffffu, e3 = ee.y >> 16; const f32x4 gt = GT[i];
    const float rs = pg8::row_rstd((const float*)(F.ws + WS_SSP), (int)(i >> 5));
    u32x2 o; o.x = cvtpk(gelu_tanh(s.x * rs * DSC[e0]) * gt.x * USC[e0], gelu_tanh(s.y * rs * DSC[e1]) * gt.y * USC[e1]);
    o.y = cvtpk(gelu_tanh(s.z * rs * DSC[e2]) * gt.z * USC[e2], gelu_tanh(s.w * rs * DSC[e3]) * gt.w * USC[e3]);
    AH[i] = o;
  }
}
DI void renorm_pass(const Ctx& F0, const float* g) {
  const Ctx F = fresh(F0);
#pragma unroll 1
  for (int m = F.gw; m < NTOK; m += F.NGW) rms_row_bf16(F.H + (size_t)m * DM, g, (bf16_t*)(F.ws + WS_HN) + (size_t)m * DM, F.lane);
}
DI void final_norm_token(const Ctx& F, const int tok) {
  const int lane = F.lane; const bf16_t* hrow = (const bf16_t*)(F.ws + WS_HN) + (size_t)tok * DM; float* orow = F.H + (size_t)tok * DM; const float* gf = F.in[I_NFIN];
  f32x4 v[4]; float ss = 0.f;
#pragma unroll
  for (int j = 0; j < 4; ++j) { const u32x2 hb = ((const u32x2*)hrow)[lane + 64 * j]; v[j] = (f32x4){bflo(hb.x), bfhi(hb.x), bflo(hb.y), bfhi(hb.y)}; ss += v[j].x * v[j].x + v[j].y * v[j].y + v[j].z * v[j].z + v[j].w * v[j].w; }
  const float r = rsqrtf(wave_sum(ss) * (1.f / DM) + EPS);
#pragma unroll
  for (int j = 0; j < 4; ++j) ((f32x4*)orow)[lane + 64 * j] = v[j] * r * ((const f32x4*)gf)[lane + 64 * j];
}

#define XB_TMO      128
#define XB_XCNT(j)  (256  + 64 * (j))
#define XB_XSUB(j)  (1280 + 64 * (j))
#define XB_XGEN(j)  (2304 + 64 * (j))
#define XB_TOP      3328
#define XB_TOPGEN   3392
#define XCD_BAR_WORDS 3456
#define XB_SPIN_CAP (1u << 22)
DI unsigned xb_ld(unsigned* p)              { return __hip_atomic_load(p, __ATOMIC_RELAXED, __HIP_MEMORY_SCOPE_AGENT); }
DI unsigned xb_add(unsigned* p, unsigned v) { return __hip_atomic_fetch_add(p, v, __ATOMIC_RELAXED, __HIP_MEMORY_SCOPE_AGENT); }
DI unsigned xb_xcc_id() { return (unsigned)__builtin_amdgcn_s_getreg((3 << 11) | 20) & 0xFu; }
#define XB_SPIN(cond, bar) do { unsigned _sp = 0; while (cond) { __builtin_amdgcn_s_sleep(1); \
    if ((++_sp & 255u) == 0u) { if (xb_ld(&(bar)[XB_TMO])) break; if (_sp > XB_SPIN_CAP) { atomicAdd(&(bar)[XB_TMO], 1u); break; } } } } while (0)
struct XcdBarrier { unsigned* bar; unsigned x; volatile LAS unsigned* st; };
DI XcdBarrier xcd_barrier_post(unsigned* bar, volatile LAS unsigned* st) {
  XcdBarrier b; b.bar = bar; b.x = xb_xcc_id(); b.st = st;
  if (threadIdx.x == 0) (void)xb_add(&bar[XB_XCNT(b.x)], 1u);
  return b;
}
DI void xcd_barrier_complete(unsigned* bar, unsigned x, unsigned& nloc, unsigned& nx) {
  const unsigned G = gridDim.x * gridDim.y * gridDim.z;
  unsigned sum, cnt, mine, sp = 0u;
  for (;;) {
    sum = 0u; cnt = 0u; mine = 0u;
#pragma unroll
    for (unsigned j = 0; j < 16; ++j) { const unsigned c = xb_ld(&bar[XB_XCNT(j)]); sum += c; cnt += (c > 0u) ? 1u : 0u; mine = (j == x) ? c : mine; }
    if (sum == G) break;
    __builtin_amdgcn_s_sleep(1);
    if ((++sp & 255u) == 0u) { if (xb_ld(&bar[XB_TMO])) break; if (sp > XB_SPIN_CAP) { atomicAdd(&bar[XB_TMO], 1u); break; } }
  }
  nloc = mine > 0u ? mine : 1u; nx = cnt > 0u ? cnt : 1u;
}
DI void xcd_barrier(const XcdBarrier& b) {
  asm volatile("s_waitcnt vmcnt(0)" ::: "memory");
  __syncthreads();
  if (threadIdx.x == 0) {
    unsigned* bar = b.bar;
    __builtin_amdgcn_s_waitcnt(0);
    unsigned nloc = b.st[0], nx = b.st[1];
    if (nloc == 0u) { xcd_barrier_complete(bar, b.x, nloc, nx); b.st[0] = nloc; b.st[1] = nx; }
    const unsigned old = xb_add(&bar[XB_XSUB(b.x)], 1u);
    const unsigned gen = old / nloc;
    if (old + 1u == (gen + 1u) * nloc) {
      __builtin_amdgcn_fence(__ATOMIC_RELEASE, "agent");
      asm volatile("s_waitcnt vmcnt(0)" ::: "memory");
      const unsigned og = xb_add(&bar[XB_TOP], 1u);
      const unsigned tg = og / nx;
      if (og + 1u == (tg + 1u) * nx) xb_add(&bar[XB_TOPGEN], 1u);
      else XB_SPIN(xb_ld(&bar[XB_TOPGEN]) == tg, bar);
      __builtin_amdgcn_fence(__ATOMIC_ACQUIRE, "agent");
      xb_add(&bar[XB_XGEN(b.x)], 1u);
      asm volatile("s_waitcnt vmcnt(0)" ::: "memory");
    } else {
      XB_SPIN(xb_ld(&bar[XB_XGEN(b.x)]) == gen, bar);
      __builtin_amdgcn_fence(__ATOMIC_ACQUIRE, "agent");
      asm volatile("s_waitcnt vmcnt(0)" ::: "memory");
    }
  }
  __syncthreads();
}
constexpr int CW_BAR = 4096, CW_QA = 16384, CW_QC = 16384 + 1024, CW_QN = 16384 + 2048;

__global__ void __launch_bounds__(NTHREADS, 2) mega(Params p) {
  extern __shared__ __attribute__((aligned(16))) unsigned char lds_raw[];
  cg::grid_group grid = cg::this_grid();
  Ctx F;
  F.lds = (LAS unsigned char*)lds_raw;
  F.tid = threadIdx.x; F.lane = F.tid & 63; F.wave = __builtin_amdgcn_readfirstlane(F.tid >> 6);
  F.G = gridDim.x; F.gw = blockIdx.x * NWAVES + F.wave; F.NGW = F.G * NWAVES;
  F.in = p.in; F.H = p.out; F.ws = p.ws;
  unsigned char* ws = p.ws;
  const int bx = blockIdx.x;
  if (F.tid < 8) ((LAS unsigned*)(F.lds + LDSCTL_OFF))[F.tid] = 0u;
  __syncthreads();
  const XcdBarrier bar = xcd_barrier_post((unsigned*)(ws + WS_CTL) + CW_BAR, (volatile LAS unsigned*)(F.lds + LDSCTL_OFF));
#define GRID_BAR() xcd_barrier(bar)

  prologue(F);
  if (p.pad0 == 0x5eed) grid.sync();
  GRID_BAR();
  {
    pg8::PlainOrder S; S.init(ws + WS_HN, ws + WS_WIN, NTOK, ZP, DM, DM, F.G, bx);
    pg8::EpiBf16 E{(bf16_t*)(ws + WS_Z), ZP, 0};
    pg8::gemm_phase(F.lds, DM, DM, DM, S, E);
  }
  GRID_BAR();
  gla_phase<0>(F);
#if EN_NSA
  for (int cu = (bx + 128) % F.G; cu < 256; cu += F.G) nsa_compress_unit(F, cu);
#endif
  GRID_BAR();
  gla_scan(F);
#if EN_XATTN
  {
    pg8::MemProjOrder S{(const char*)(ws + WS_MEMN), (const char*)(ws + WS_XWK), (const char*)(ws + WS_XWV), F.G, (bx + 192) % F.G};
    pg8::EpiBf16 E{(bf16_t*)(ws + WS_KX), DM, 0};
    pg8::gemm_phase(F.lds, DM, DM, DM, S, E);
  }
#endif
#if EN_NSA
  {
    unsigned* qn = (unsigned*)(ws + WS_CTL) + CW_QN;
    volatile LAS int* slot = (volatile LAS int*)(F.lds + LDSCTL_OFF + 16);
    const unsigned xcc = xb_xcc_id() & 7u;
    for (int s8 = 0; s8 < 8; ++s8) {
      const int bg = (int)((xcc + (unsigned)s8) & 7u);
      for (;;) {
        __syncthreads();
        if (F.tid == 0) *slot = (int)atomicAdd(qn + 64 * bg, 1u);
        __syncthreads();
        const int u = *slot;
        if (u >= 128) break;
        nsa_unit(F, bg, 127 - u);
      }
    }
  }
#else
  for (int m = F.gw; m < NTOK; m += F.NGW) { u32x4* o = (u32x4*)((bf16_t*)(ws + WS_OCAT) + (size_t)m * DM + 512) + F.lane; *o = (u32x4){0, 0, 0, 0}; }
#endif
  GRID_BAR();
#if EN_XATTN
  {
    pg8::FoldOrder S{(const char*)(ws + WS_KX), (const char*)(ws + WS_XWQ), (const char*)(ws + WS_XWO), (const char*)(ws + WS_VXT), F.G, bx};
    pg8::EpiBf16 E{(bf16_t*)(ws + WS_MT), DM, 0};
    pg8::gemm_phase(F.lds, 256, DM, DM, S, E);
  }
#endif
  gla_phase<1>(F);
  GRID_BAR();
  {
    pg8::PlainOrder S; S.init(ws + WS_OCAT, ws + WS_WOUT, NTOK, DM, DM, DM, F.G, bx);
    pg8::EpiRes E{p.in[I_X], (bf16_t*)(ws + WS_HN), (float*)(ws + WS_SSP)};
    pg8::gemm_phase(F.lds, DM, DM, DM, S, E);
  }
  GRID_BAR();
#if EN_XATTN
  {
    pg8::XaBatchOrder S{(const char*)(ws + WS_HN), (const char*)(ws + WS_MT), F.G, bx};
    pg8::EpiSoftmax E{(bf16_t*)(ws + WS_XP), (const float*)(ws + WS_SSP), (LAS float*)(F.lds + 131072)};
    pg8::gemm_phase(F.lds, DM, DM, DM, S, E);
  }
  GRID_BAR();
  {
    pg8::XaBatchOrder S{(const char*)(ws + WS_XP), (const char*)(ws + WS_VWT), F.G, bx};
    pg8::EpiRes E{nullptr, (bf16_t*)(ws + WS_HN), (float*)(ws + WS_SSP)};
    pg8::gemm_phase(F.lds, DM, DM, DM, S, E);
  }
  GRID_BAR();
#endif
#if EN_PEER
  {
    pg8::PlainOrder S; S.init(ws + WS_HN, ws + WS_PWQ, NTOK, DM, DM, DM, F.G, bx);
    pg8::EpiBf16RS E{(bf16_t*)(ws + WS_QP), (const float*)(ws + WS_SSP)};
    pg8::gemm_phase(F.lds, DM, DM, DM, S, E);
  }
  GRID_BAR();
  for (int u = bx; u < 256; u += F.G) peer_select_unit(F, u);
  GRID_BAR();
  peer_fused_phase(F);
#else
  { const Ctx Ff = fresh(F);
#pragma unroll 1
    for (int m = Ff.gw; m < NTOK; m += Ff.NGW) final_norm_token(Ff, m); }
#endif
}

extern "C" void kernel_launch(void* const* d_in, const int* in_sizes, int n_in, void* d_out, int out_size, void* d_ws, size_t ws_size, hipStream_t stream) {
  static int grid_blocks = 0;
  if (!grid_blocks) {
    int dev = 0, cus = 0, per_cu = 0;
    (void)hipGetDevice(&dev);
    (void)hipDeviceGetAttribute(&cus, hipDeviceAttributeMultiprocessorCount, dev);
    (void)hipFuncSetAttribute((const void*)mega, hipFuncAttributeMaxDynamicSharedMemorySize, LDS_BYTES);
    (void)hipOccupancyMaxActiveBlocksPerMultiprocessor(&per_cu, (const void*)mega, NTHREADS, LDS_BYTES);
    if (per_cu < 1) { fprintf(stderr, "kernel_launch: occupancy query says %d blocks per CU\n", per_cu); per_cu = 1; }
    grid_blocks = cus;
    if (n_in != 27 || ws_size < WS_END) { fprintf(stderr, "kernel_launch: n_in %d ws %zu (need %zu)\n", n_in, ws_size, (size_t)WS_END); }
    fprintf(stderr, "kernel_launch: grid %d x %d, per_cu %d, ws %zu MiB\n", grid_blocks, NTHREADS, per_cu, ws_size >> 20);
  }
  (void)hipMemsetAsync((char*)d_ws + WS_CTL, 0, 1 * MiB, stream);
  Params p{};
  for (int i = 0; i < 27 && i < n_in; ++i) p.in[i] = (const float*)d_in[i];
  p.out = (float*)d_out; p.ws = (unsigned char*)d_ws;
  void* args[] = {&p};
  hipError_t e = hipLaunchCooperativeKernel((void*)mega, dim3(grid_blocks), dim3(NTHREADS), args, LDS_BYTES, stream);
  if (e != hipSuccess) fprintf(stderr, "cooperative launch failed: %s (grid %d)\n", hipGetErrorString(e), grid_blocks);
}
```

```cpp
#include <hip/hip_runtime.h>
#include <hip/hip_cooperative_groups.h>
#include <cstdio>
#include <cstdint>
namespace cg = cooperative_groups;

#ifndef EN_NSA
#define EN_NSA 1
#endif
#ifndef EN_SLC
#define EN_SLC 1.f
#endif
#ifndef EN_WIN
#define EN_WIN 1.f
#endif
#ifndef EN_XATTN
#define EN_XATTN 1
#endif
#ifndef EN_PEER
#define EN_PEER 1
#endif

#define LAS __attribute__((address_space(3)))
#define DI __device__ __forceinline__
typedef unsigned short bf16_t;
typedef short bf16x8 __attribute__((ext_vector_type(8)));
typedef short s16x4 __attribute__((ext_vector_type(4)));
typedef float f32x2 __attribute__((ext_vector_type(2)));
typedef float f32x4 __attribute__((ext_vector_type(4)));
typedef float f32x16 __attribute__((ext_vector_type(16)));
typedef unsigned u32x2 __attribute__((ext_vector_type(2)));
typedef unsigned u32x4 __attribute__((ext_vector_type(4)));
typedef __bf16 bf16x2_t __attribute__((ext_vector_type(2)));
typedef short v4i16_t __attribute__((ext_vector_type(4)));

constexpr int NB = 4, T = 8192, NTOK = NB * T, DM = 1024;
constexpr int ZP = 3072;
constexpr int C_GQ = 0, C_GK = 256, C_GV = 512, C_GR = 1024, C_GLR = 1536, C_NQ = 1552, C_KC = 2064, C_VC = 2192,
              C_KS = 2320, C_VS = 2448, C_KW = 2576, C_VW = 2704, C_NG = 2832, IN_COLS = 2856;
constexpr float EPS = 1e-6f;
constexpr int NTHREADS = 512, NWAVES = 8;
constexpr int LDS_BYTES = 147456;
constexpr int LDSCTL_OFF = 139264;

constexpr size_t MiB = 1u << 20;
constexpr size_t WS_CTL = 0;
constexpr size_t WS_XL = 256 * 1024;
constexpr size_t WS_BUCK = 1 * MiB;
constexpr size_t WS_C1 = 1 * MiB + 16 * 1024;
constexpr size_t WS_W2T = 1 * MiB + 32 * 1024;
constexpr size_t WS_SK = 1 * MiB + 128 * 1024;
constexpr size_t WS_DL = 1 * MiB + 512 * 1024;
constexpr size_t WS_KCMP = 2 * MiB;
constexpr size_t WS_VCMP = 2 * MiB + 512 * 1024;
constexpr size_t WS_W1T = 3 * MiB;
constexpr size_t WS_WIN = 4 * MiB;
constexpr size_t WS_WOUT = 10 * MiB, WS_XWQ = 12 * MiB, WS_XWK = 14 * MiB, WS_XWV = 16 * MiB, WS_XWO = 18 * MiB, WS_PWQ = 20 * MiB;
constexpr size_t WS_MEMN = 22 * MiB, WS_KX = 24 * MiB, WS_VXT = 26 * MiB;
constexpr size_t WS_PDOWN8 = 32 * MiB, WS_PUP8 = 48 * MiB;
constexpr size_t WS_DSC = 1 * MiB + 64 * 1024, WS_USC = 1 * MiB + 384 * 1024;
constexpr size_t WS_SSP = 28 * MiB;
constexpr size_t WS_PART = 256 * MiB;
constexpr size_t WS_HN = 96 * MiB;
constexpr size_t WS_GU = 96 * MiB;
constexpr size_t WS_Z = 160 * MiB;
constexpr size_t WS_QX = 160 * MiB, WS_XP = 224 * MiB, WS_OX = 288 * MiB;
constexpr size_t WS_QP = 160 * MiB, WS_EIDX = 224 * MiB, WS_ACTH = 232 * MiB, WS_GATE = 240 * MiB;
constexpr size_t WS_OCAT = 352 * MiB;
constexpr size_t WS_GS = 416 * MiB;
constexpr size_t WS_MT = 448 * MiB;
constexpr size_t WS_VWT = 456 * MiB;
constexpr size_t WS_GQ = 464 * MiB, WS_GK = 480 * MiB;
constexpr size_t WS_END = 496 * MiB;

DI unsigned f2bf(float f) { unsigned u = __builtin_bit_cast(unsigned, f); return (u + 0x7fffu + ((u >> 16) & 1u)) >> 16; }
DI float bf2f(unsigned short b) { return __builtin_bit_cast(float, (unsigned)b << 16); }
DI float bflo(unsigned w) { return __builtin_bit_cast(float, w << 16); }
DI float bfhi(unsigned w) { return __builtin_bit_cast(float, w & 0xffff0000u); }
DI unsigned cvtpk(float lo, float hi) { f32x2 v = {lo, hi}; bf16x2_t b = __builtin_convertvector(v, bf16x2_t); return __builtin_bit_cast(unsigned, b); }
DI float wave_sum(float v) {
#pragma unroll
  for (int o = 1; o < 64; o <<= 1) v += __shfl_xor(v, o);
  return v;
}
DI int crow(int r, int hi) { return (r & 3) + 8 * (r >> 2) + 4 * hi; }
DI s16x4 vtr(const LAS unsigned char* p) { return __builtin_bit_cast(s16x4, __builtin_amdgcn_ds_read_tr16_b64_v4i16((LAS v4i16_t*)p)); }
DI bf16x8 cat8(s16x4 a, s16x4 b) { return __builtin_shufflevector(a, b, 0, 1, 2, 3, 4, 5, 6, 7); }
#define MFMA32(a, b, c) __builtin_amdgcn_mfma_f32_32x32x16_bf16((a), (b), (c), 0, 0, 0)
DI bf16x8 pack8(const f32x16& x, int s) {
  u32x4 p; p[0] = cvtpk(x[8 * s], x[8 * s + 1]); p[1] = cvtpk(x[8 * s + 2], x[8 * s + 3]); p[2] = cvtpk(x[8 * s + 4], x[8 * s + 5]); p[3] = cvtpk(x[8 * s + 6], x[8 * s + 7]);
  return __builtin_bit_cast(bf16x8, p);
}
DI float gelu_tanh(float x) {
  const float y = 0.7978845608028654f * (x + 0.044715f * x * x * x);
  const float e = __expf(2.f * y);
  const float th = 1.f - 2.f / (1.f + e);
  return 0.5f * x * (1.f + th);
}
DI float sigmoidf_(float x) { return 1.f / (1.f + __expf(-x)); }

DI void sort16_desc(int (&x)[16]) {
#define CE_(a, b) { const int h_ = max(x[a], x[b]); const int l_ = min(x[a], x[b]); x[a] = h_; x[b] = l_; }
  CE_(0,1); CE_(2,3); CE_(0,2); CE_(1,3); CE_(1,2); CE_(4,5); CE_(6,7); CE_(4,6); CE_(5,7); CE_(5,6); CE_(0,4); CE_(2,6); CE_(2,4); CE_(1,5); CE_(3,7); CE_(3,5); CE_(1,2); CE_(3,4); CE_(5,6); CE_(8,9); CE_(10,11); CE_(8,10); CE_(9,11); CE_(9,10); CE_(12,13); CE_(14,15); CE_(12,14); CE_(13,15); CE_(13,14); CE_(8,12); CE_(10,14); CE_(10,12); CE_(9,13); CE_(11,15); CE_(11,13); CE_(9,10); CE_(11,12); CE_(13,14); CE_(0,8); CE_(4,12); CE_(4,8); CE_(2,10); CE_(6,14); CE_(6,10); CE_(2,4); CE_(6,8); CE_(10,12); CE_(1,9); CE_(5,13); CE_(5,9); CE_(3,11); CE_(7,15); CE_(7,11); CE_(3,5); CE_(7,9); CE_(11,13); CE_(1,2); CE_(3,4); CE_(5,6); CE_(7,8); CE_(9,10); CE_(11,12); CE_(13,14);
#undef CE_
}
DI void merge16_top(int (&a)[16], const int (&b)[16]) {
  int c[16];
#pragma unroll
  for (int i = 0; i < 16; ++i) c[i] = max(a[i], b[15 - i]);
#pragma unroll
  for (int st = 8; st >= 1; st >>= 1)
#pragma unroll
    for (int i = 0; i < 16; ++i) if ((i & st) == 0) { const int x = c[i], y = c[i + st]; c[i] = max(x, y); c[i + st] = min(x, y); }
#pragma unroll
  for (int i = 0; i < 16; ++i) a[i] = c[i];
}

struct Params {
  const float* in[27];
  float* out;
  unsigned char* ws;
  int pad0, pad1;
};
enum { I_X = 0, I_MEM, I_RELB, I_NMIX, I_WIN, I_GW2, I_GB, I_GON, I_POSK, I_POSV, I_CKW1, I_CKW2, I_CVW1, I_CVW2, I_WOUT, I_NXA, I_NMEM,
       I_XWQ, I_XWK, I_XWV, I_XWO, I_NFFN, I_PWQ, I_PSK, I_PDOWN, I_PUP, I_NFIN };

namespace pg8 {
constexpr int BM = 256, BK = 64, HALF = 128, HTB = HALF * BK * 2, STAGE_BYTES = 8 * HTB;
DI int lds_byte(int r, int c) { const int st = (r >> 4) * 2 + (c >> 5), rr = r & 15, cc = c & 31, ob = rr * 64 + cc * 2; return st * 1024 + (ob ^ (((ob >> 9) & 1) << 5)); }
DI void stage_rc(int b, int& R, int& C) { const int st = b / 1024, sb = b % 1024, swz = sb ^ (((sb >> 9) & 1) << 5); R = (st >> 1) * 16 + swz / 64; C = (st & 1) * 32 + (swz % 64) / 2; }
DI int perm32(int rho) { const int n = rho >> 4, i = rho & 15; return 8 * (i >> 2) + 4 * n + (i & 3); }
struct Unit { const char* a; const char* b; int pm, pn; };
DI const char* uni_ptr(const char* p) { const unsigned long long v = (unsigned long long)p; const unsigned lo = __builtin_amdgcn_readfirstlane((unsigned)v), hi = __builtin_amdgcn_readfirstlane((unsigned)(v >> 32)); return (const char*)(((unsigned long long)hi << 32) | lo); }

template <class Epi, class Sched>
DI void gemm_phase(LAS unsigned char* lds, const int K, const int lda, const int ldb, const Sched& S, const Epi& E) {
  constexpr bool ALIGN_EPI = true;
  int tid_ = threadIdx.x; asm volatile("" : "+v"(tid_));
  const int tid = tid_, wid = __builtin_amdgcn_readfirstlane(tid >> 6), lane = tid & 63, wr = wid >> 2, wc = wid & 3, fr = lane & 15, fq = lane >> 4;
  const int nt = K / BK;
  unsigned voffA[2], voffB[2];
#pragma unroll
  for (int i = 0; i < 2; ++i) { int R, C; stage_rc(tid * 16 + i * 8192, R, C); const int Rb = Epi::PERM ? ((R & ~31) + perm32(R & 31)) : R;
    voffA[i] = (unsigned)(R * lda + C) * 2u; voffB[i] = (unsigned)(Rb * ldb + C) * 2u; }
  const size_t kstep = (size_t)(BK * 2);
  const size_t hstepA = (size_t)HALF * lda * 2, hstepB = (size_t)HALF * ldb * 2;
  const unsigned ldsw = (unsigned)wid * 1024u;
  const int aoff = lds_byte(wr * 64 + fr, fq * 8), boff = lds_byte(wc * 32 + fr, fq * 8);
#define PG8_SA(b, h) (((b) * 2 + (h)) * HTB)
#define PG8_SB(b, h) ((4 + (b) * 2 + (h)) * HTB)
#define PG8_STAGE(bufoff, gbase, voff) do { _Pragma("unroll") for (int _i = 0; _i < 2; ++_i) \
        __builtin_amdgcn_global_load_lds((const unsigned*)((const char*)(gbase) + (voff)[_i]), (LAS unsigned*)(lds + (bufoff) + ldsw + _i * 8192), 16, 0, 0); } while (0)
#define PG8_LDA(dst, b, h) do { _Pragma("unroll") for (int m = 0; m < 4; ++m) _Pragma("unroll") for (int k = 0; k < 2; ++k) dst[m][k] = *(const LAS bf16x8*)(lds + PG8_SA(b, h) + aoff + m * 2048 + k * 1024); } while (0)
#define PG8_LDB(dst, b, h) do { _Pragma("unroll") for (int n = 0; n < 2; ++n) _Pragma("unroll") for (int k = 0; k < 2; ++k) dst[n][k] = *(const LAS bf16x8*)(lds + PG8_SB(b, h) + boff + n * 2048 + k * 1024); } while (0)
#define PG8_MMA(ai, bj, At, Bt) do { __builtin_amdgcn_s_setprio(1); _Pragma("unroll") for (int m = 0; m < 4; ++m) _Pragma("unroll") for (int n = 0; n < 2; ++n) _Pragma("unroll") for (int k = 0; k < 2; ++k) \
        acc[ai][bj][m][n] = __builtin_amdgcn_mfma_f32_16x16x32_bf16(Bt[n][k], At[m][k], acc[ai][bj][m][n], 0, 0, 0); __builtin_amdgcn_s_setprio(0); } while (0)
#define PG8_WAIT_V(n) asm volatile("s_waitcnt vmcnt(" #n ")" ::: "memory")
#define PG8_WAIT_L(n) asm volatile("s_waitcnt lgkmcnt(" #n ")" ::: "memory")
#define PG8_BAR __builtin_amdgcn_s_barrier()
#define PG8_SCHED __builtin_amdgcn_sched_barrier(0)
  __syncthreads();
  Unit cur, nxt; int ui = 0;
  if (!S.next(0, cur)) return;
  f32x4 acc[2][2][4][2];
#pragma unroll
  for (int a = 0; a < 2; ++a)
#pragma unroll
    for (int b = 0; b < 2; ++b)
#pragma unroll
      for (int m = 0; m < 4; ++m)
#pragma unroll
        for (int n = 0; n < 2; ++n) acc[a][b][m][n] = (f32x4){0.f, 0.f, 0.f, 0.f};
  bf16x8 At[4][2], B0[2][2], B1[2][2];
  const char* cA = uni_ptr(cur.a); const char* cB = uni_ptr(cur.b);
  PG8_STAGE(PG8_SB(0, 0), cB, voffB); PG8_STAGE(PG8_SB(0, 1), cB + hstepB, voffB); PG8_STAGE(PG8_SA(0, 0), cA, voffA); PG8_STAGE(PG8_SA(0, 1), cA + hstepA, voffA);
  if (wr == 1) PG8_BAR;
  PG8_WAIT_V(2); PG8_BAR;
  PG8_STAGE(PG8_SB(1, 0), cB + kstep, voffB); PG8_STAGE(PG8_SA(1, 0), cA + kstep, voffA); PG8_STAGE(PG8_SB(1, 1), cB + hstepB + kstep, voffB);
  PG8_WAIT_V(6); PG8_BAR;
  for (;;) {
    const bool has_next = S.next(ui + 1, nxt);
    const char* nA = has_next ? uni_ptr(nxt.a) : cA; const char* nB = has_next ? uni_ptr(nxt.b) : cB;
#pragma unroll 1
    for (int t = 0; t < nt; t += 2) {
      const bool last = (t == nt - 2);
      const char* a1 = cA + (size_t)(t + 1) * kstep;
      const char* a2 = last ? nA : cA + (size_t)(t + 2) * kstep; const char* b2 = last ? nB : cB + (size_t)(t + 2) * kstep;
      const char* a3 = a2 + kstep; const char* b3 = b2 + kstep;
      PG8_LDB(B0, 0, 0); PG8_LDB(B1, 0, 1); PG8_SCHED; PG8_LDA(At, 0, 0); PG8_STAGE(PG8_SA(1, 1), a1 + hstepA, voffA);
      PG8_WAIT_V(8); PG8_WAIT_L(0); PG8_BAR; PG8_MMA(0, 0, At, B0); PG8_MMA(0, 1, At, B1); PG8_BAR; PG8_SCHED;
      PG8_LDA(At, 0, 1); PG8_STAGE(PG8_SB(0, 0), b2, voffB); PG8_STAGE(PG8_SB(0, 1), b2 + hstepB, voffB); PG8_STAGE(PG8_SA(0, 0), a2, voffA);
      PG8_WAIT_V(8); PG8_WAIT_L(0); PG8_BAR; PG8_MMA(1, 0, At, B0); PG8_MMA(1, 1, At, B1); PG8_BAR; PG8_SCHED;
      PG8_LDB(B0, 1, 0); PG8_LDB(B1, 1, 1); PG8_SCHED; PG8_LDA(At, 1, 0); PG8_STAGE(PG8_SA(0, 1), a2 + hstepA, voffA);
      PG8_WAIT_V(8); PG8_WAIT_L(0); PG8_BAR; PG8_MMA(0, 0, At, B0); PG8_MMA(0, 1, At, B1); PG8_BAR; PG8_SCHED;
      PG8_LDA(At, 1, 1); PG8_STAGE(PG8_SB(1, 0), b3, voffB); PG8_STAGE(PG8_SB(1, 1), b3 + hstepB, voffB); PG8_STAGE(PG8_SA(1, 0), a3, voffA);
      PG8_WAIT_V(8); PG8_WAIT_L(0); PG8_BAR; PG8_MMA(1, 0, At, B0); PG8_MMA(1, 1, At, B1); PG8_BAR; PG8_SCHED;
    }
    if constexpr (ALIGN_EPI) { if (wr == 0) PG8_BAR; }
    E(acc, cur, wr, wc, fr, fq);
    if (!has_next) break;
#pragma unroll
    for (int a = 0; a < 2; ++a)
#pragma unroll
      for (int b = 0; b < 2; ++b)
#pragma unroll
        for (int m = 0; m < 4; ++m)
#pragma unroll
          for (int n = 0; n < 2; ++n) acc[a][b][m][n] = (f32x4){0.f, 0.f, 0.f, 0.f};
    cur = nxt; cA = nA; cB = nB; ++ui;
    if constexpr (ALIGN_EPI) { if (wr == 1) PG8_BAR; }
  }
  PG8_WAIT_V(0);
  if constexpr (!ALIGN_EPI) { if (wr == 0) PG8_BAR; }
  PG8_BAR;
#undef PG8_SA
#undef PG8_SB
#undef PG8_STAGE
#undef PG8_LDA
#undef PG8_LDB
#undef PG8_MMA
#undef PG8_WAIT_V
#undef PG8_WAIT_L
#undef PG8_BAR
#undef PG8_SCHED
}

struct EpiBf16 {
  static constexpr bool PERM = true;
  bf16_t* O; int ldc; int coloff;
  DI void operator()(const f32x4 (&acc)[2][2][4][2], const Unit& u, int wr, int wc, int fr, int fq) const {
    const int row0 = u.pm * BM + wr * 64 + fr; const int col0 = coloff + u.pn * BM + wc * 32 + 8 * fq;
#pragma unroll
    for (int ai = 0; ai < 2; ++ai)
#pragma unroll
      for (int m = 0; m < 4; ++m) { bf16_t* rowp = O + (size_t)(row0 + ai * HALF + m * 16) * ldc + col0;
#pragma unroll
        for (int bj = 0; bj < 2; ++bj) { const f32x4 v0 = acc[ai][bj][m][0], v1 = acc[ai][bj][m][1];
          u32x4 w; w.x = cvtpk(v0[0], v0[1]); w.y = cvtpk(v0[2], v0[3]); w.z = cvtpk(v1[0], v1[1]); w.w = cvtpk(v1[2], v1[3]);
          *(u32x4*)(rowp + bj * HALF) = w; } }
  }
};
struct EpiRes {
  static constexpr bool PERM = false;
  const float* ResF; bf16_t* HB; float* SSP;
  DI void operator()(const f32x4 (&acc)[2][2][4][2], const Unit& u, int wr, int wc, int fr, int fq) const {
    const int row0 = u.pm * BM + wr * 64 + fr; const int col0 = u.pn * BM + wc * 32 + 4 * fq;
#pragma unroll
    for (int ai = 0; ai < 2; ++ai)
#pragma unroll
      for (int m = 0; m < 4; ++m) { const int row = row0 + ai * HALF + m * 16; const size_t off = (size_t)row * DM + col0; float ss = 0.f;
#pragma unroll
        for (int bj = 0; bj < 2; ++bj)
#pragma unroll
          for (int n = 0; n < 2; ++n) { f32x4 r;
            if (ResF) r = *(const f32x4*)(ResF + off + bj * HALF + n * 16);
            else { const u32x2 rb = *(const u32x2*)(HB + off + bj * HALF + n * 16); r = (f32x4){bflo(rb.x), bfhi(rb.x), bflo(rb.y), bfhi(rb.y)}; }
            const f32x4 o = r + acc[ai][bj][m][n];
            u32x2 w; w.x = cvtpk(o[0], o[1]); w.y = cvtpk(o[2], o[3]); *(u32x2*)(HB + off + bj * HALF + n * 16) = w;
            const float q0 = bflo(w.x), q1 = bfhi(w.x), q2 = bflo(w.y), q3 = bfhi(w.y);
            ss += (q0 * q0 + q1 * q1) + (q2 * q2 + q3 * q3); }
        ss += __shfl_xor(ss, 16); ss += __shfl_xor(ss, 32);
        if (fq == 0) SSP[(size_t)row * 16 + u.pn * 4 + wc] = ss; }
  }
};
DI float row_rstd(const float* SSP, int row) {
  const f32x4* p = (const f32x4*)(SSP + (size_t)row * 16); const f32x4 a = p[0], b = p[1], c = p[2], d = p[3];
  const float s = ((a[0] + a[1]) + (a[2] + a[3])) + ((b[0] + b[1]) + (b[2] + b[3])) + ((c[0] + c[1]) + (c[2] + c[3])) + ((d[0] + d[1]) + (d[2] + d[3]));
  return rsqrtf(s * (1.f / DM) + EPS);
}
struct EpiBf16RS {
  static constexpr bool PERM = true;
  bf16_t* O; const float* SSP;
  DI void operator()(const f32x4 (&acc)[2][2][4][2], const Unit& u, int wr, int wc, int fr, int fq) const {
    const int row0 = u.pm * BM + wr * 64 + fr; const int col0 = u.pn * BM + wc * 32 + 8 * fq;
#pragma unroll
    for (int ai = 0; ai < 2; ++ai)
#pragma unroll
      for (int m = 0; m < 4; ++m) { const int row = row0 + ai * HALF + m * 16; bf16_t* rowp = O + (size_t)row * DM + col0; const float rs = row_rstd(SSP, row);
#pragma unroll
        for (int bj = 0; bj < 2; ++bj) { const f32x4 v0 = acc[ai][bj][m][0] * rs, v1 = acc[ai][bj][m][1] * rs;
          u32x4 w; w.x = cvtpk(v0[0], v0[1]); w.y = cvtpk(v0[2], v0[3]); w.z = cvtpk(v1[0], v1[1]); w.w = cvtpk(v1[2], v1[3]);
          *(u32x4*)(rowp + bj * HALF) = w; } }
  }
};
struct EpiSoftmax {
  static constexpr bool PERM = true;
  bf16_t* P; const float* SSP; LAS float* xch;
  DI void operator()(f32x4 (&acc)[2][2][4][2], const Unit& u, int wr, int wc, int fr, int fq) const {
    const int row0 = u.pm * BM + wr * 64 + fr; const int col0 = u.pn * BM + wc * 32 + 8 * fq;
#pragma unroll
    for (int ai = 0; ai < 2; ++ai)
#pragma unroll
      for (int m = 0; m < 4; ++m) { const int row = row0 + ai * HALF + m * 16; const float rs = row_rstd(SSP, row) * 1.4426950408889634f; float s = 0.f;
#pragma unroll
        for (int bj = 0; bj < 2; ++bj)
#pragma unroll
          for (int n = 0; n < 2; ++n) { f32x4 v = acc[ai][bj][m][n] * rs;
#pragma unroll
            for (int q = 0; q < 4; ++q) v[q] = __builtin_amdgcn_exp2f(v[q]);
            acc[ai][bj][m][n] = v; s += (v[0] + v[1]) + (v[2] + v[3]); }
        s += __shfl_xor(s, 16); s += __shfl_xor(s, 32);
        if (fq == 0) xch[(wr * 64 + ai * HALF + m * 16 + fr) * 4 + wc] = s; }
    asm volatile("s_waitcnt lgkmcnt(0)" ::: "memory"); __builtin_amdgcn_s_barrier(); asm volatile("" ::: "memory");
#pragma unroll
    for (int ai = 0; ai < 2; ++ai)
#pragma unroll
      for (int m = 0; m < 4; ++m) { const int rl = wr * 64 + ai * HALF + m * 16 + fr; const f32x4 ps = *(const LAS f32x4*)(xch + rl * 4); const float inv = 1.f / ((ps[0] + ps[1]) + (ps[2] + ps[3]));
        bf16_t* rowp = P + (size_t)(row0 + ai * HALF + m * 16) * DM + col0;
#pragma unroll
        for (int bj = 0; bj < 2; ++bj) { const f32x4 v0 = acc[ai][bj][m][0] * inv, v1 = acc[ai][bj][m][1] * inv;
          u32x4 w; w.x = cvtpk(v0[0], v0[1]); w.y = cvtpk(v0[2], v0[3]); w.z = cvtpk(v1[0], v1[1]); w.w = cvtpk(v1[2], v1[3]);
          *(u32x4*)(rowp + bj * HALF) = w; } }
    asm volatile("s_waitcnt lgkmcnt(0)" ::: "memory"); __builtin_amdgcn_s_barrier(); asm volatile("" ::: "memory");
  }
};

struct PlainOrder {
  const char* A; const char* Bt; size_t tstepA, tstepB; int nM, nN, nwg, G, c;
  DI void init(const void* A_, const void* Bt_, int M, int N, int lda, int ldb, int G_, int c_) { A = (const char*)A_; Bt = (const char*)Bt_; tstepA = (size_t)BM * lda * 2; tstepB = (size_t)BM * ldb * 2; nM = M / BM; nN = N / BM; nwg = nM * nN; G = G_; c = c_; }
  DI bool next(int i, Unit& u) const {
    const long L = (long)i * G + c; if (L >= nwg) return false;
    int wgid = (int)L; { const int q = nwg / 8, r = nwg % 8, xcd = wgid % 8, off = wgid / 8; wgid = (xcd < r ? xcd * (q + 1) : r * (q + 1) + (xcd - r) * q) + off; }
    constexpr int WGM = 8;
    const int nig = WGM * nN, gid = wgid / nig, fm = gid * WGM, gsz = (nM - fm) < WGM ? (nM - fm) : WGM;
    u.pm = fm + ((wgid % nig) % gsz); u.pn = (wgid % nig) / gsz; u.a = A + (size_t)u.pm * tstepA; u.b = Bt + (size_t)u.pn * tstepB; return true;
  }
};
struct XaBatchOrder {
  const char* A; const char* Bb; int G, c;
  DI bool next(int i, Unit& u) const { const int L = i * G + c; if (L >= 512) return false; u.pm = L >> 2; u.pn = L & 3; const int b = u.pm >> 5;
    u.a = A + (size_t)u.pm * 256 * DM * 2; u.b = Bb + ((size_t)(b * 1024 + u.pn * 256) * DM) * 2; return true; }
};
struct FoldOrder {
  const char* KX; const char* WQO; const char* WOT; const char* VX; int G, c;
  DI bool next(int i, Unit& u) const { const int L = i * G + c; if (L >= 128) return false; const int t = L >> 6, b = (L >> 4) & 3, h = (L >> 2) & 3, q = L & 3;
    if (t == 0) { u.pm = b * 4 + h; u.pn = q; u.a = KX + ((size_t)(b * 256) * DM + h * 256) * 2; u.b = WQO + ((size_t)(q * 256) * DM + h * 256) * 2; }
    else { u.pm = 16 + b * 4 + q; u.pn = h; u.a = WOT + ((size_t)(q * 256) * DM + h * 256) * 2; u.b = VX + ((size_t)(b * 256) * DM + h * 256) * 2; }
    return true; }
};
struct MemProjOrder {
  const char* MEMN; const char* WKT; const char* WVT; int G, c;
  DI bool next(int i, Unit& u) const { const int L = i * G + c; if (L >= 32) return false; const int t = L >> 4, m = (L >> 2) & 3, n = L & 3;
    u.pm = t * 4 + m; u.pn = n; u.a = MEMN + (size_t)(m * 256) * DM * 2; u.b = (t ? WVT : WKT) + (size_t)(n * 256) * DM * 2; return true; }
};
}

struct Ctx {
  LAS unsigned char* lds;
  int tid, lane, wave, G, gw, NGW;
  const float* const* in;
  float* H;
  unsigned char* ws;
};
DI Ctx fresh(const Ctx& F) { Ctx R = F; int t = threadIdx.x; asm volatile("" : "+v"(t)); R.tid = t; R.lane = t & 63; R.wave = __builtin_amdgcn_readfirstlane(t >> 6); R.gw = blockIdx.x * NWAVES + R.wave; return R; }

DI void transpose_item(const float* W, int K, int Nsrc, int ldw, bf16_t* WT, int nblk, LAS float* scr, int item, int lane, int mode, const float* kgain = nullptr) {
  const int kb = item / nblk, nb = item % nblk, k0 = 64 * kb, n0 = 32 * nb;
  const int ncol = n0 + (lane & 31);
  float sc = 1.f;
  if (mode == 1) { if (ncol < 256) sc = 0.125f; else if (ncol >= C_NQ && ncol < C_NQ + 512) sc = 0.125f * 1.4426950408889634f; }
  if (mode == 2) sc = 0.0625f;
  float tv[32];
#pragma unroll
  for (int i = 0; i < 32; ++i) { const int kk = 2 * i + (lane >> 5); tv[i] = ncol < Nsrc ? W[(size_t)(k0 + kk) * ldw + ncol] : 0.f; }
#pragma unroll
  for (int i = 0; i < 32; ++i) { const int kk = 2 * i + (lane >> 5); const float gk = kgain ? kgain[k0 + kk] : 1.f; scr[kk * 33 + (lane & 31)] = tv[i] * (sc * gk); }
  asm volatile("s_waitcnt lgkmcnt(0)" ::: "memory");
  const int c = lane & 7;
#pragma unroll
  for (int j = 0; j < 4; ++j) { const int n = (lane >> 3) + 8 * j; const LAS float* s = scr + (8 * c) * 33 + n;
    u32x4 o; o.x = cvtpk(s[0 * 33], s[1 * 33]); o.y = cvtpk(s[2 * 33], s[3 * 33]); o.z = cvtpk(s[4 * 33], s[5 * 33]); o.w = cvtpk(s[6 * 33], s[7 * 33]);
    *(u32x4*)(WT + (size_t)(n0 + n) * K + k0 + 8 * c) = o; }
  asm volatile("s_waitcnt lgkmcnt(0)" ::: "memory");
}
DI void rms_row_bf16(const float* xrow, const float* g, bf16_t* orow, int lane) {
  const f32x4* xr = (const f32x4*)xrow + lane;
  f32x4 v[4]; float s = 0.f;
#pragma unroll
  for (int j = 0; j < 4; ++j) { v[j] = xr[64 * j]; s += (v[j].x * v[j].x + v[j].y * v[j].y) + (v[j].z * v[j].z + v[j].w * v[j].w); }
  const float r = rsqrtf(wave_sum(s) * (1.f / DM) + EPS);
  u32x2* o8 = (u32x2*)orow + lane;
#pragma unroll
  for (int j = 0; j < 4; ++j) { const f32x4 gg = ((const f32x4*)g)[lane + 64 * j]; u32x2 w; w.x = cvtpk(v[j].x * r * gg.x, v[j].y * r * gg.y); w.y = cvtpk(v[j].z * r * gg.z, v[j].w * r * gg.w); o8[64 * j] = w; }
}
DI void cvt_row_fp8(const float* xrow, unsigned char* orow, float* inv_scale, int lane, const float* cgain = nullptr) {
  const f32x4* xr = (const f32x4*)xrow + lane; unsigned* o4 = (unsigned*)orow + lane;
  f32x4 v[4]; float mx = 0.f;
#pragma unroll
  for (int j = 0; j < 4; ++j) { v[j] = xr[64 * j]; if (cgain) v[j] = v[j] * ((const f32x4*)cgain)[lane + 64 * j]; mx = fmaxf(mx, fmaxf(fmaxf(fabsf(v[j].x), fabsf(v[j].y)), fmaxf(fabsf(v[j].z), fabsf(v[j].w)))); }
#pragma unroll
  for (int o = 1; o < 64; o <<= 1) mx = fmaxf(mx, __shfl_xor(mx, o));
  const float sc = mx > 0.f ? 256.f / mx : 1.f;
#pragma unroll
  for (int j = 0; j < 4; ++j) { int w = 0; w = __builtin_amdgcn_cvt_pk_fp8_f32(v[j].x * sc, v[j].y * sc, w, false); w = __builtin_amdgcn_cvt_pk_fp8_f32(v[j].z * sc, v[j].w * sc, w, true); o4[64 * j] = (unsigned)w; }
  if (lane == 0) *inv_scale = mx > 0.f ? mx * (1.f / 256.f) : 1.f;
}
DI void cvt_row_bf16(const float* xrow, bf16_t* orow, int lane) {
  const f32x4* xr = (const f32x4*)xrow + lane; u32x2* o8 = (u32x2*)orow + lane;
#pragma unroll
  for (int j = 0; j < 4; ++j) { const f32x4 v = xr[64 * j]; u32x2 w; w.x = cvtpk(v.x, v.y); w.y = cvtpk(v.z, v.w); o8[64 * j] = w; }
}

DI void rows4_load(f32x4 (&v)[4][4], const float* x, const int (&rows)[4], int lane) {
#pragma unroll
  for (int q = 0; q < 4; ++q) { const f32x4* xr = (const f32x4*)(x + (size_t)rows[q] * DM) + lane;
#pragma unroll
    for (int j = 0; j < 4; ++j) v[q][j] = xr[64 * j]; }
}
DI void rms_rows4_bf16(f32x4 (&v)[4][4], const float* g, bf16_t* o, const int (&rows)[4], int lane) {
#pragma unroll
  for (int q = 0; q < 4; ++q) { float s = 0.f;
#pragma unroll
    for (int j = 0; j < 4; ++j) s += (v[q][j].x * v[q][j].x + v[q][j].y * v[q][j].y) + (v[q][j].z * v[q][j].z + v[q][j].w * v[q][j].w);
    const float r = rsqrtf(wave_sum(s) * (1.f / DM) + EPS);
    u32x2* o8 = (u32x2*)(o + (size_t)rows[q] * DM) + lane;
#pragma unroll
    for (int j = 0; j < 4; ++j) { const f32x4 gg = ((const f32x4*)g)[lane + 64 * j]; u32x2 w; w.x = cvtpk(v[q][j].x * r * gg.x, v[q][j].y * r * gg.y); w.y = cvtpk(v[q][j].z * r * gg.z, v[q][j].w * r * gg.w); o8[64 * j] = w; } }
}
DI void cvt_rows4_fp8(f32x4 (&v)[4][4], unsigned char* o, float* inv_scale, const int (&rows)[4], int lane, const float* cgain) {
#pragma unroll
  for (int q = 0; q < 4; ++q) { float mx = 0.f;
#pragma unroll
    for (int j = 0; j < 4; ++j) { if (cgain) v[q][j] = v[q][j] * ((const f32x4*)cgain)[lane + 64 * j]; mx = fmaxf(mx, fmaxf(fmaxf(fabsf(v[q][j].x), fabsf(v[q][j].y)), fmaxf(fabsf(v[q][j].z), fabsf(v[q][j].w)))); }
#pragma unroll
    for (int o_ = 1; o_ < 64; o_ <<= 1) mx = fmaxf(mx, __shfl_xor(mx, o_));
    const float sc = mx > 0.f ? 256.f / mx : 1.f;
#pragma unroll
    for (int j = 0; j < 4; ++j) { int w = 0; w = __builtin_amdgcn_cvt_pk_fp8_f32(v[q][j].x * sc, v[q][j].y * sc, w, false); w = __builtin_amdgcn_cvt_pk_fp8_f32(v[q][j].z * sc, v[q][j].w * sc, w, true);
      const int col = 4 * (lane + 64 * j); *(unsigned*)(o + ((size_t)(col >> 7) * 16384 + rows[q]) * 128 + (col & 127)) = (unsigned)w; }
    if (lane == 0) inv_scale[rows[q]] = mx > 0.f ? mx * (1.f / 256.f) : 1.f; }
}
struct BigItem { const float* src; int kind; int rows[4]; };

DI void prologue(const Ctx& F0) {
  const Ctx F = fresh(F0);
  LAS float* scr = (LAS float*)(F.lds + F.wave * 16384);
  unsigned char* ws = F.ws;
  auto do_transposes = [&]() {
  constexpr int I_IN = 16 * 96, I_SQ = 16 * 32, I_W1 = 32 * 4, I_W2 = 2 * 2;
  constexpr int NT_ITEMS = I_IN + 5 * I_SQ + 2 * I_W1 + 2 * I_W2;
  for (int it = F.gw; it < NT_ITEMS; it += F.NGW) {
    int r = it;
    if (r < I_IN) { transpose_item(F.in[I_WIN], 1024, IN_COLS, IN_COLS, (bf16_t*)(ws + WS_WIN), 96, scr, r, F.lane, 1); continue; } r -= I_IN;
    if (r < I_SQ) { transpose_item(F.in[I_WOUT], 1024, 1024, 1024, (bf16_t*)(ws + WS_WOUT), 32, scr, r, F.lane, 0); continue; } r -= I_SQ;
    if (r < I_SQ) { transpose_item(F.in[I_XWK], 1024, 1024, 1024, (bf16_t*)(ws + WS_XWK), 32, scr, r, F.lane, 0); continue; } r -= I_SQ;
    if (r < I_SQ) { transpose_item(F.in[I_XWV], 1024, 1024, 1024, (bf16_t*)(ws + WS_XWV), 32, scr, r, F.lane, 0); continue; } r -= I_SQ;
    if (r < I_SQ) { transpose_item(F.in[I_XWO], 1024, 1024, 1024, (bf16_t*)(ws + WS_XWO), 32, scr, r, F.lane, 0); continue; } r -= I_SQ;
    if (r < I_SQ) { transpose_item(F.in[I_PWQ], 1024, 1024, 1024, (bf16_t*)(ws + WS_PWQ), 32, scr, r, F.lane, 0, F.in[I_NFFN]); continue; } r -= I_SQ;
    if (r < I_W1) { transpose_item(F.in[I_CKW1], 2048, 128, 128, (bf16_t*)(ws + WS_W1T), 4, scr, r, F.lane, 0); continue; } r -= I_W1;
    if (r < I_W1) { transpose_item(F.in[I_CVW1], 2048, 128, 128, (bf16_t*)(ws + WS_W1T) + 128 * 2048, 4, scr, r, F.lane, 0); continue; } r -= I_W1;
    if (r < I_W2) { transpose_item(F.in[I_CKW2], 128, 64, 64, (bf16_t*)(ws + WS_W2T), 2, scr, r, F.lane, 0); continue; } r -= I_W2;
    transpose_item(F.in[I_CVW2], 128, 64, 64, (bf16_t*)(ws + WS_W2T) + 64 * 128, 2, scr, r, F.lane, 0);
  }
  };
  auto do_bigrows = [&]() {
  {
    const int step = 4 * F.NGW, nx = (NTOK + step - 1) / step, nt = (16384 + step - 1) / step, J = nx + 2 * nt;
    auto item = [&](int j, BigItem& I) -> bool {
      int r0, nmax;
      if (j < nx) { I.src = F.in[I_X]; I.kind = 0; r0 = F.gw + j * step; nmax = NTOK; }
      else { const int jj = j - nx; I.kind = 1 + (jj & 1); I.src = F.in[(jj & 1) ? I_PUP : I_PDOWN]; r0 = F.gw + (jj >> 1) * step; nmax = 16384; }
      if (r0 >= nmax) return false;
#pragma unroll
      for (int q = 0; q < 4; ++q) I.rows[q] = min(r0 + q * F.NGW, nmax - 1);
      return true; };
    auto proc = [&](f32x4 (&v)[4][4], const BigItem& I) {
      if (I.kind == 0) rms_rows4_bf16(v, F.in[I_NMIX], (bf16_t*)(ws + WS_HN), I.rows, F.lane);
      else if (I.kind == 1) cvt_rows4_fp8(v, ws + WS_PDOWN8, (float*)(ws + WS_DSC), I.rows, F.lane, F.in[I_NFFN]);
      else cvt_rows4_fp8(v, ws + WS_PUP8, (float*)(ws + WS_USC), I.rows, F.lane, nullptr); };
    f32x4 VA[4][4], VB[4][4]; BigItem IA, IB;
    bool ha = item(0, IA); if (ha) rows4_load(VA, IA.src, IA.rows, F.lane);
#pragma unroll 1
    for (int j = 0; j < J; j += 2) {
      const bool hb = (j + 1 < J) && item(j + 1, IB); if (hb) rows4_load(VB, IB.src, IB.rows, F.lane);
      if (ha) proc(VA, IA);
      ha = (j + 2 < J) && item(j + 2, IA); if (ha) rows4_load(VA, IA.src, IA.rows, F.lane);
      if (hb) proc(VB, IB);
    }
  }
  };
  if (F.wave & 1) { do_bigrows(); do_transposes(); } else { do_transposes(); do_bigrows(); }
  constexpr int R_MEM = 1024, R_WQ = 1024, R_SK = 128, R_C1 = 256, R_BK = 8;
  constexpr int NR_ITEMS = R_MEM + R_WQ + R_SK + R_C1 + R_BK;
  for (int it = F.gw; it < NR_ITEMS; it += F.NGW) {
    int r = it;
    if (r < R_MEM) { rms_row_bf16(F.in[I_MEM] + (size_t)r * DM, F.in[I_NMEM], (bf16_t*)(ws + WS_MEMN) + (size_t)r * DM, F.lane); continue; } r -= R_MEM;
    if (r < R_WQ) {
      const float sck = F.in[I_NXA][r] * 0.0625f; const f32x4* xr = (const f32x4*)(F.in[I_XWQ] + (size_t)r * DM) + F.lane; u32x2* o8 = (u32x2*)((bf16_t*)(ws + WS_XWQ) + (size_t)r * DM) + F.lane;
#pragma unroll
      for (int j = 0; j < 4; ++j) { const f32x4 v = xr[64 * j] * sck; u32x2 w; w.x = cvtpk(v.x, v.y); w.y = cvtpk(v.z, v.w); o8[64 * j] = w; }
      continue; } r -= R_WQ;
    if (r < R_SK) { cvt_row_bf16(F.in[I_PSK] + (size_t)r * 1024, (bf16_t*)(ws + WS_SK) + (size_t)r * 1024, F.lane); continue; } r -= R_SK;
    if (r < R_C1) {
      const int kv = r >> 7, hid = r & 127; const float* pos = F.in[kv ? I_POSV : I_POSK]; const float* w1 = F.in[kv ? I_CVW1 : I_CKW1];
      float s = 0.f;
      for (int i = F.lane; i < 2048; i += 64) s += pos[i] * w1[(size_t)i * 128 + hid];
      s = wave_sum(s);
      if (F.lane == 0) ((float*)(ws + WS_C1))[kv * 128 + hid] = s;
      continue; } r -= R_C1;
    {
      unsigned char* bk = ws + WS_BUCK;
      for (int i = F.lane; i < 1024; i += 64) { const int d = r * 1024 + i;
        int b = d;
        if (d >= 16) { b = 16; const int thr[15] = {22, 30, 40, 54, 73, 99, 134, 182, 246, 332, 450, 609, 825, 1117, 1513};
#pragma unroll
          for (int k = 0; k < 15; ++k) b += (d >= thr[k]) ? 1 : 0; }
        bk[d] = (unsigned char)b; }
    }
  }
}

constexpr int GL_LA = 0, GL_SEG = 16384, GL_GLR = 18432, GL_W2 = 22528, GL_BIAS = 26624, GL_QT = 27648, GL_KT = 35840, GL_KTT = 44032, GL_V = 52224, GL_O = 68608;
constexpr int G0_STRIDE = 68608;
constexpr int G1_QT = 0, G1_KT = 8192, G1_V = 16384, G1_O = 32768, G1_STRIDE = 66560;
template <int MODE>
DI void gla_pair(const Ctx& F, const int ua, const int ub) {
  const int tid = F.tid, lane = F.lane, w = F.wave;
  const bf16_t* Z = (const bf16_t*)(F.ws + WS_Z);
  const int t = tid >> 3, c8 = tid & 7;
  const int r32 = lane & 31, hi = lane >> 5, i16 = lane & 15, g16 = lane >> 4;
  const int un[2] = {ua, ub};
  __syncthreads();
  if constexpr (MODE == 0) {
    u32x4 q8[2], k8[2];
#pragma unroll
    for (int s = 0; s < 2; ++s) {
      const int unit = un[s], c = unit & 127, h = (unit >> 7) & 3, b = unit >> 9; const size_t m0 = (size_t)b * T + (size_t)c * 64;
      LAS unsigned char* L = F.lds + s * G0_STRIDE;
      const bf16_t* zrow = Z + (m0 + t) * ZP;
      q8[s] = *(const u32x4*)(zrow + C_GQ + h * 64 + c8 * 8); k8[s] = *(const u32x4*)(zrow + C_GK + h * 64 + c8 * 8);
      const u32x4 v0 = *(const u32x4*)(zrow + C_GV + h * 128 + c8 * 8), v1 = *(const u32x4*)(zrow + C_GV + h * 128 + 64 + c8 * 8);
      *(LAS u32x4*)(L + GL_V + t * 256 + c8 * 16) = v0; *(LAS u32x4*)(L + GL_V + t * 256 + 128 + c8 * 16) = v1;
      if (tid < 128) { const int tt = tid >> 1, hf = tid & 1; const u32x4 g = *(const u32x4*)(Z + (m0 + tt) * ZP + C_GLR + hf * 8);
        LAS float* o = (LAS float*)(L + GL_GLR) + tt * 16 + hf * 8; o[0] = bflo(g.x); o[1] = bfhi(g.x); o[2] = bflo(g.y); o[3] = bfhi(g.y); o[4] = bflo(g.z); o[5] = bfhi(g.z); o[6] = bflo(g.w); o[7] = bfhi(g.w); }
      if (tid < 256) { const int r = tid >> 4, c4 = tid & 15; *(LAS f32x4*)((LAS float*)(L + GL_W2) + r * 64 + c4 * 4) = *(const f32x4*)(F.in[I_GW2] + r * 256 + h * 64 + c4 * 4); }
      if (tid < 64) ((LAS float*)(L + GL_BIAS))[tid] = F.in[I_GB][h * 64 + tid];
    }
    __syncthreads();
#pragma unroll
    for (int s = 0; s < 2; ++s) {
      LAS unsigned char* L = F.lds + s * G0_STRIDE;
      LAS float* LA = (LAS float*)(L + GL_LA); const LAS float* GLR = (const LAS float*)(L + GL_GLR); const LAS float* W2 = (const LAS float*)(L + GL_W2); const LAS float* BIAS = (const LAS float*)(L + GL_BIAS);
      float z[8];
#pragma unroll
      for (int j = 0; j < 8; ++j) z[j] = BIAS[c8 * 8 + j];
#pragma unroll
      for (int r = 0; r < 16; ++r) { const float g = GLR[t * 16 + r];
#pragma unroll
        for (int j = 0; j < 8; ++j) z[j] += g * W2[r * 64 + c8 * 8 + j]; }
#pragma unroll
      for (int j = 0; j < 8; ++j) { const float zz = z[j]; const float ls = fminf(zz, 0.f) - __logf(1.f + __expf(-fabsf(zz))); LA[t * 64 + c8 * 8 + j] = ls * (1.f / 16.f); }
    }
    __syncthreads();
    {
      const int d = tid & 63, seg = tid >> 6; float v[2][8];
#pragma unroll
      for (int s = 0; s < 2; ++s) { LAS unsigned char* L = F.lds + s * G0_STRIDE; const LAS float* LA = (const LAS float*)(L + GL_LA); float run = 0.f;
#pragma unroll
        for (int i = 0; i < 8; ++i) { run += LA[(seg * 8 + i) * 64 + d]; v[s][i] = run; }
        ((LAS float*)(L + GL_SEG))[seg * 64 + d] = run; }
      __syncthreads();
#pragma unroll
      for (int s = 0; s < 2; ++s) { LAS unsigned char* L = F.lds + s * G0_STRIDE; LAS float* LA = (LAS float*)(L + GL_LA); const LAS float* SEG = (const LAS float*)(L + GL_SEG); float off = 0.f;
#pragma unroll
        for (int q = 0; q < 8; ++q) off += (q < seg) ? SEG[q * 64 + d] : 0.f;
#pragma unroll
        for (int i = 0; i < 8; ++i) LA[(seg * 8 + i) * 64 + d] = v[s][i] + off; }
    }
    __syncthreads();
#pragma unroll
    for (int s = 0; s < 2; ++s) {
      const int unit = un[s]; LAS unsigned char* L = F.lds + s * G0_STRIDE; const LAS float* LA = (const LAS float*)(L + GL_LA);
      float bb[8];
#pragma unroll
      for (int j = 0; j < 8; ++j) bb[j] = LA[t * 64 + c8 * 8 + j];
      const unsigned qw[4] = {q8[s].x, q8[s].y, q8[s].z, q8[s].w}, kw[4] = {k8[s].x, k8[s].y, k8[s].z, k8[s].w};
      u32x4 qo, ko; unsigned kk16[8];
#pragma unroll
      for (int p = 0; p < 4; ++p) {
        const float e0 = __expf(bb[2 * p]), e1 = __expf(bb[2 * p + 1]);
        const unsigned qp = cvtpk(bflo(qw[p]) * e0, bfhi(qw[p]) * e1), kp = cvtpk(bflo(kw[p]) / e0, bfhi(kw[p]) / e1);
        qo[p] = qp; ko[p] = kp; kk16[2 * p] = kp & 0xffffu; kk16[2 * p + 1] = kp >> 16;
      }
      *(u32x4*)((bf16_t*)(F.ws + WS_GQ) + (size_t)unit * 4096 + t * 64 + c8 * 8) = qo;
      *(u32x4*)((bf16_t*)(F.ws + WS_GK) + (size_t)unit * 4096 + t * 64 + c8 * 8) = ko;
#pragma unroll
      for (int j = 0; j < 8; ++j) { const int d = c8 * 8 + j; *(LAS unsigned short*)(L + GL_KTT + d * 128 + (((t >> 3) ^ (d & 7)) << 4) + (t & 7) * 2) = (unsigned short)kk16[j]; }
    }
    __syncthreads();
#pragma unroll
    for (int s = 0; s < 2; ++s) {
      const int unit = un[s]; LAS unsigned char* L = F.lds + s * G0_STRIDE;
      const int dvt = w >> 1, dt = w & 1; f32x16 acc = {}; const int dcol = 32 * dt + r32;
#pragma unroll
      for (int ks = 0; ks < 4; ++ks) {
        const LAS unsigned char* vp = L + GL_V + (16 * ks + 8 * hi + (i16 >> 2)) * 256 + (32 * dvt + 16 * (g16 & 1) + 4 * (i16 & 3)) * 2;
        const bf16x8 a = cat8(vtr(vp), vtr(vp + 4 * 256));
        const bf16x8 bfr = *(const LAS bf16x8*)(L + GL_KTT + dcol * 128 + (((2 * ks + hi) ^ (dcol & 7)) << 4));
        acc = MFMA32(a, bfr, acc);
      }
      float* U = (float*)(F.ws + WS_GU) + (size_t)unit * 8192;
#pragma unroll
      for (int r = 0; r < 16; ++r) U[(32 * dvt + crow(r, hi)) * 64 + dcol] = acc[r];
      if (tid < 64) ((float*)(F.ws + WS_DL))[unit * 64 + tid] = __expf(((const LAS float*)(L + GL_LA))[63 * 64 + tid]);
    }
  } else {
    u32x4 gr0[2], gr1[2]; bf16x8 sf[2][4];
#pragma unroll
    for (int s = 0; s < 2; ++s) {
      const int unit = un[s], c = unit & 127, h = (unit >> 7) & 3, b = unit >> 9; const size_t m0 = (size_t)b * T + (size_t)c * 64;
      LAS unsigned char* L = F.lds + s * G1_STRIDE;
      const bf16_t* zrow = Z + (m0 + t) * ZP;
      const u32x4 qo = *(const u32x4*)((const bf16_t*)(F.ws + WS_GQ) + (size_t)unit * 4096 + t * 64 + c8 * 8);
      const u32x4 ko = *(const u32x4*)((const bf16_t*)(F.ws + WS_GK) + (size_t)unit * 4096 + t * 64 + c8 * 8);
      const u32x4 v0 = *(const u32x4*)(zrow + C_GV + h * 128 + c8 * 8), v1 = *(const u32x4*)(zrow + C_GV + h * 128 + 64 + c8 * 8);
      const int seg = tid & 7;
      gr0[s] = *(const u32x4*)(zrow + C_GR + h * 128 + seg * 16); gr1[s] = *(const u32x4*)(zrow + C_GR + h * 128 + seg * 16 + 8);
      const bf16_t* S = (const bf16_t*)(F.ws + WS_GS) + (size_t)unit * 8192;
#pragma unroll
      for (int kd = 0; kd < 4; ++kd) sf[s][kd] = *(const bf16x8*)(S + (32 * (w >> 1) + r32) * 64 + 16 * kd + 8 * hi);
      const int swz = (c8 ^ (t & 7)) << 4;
      *(LAS u32x4*)(L + G1_QT + t * 128 + swz) = qo; *(LAS u32x4*)(L + G1_KT + t * 128 + swz) = ko;
      *(LAS u32x4*)(L + G1_V + t * 256 + c8 * 16) = v0; *(LAS u32x4*)(L + G1_V + t * 256 + 128 + c8 * 16) = v1;
    }
    __syncthreads();
#pragma unroll
    for (int s = 0; s < 2; ++s) {
      const int unit = un[s], c = unit & 127; LAS unsigned char* L = F.lds + s * G1_STRIDE;
      const int dvt = w >> 1, tt = w & 1; f32x16 o = {}; const int tcol = 32 * tt + r32;
      for (int st = 0; st <= tt; ++st) {
        f32x16 x = {}; const int srow = 32 * st + r32;
#pragma unroll
        for (int kd = 0; kd < 4; ++kd) {
          const bf16x8 a = *(const LAS bf16x8*)(L + G1_KT + srow * 128 + (((2 * kd + hi) ^ (srow & 7)) << 4));
          const bf16x8 bfr = *(const LAS bf16x8*)(L + G1_QT + tcol * 128 + (((2 * kd + hi) ^ (tcol & 7)) << 4));
          x = MFMA32(a, bfr, x);
        }
        if (st == tt) {
#pragma unroll
          for (int r = 0; r < 16; ++r) if (crow(r, hi) > r32) x[r] = 0.f;
        }
#pragma unroll
        for (int ks2 = 0; ks2 < 2; ++ks2) {
          const LAS unsigned char* vp = L + G1_V + (32 * st + 16 * ks2 + 4 * hi + (i16 >> 2)) * 256 + (32 * dvt + 16 * (g16 & 1) + 4 * (i16 & 3)) * 2;
          const bf16x8 a = cat8(vtr(vp), vtr(vp + 8 * 256));
          o = MFMA32(a, pack8(x, ks2), o);
        }
      }
      if (c > 0) {
#pragma unroll
        for (int kd = 0; kd < 4; ++kd) {
          const bf16x8 bfr = *(const LAS bf16x8*)(L + G1_QT + tcol * 128 + (((2 * kd + hi) ^ (tcol & 7)) << 4));
          o = MFMA32(sf[s][kd], bfr, o);
        }
      }
      LAS float* OL = (LAS float*)(L + G1_O);
#pragma unroll
      for (int r = 0; r < 16; ++r) OL[tcol * 129 + 32 * dvt + crow(r, hi)] = o[r];
    }
    __syncthreads();
#pragma unroll
    for (int s = 0; s < 2; ++s) {
      const int unit = un[s], c = unit & 127, h = (unit >> 7) & 3, b = unit >> 9; const size_t m0 = (size_t)b * T + (size_t)c * 64;
      const LAS float* OL = (const LAS float*)(F.lds + s * G1_STRIDE + G1_O);
      const int seg = tid & 7; float v[16]; float ss = 0.f;
#pragma unroll
      for (int j = 0; j < 16; ++j) { v[j] = OL[t * 129 + seg * 16 + j]; ss += v[j] * v[j]; }
      ss += __shfl_xor(ss, 1); ss += __shfl_xor(ss, 2); ss += __shfl_xor(ss, 4);
      const float rs = rsqrtf(ss * (1.f / 128.f) + EPS);
      const unsigned gw_[8] = {gr0[s].x, gr0[s].y, gr0[s].z, gr0[s].w, gr1[s].x, gr1[s].y, gr1[s].z, gr1[s].w};
      const float* on = F.in[I_GON] + seg * 16;
      unsigned ow[8];
#pragma unroll
      for (int p = 0; p < 8; ++p) { const float ga = bflo(gw_[p]), gb = bfhi(gw_[p]);
        const float oa = v[2 * p] * rs * on[2 * p] * (ga * sigmoidf_(ga)), ob = v[2 * p + 1] * rs * on[2 * p + 1] * (gb * sigmoidf_(gb)); ow[p] = cvtpk(oa, ob); }
      bf16_t* dst = (bf16_t*)(F.ws + WS_OCAT) + (m0 + t) * DM + h * 128 + seg * 16;
      *(u32x4*)dst = (u32x4){ow[0], ow[1], ow[2], ow[3]}; *(u32x4*)(dst + 8) = (u32x4){ow[4], ow[5], ow[6], ow[7]};
    }
  }
}
template <int MODE>
DI void gla_phase(const Ctx& F0) {
  const Ctx F = fresh(F0);
  const int bx = blockIdx.x, G = F.G;
  const int nu = bx < 2048 ? (2048 - bx + G - 1) / G : 0;
#pragma unroll 1
  for (int i = 0; i < nu; i += 2) gla_pair<MODE>(F, bx + i * G, bx + (i + 1 < nu ? i + 1 : i) * G);
}
DI void gla_scan(const Ctx& F0) {
  const Ctx F = fresh(F0);
  const float* U = (const float*)(F.ws + WS_GU); const float* DL = (const float*)(F.ws + WS_DL); bf16_t* GS = (bf16_t*)(F.ws + WS_GS);
  for (int e = blockIdx.x * NTHREADS + F.tid; e < 16 * 8192; e += F.G * NTHREADS) {
    const int bh = e >> 13, rem = e & 8191, d = e & 63;
    float S = 0.f;
#pragma unroll 8
    for (int c = 0; c < 128; ++c) { const size_t unit = (size_t)bh * 128 + c;
      GS[unit * 8192 + rem] = (bf16_t)f2bf(S);
      S = DL[unit * 64 + d] * (S + U[unit * 8192 + rem]); }
  }
}

DI void nsa_compress_unit(const Ctx& F0, const int wt) {
  const Ctx F = fresh(F0);
  const int lane = F.lane, w = F.wave, r32 = lane & 31, hi = lane >> 5;
  const int kv = wt >> 7, nt = wt & 127, bg = nt >> 4, n0 = (nt & 15) * 32, b = bg >> 1, g = bg & 1;
  const bf16_t* Z = (const bf16_t*)(F.ws + WS_Z);
  const bf16_t* W1T = (const bf16_t*)(F.ws + WS_W1T) + (size_t)kv * 128 * 2048;
  const bf16_t* W2T = (const bf16_t*)(F.ws + WS_W2T) + (size_t)kv * 64 * 128;
  const float* C1 = (const float*)(F.ws + WS_C1) + kv * 128;
  const int col0 = (kv ? C_VC : C_KC) + g * 64;
  const int n = n0 + r32;
  LAS float* RED = (LAS float*)F.lds;
  __syncthreads();
  f32x16 acc[4] = {};
#pragma unroll
  for (int ll = 0; ll < 4; ++ll) {
    const int l = 4 * w + ll;
    int trow = 16 * n + l; trow = trow > T - 1 ? T - 1 : trow;
    const bf16_t* src = Z + ((size_t)b * T + trow) * ZP + col0 + 8 * hi;
#pragma unroll
    for (int q = 0; q < 4; ++q) {
      const int ks = 4 * l + q;
      const bf16x8 bfr = *(const bf16x8*)(src + 16 * q);
#pragma unroll
      for (int ht = 0; ht < 4; ++ht) { const bf16x8 a = *(const bf16x8*)(W1T + (size_t)(32 * ht + r32) * 2048 + 16 * ks + 8 * hi); acc[ht] = MFMA32(a, bfr, acc[ht]); }
    }
  }
#pragma unroll
  for (int ht = 0; ht < 4; ++ht)
#pragma unroll
    for (int r = 0; r < 16; ++r) RED[w * 4096 + (ht * 16 + r) * 64 + lane] = acc[ht][r];
  __syncthreads();
  if (w == 0) {
    bf16x8 pb[4][2];
#pragma unroll
    for (int ht = 0; ht < 4; ++ht) {
#pragma unroll
      for (int r = 0; r < 16; ++r) { float sm = 0.f;
#pragma unroll
        for (int ww = 0; ww < 8; ++ww) sm += RED[ww * 4096 + (ht * 16 + r) * 64 + lane];
        acc[ht][r] = gelu_tanh(sm + C1[32 * ht + crow(r, hi)]); }
      pb[ht][0] = pack8(acc[ht], 0); pb[ht][1] = pack8(acc[ht], 1);
    }
    bf16_t* OUT = (bf16_t*)(F.ws + (kv ? WS_VCMP : WS_KCMP)) + ((size_t)bg * 512 + n) * 64;
#pragma unroll
    for (int dt = 0; dt < 2; ++dt) {
      f32x16 o = {};
#pragma unroll
      for (int ht = 0; ht < 4; ++ht)
#pragma unroll
        for (int ks2 = 0; ks2 < 2; ++ks2) {
          const bf16_t* wp = W2T + (size_t)(32 * dt + r32) * 128 + 32 * ht + 16 * ks2 + 4 * hi;
          const u32x2 lo = *(const u32x2*)wp, hi2 = *(const u32x2*)(wp + 8);
          const u32x4 aw = {lo.x, lo.y, hi2.x, hi2.y};
          o = MFMA32(__builtin_bit_cast(bf16x8, aw), pb[ht][ks2], o);
        }
#pragma unroll
      for (int rr = 0; rr < 4; ++rr) { u32x2 wv; wv.x = cvtpk(o[4 * rr], o[4 * rr + 1]); wv.y = cvtpk(o[4 * rr + 2], o[4 * rr + 3]); *(u32x2*)(OUT + 32 * dt + 8 * rr + 4 * hi) = wv; }
    }
  }
  __syncthreads();
}

constexpr int NS_K = 0, NS_V = 32768, NS_IMP = 65536, NS_MASK = 99328, NS_BUCK = 100352, NS_BIAS = 108544, NS_THR = 109056, NS_WB = 109184;
constexpr int IMP_P = 132;
constexpr int NS_X3 = NS_IMP;
struct TileSrc { const bf16_t* k; const bf16_t* v; int pitch; };
DI void ns_load(u32x4& kr, u32x4& vr, const TileSrc& s, int row0, int tid) {
  const int key = tid >> 3, c8 = tid & 7;
  kr = *(const u32x4*)(s.k + (size_t)(row0 + key) * s.pitch + c8 * 8);
  vr = *(const u32x4*)(s.v + (size_t)(row0 + key) * s.pitch + c8 * 8);
}
DI void ns_store(LAS unsigned char* L, int buf, const u32x4& kr, const u32x4& vr, int tid) {
  const int key = tid >> 3, c8 = tid & 7;
  *(LAS u32x4*)(L + NS_K + buf * 8192 + key * 128 + ((c8 ^ ((key >> 1) & 7)) << 4)) = kr;
  *(LAS u32x4*)(L + NS_V + buf * 8192 + key * 128 + ((c8 * 16) ^ (((key >> 1) & 1) << 6))) = vr;
}
DI void ns_qk(f32x16& p0, f32x16& p1, const LAS unsigned char* Kb, const bf16x8 (&qf)[4], int r32, int hi) {
  p0 = (f32x16){}; p1 = (f32x16){};
#pragma unroll
  for (int ks = 0; ks < 4; ++ks) {
    const bf16x8 a0 = *(const LAS bf16x8*)(Kb + r32 * 128 + (((2 * ks + hi) ^ ((r32 >> 1) & 7)) << 4));
    const bf16x8 a1 = *(const LAS bf16x8*)(Kb + (32 + r32) * 128 + (((2 * ks + hi) ^ ((r32 >> 1) & 7)) << 4));
    p0 = MFMA32(a0, qf[ks], p0); p1 = MFMA32(a1, qf[ks], p1);
  }
}
DI void ns_pv(f32x16 (&o)[2], const LAS unsigned char* Vb, const f32x16& p0, const f32x16& p1, int lane) {
  const int hi = lane >> 5, i16 = lane & 15, g16 = lane >> 4;
#pragma unroll
  for (int ks = 0; ks < 4; ++ks) {
    const bf16x8 pb = pack8(ks < 2 ? p0 : p1, ks & 1);
#pragma unroll
    for (int dt = 0; dt < 2; ++dt) {
      const int vrow = 16 * ks + 4 * hi + (i16 >> 2);
      const LAS unsigned char* vp = Vb + vrow * 128 + (((32 * dt + 16 * (g16 & 1) + 4 * (i16 & 3)) * 2) ^ (((vrow >> 1) & 1) << 6));
      o[dt] = MFMA32(cat8(vtr(vp), vtr(vp + 8 * 128)), pb, o[dt]);
    }
  }
}
DI void ns_dma(LAS unsigned char* L, int kslot_off, int vslot_off, const TileSrc& s, int row0, int lane, int w) {
  const int row = 8 * w + (lane >> 3), pc = lane & 7;
  const bf16_t* kp = s.k + (size_t)(row0 + row) * s.pitch + ((pc ^ ((row >> 1) & 7)) << 3);
  const bf16_t* vp = s.v + (size_t)(row0 + row) * s.pitch + ((pc ^ (((row >> 1) & 1) << 2)) << 3);
  __builtin_amdgcn_global_load_lds((const unsigned*)kp, (LAS unsigned*)(L + kslot_off + w * 1024), 16, 0, 0);
  __builtin_amdgcn_global_load_lds((const unsigned*)vp, (LAS unsigned*)(L + vslot_off + w * 1024), 16, 0, 0);
}
DI float ns_bias(const LAS unsigned char* L, int hd, int dist) {
  const int dc = dist < 0 ? 0 : dist;
  const int bk = *(const LAS unsigned char*)(L + NS_BUCK + dc);
  return ((const LAS float*)(L + NS_BIAS))[bk * 4 + hd];
}
DI float ex2(float x) { return __builtin_amdgcn_exp2f(x); }

DI void nsa_unit(const Ctx& F0, const int bg, const int tile) {
  const Ctx F = fresh(F0);
  const int tid = F.tid, lane = F.lane, w = F.wave, r32 = lane & 31, hi = lane >> 5;
  const int b = bg >> 1, g = bg & 1, t0 = tile * 64, cur = tile;
  LAS unsigned char* L = F.lds;
  const bf16_t* Z = (const bf16_t*)(F.ws + WS_Z);
  const int tokl = r32 >> 2, hd = r32 & 3, head = g * 4 + hd;
  const int t = t0 + 8 * w + tokl;
  const size_t mrow = (size_t)b * T + t;
  __syncthreads();
  for (int i = tid; i < 2048; i += NTHREADS) ((LAS unsigned*)(L + NS_BUCK))[i] = ((const unsigned*)(F.ws + WS_BUCK))[i];
  if (tid < 128) ((LAS float*)(L + NS_BIAS))[tid] = F.in[I_RELB][(tid >> 2) * 8 + g * 4 + (tid & 3)] * 1.4426950408889634f;
  if (tid < 32) { const int thr[32] = {0, 1, 2, 3, 4, 5, 6, 7, 8, 9, 10, 11, 12, 13, 14, 15, 16, 22, 30, 40, 54, 73, 99, 134, 182, 246, 332, 450, 609, 825, 1117, 1513};
    int v = 0;
#pragma unroll
    for (int k = 0; k < 32; ++k) v = (tid == k) ? thr[k] : v;
    ((LAS int*)(L + NS_THR))[tid] = v; }
  __syncthreads();
  for (int i = tid; i < 4 * 576; i += NTHREADS) { const int hh = i / 576, d = i - hh * 576; ((LAS float*)(L + NS_WB))[hh * 577 + d] = ((const LAS float*)(L + NS_BIAS))[(int)*(const LAS unsigned char*)(L + NS_BUCK + d) * 4 + hh]; }
  bf16x8 qf[4];
#pragma unroll
  for (int ks = 0; ks < 4; ++ks) qf[ks] = *(const bf16x8*)(Z + mrow * ZP + C_NQ + head * 64 + 16 * ks + 8 * hi);
  float gate[3];
#pragma unroll
  for (int i = 0; i < 3; ++i) gate[i] = sigmoidf_(bf2f(Z[mrow * ZP + C_NG + head * 3 + i]));
  f32x16 tot[2] = {};
  u32x4 kr, vr;

  const int nmax = (t0 + 32) >> 4;
  const int nct = (nmax >> 6) + 1;
  TileSrc sc; sc.k = (const bf16_t*)(F.ws + WS_KCMP) + (size_t)bg * 512 * 64; sc.v = (const bf16_t*)(F.ws + WS_VCMP) + (size_t)bg * 512 * 64; sc.pitch = 64;
  float m_c = -1e30f, l_c = 0.f;
  u32x4 kr2 = {}, vr2 = {};
  ns_load(kr, vr, sc, 0, tid); ns_store(L, 0, kr, vr, tid); ns_load(kr, vr, sc, nct > 1 ? 64 : 0, tid); __syncthreads();
  auto step1 = [&](const int ci, u32x4& kA, u32x4& vA, u32x4& kB, u32x4& vB) {
    ns_load(kB, vB, sc, 64 * (ci + 2 < nct ? ci + 2 : nct - 1), tid);
    f32x16 p0, p1; ns_qk(p0, p1, L + NS_K + (ci & 1) * 8192, qf, r32, hi);
    float mt = -1e30f;
    if (t0 + 8 * w - 31 - 16 * (64 * ci + 63) >= 1513) {
      const float b31 = ((const LAS float*)(L + NS_BIAS))[31 * 4 + hd];
#pragma unroll
      for (int r = 0; r < 16; ++r) { p0[r] += b31; p1[r] += b31; mt = fmaxf(mt, fmaxf(p0[r], p1[r])); }
    } else {
#pragma unroll
    for (int hf = 0; hf < 2; ++hf)
#pragma unroll
      for (int r = 0; r < 16; ++r) { const int n = 64 * ci + 32 * hf + crow(r, hi); const int dist = t - 16 * n - 31;
        float s = (hf ? p1[r] : p0[r]) + ns_bias(L, hd, dist); s = dist >= 0 ? s : -INFINITY; if (hf) p1[r] = s; else p0[r] = s; mt = fmaxf(mt, s); }
    }
    const float mn = fmaxf(m_c, mt); float sum = 0.f;
#pragma unroll
    for (int r = 0; r < 16; ++r) sum += ex2(p0[r] - mn) + ex2(p1[r] - mn);
    l_c = l_c * ex2(m_c - mn) + sum; m_c = mn;
    ns_store(L, (ci + 1) & 1, kA, vA, tid);
    __syncthreads();
  };
  for (int ci = 0; ci < nct; ci += 2) { step1(ci, kr, vr, kr2, vr2); if (ci + 1 < nct) step1(ci + 1, kr2, vr2, kr, vr); }
  { const float mo = __shfl_xor(m_c, 32), lo = __shfl_xor(l_c, 32); const float mn = fmaxf(m_c, mo); l_c = l_c * ex2(m_c - mn) + lo * ex2(mo - mn); m_c = mn; }
  const float inv_lc = l_c > 0.f ? 1.f / l_c : 0.f;
  {
    f32x16 oc[2] = {};
    float carry = 0.f;
    LAS float* IMP = (LAS float*)(L + NS_IMP);
    ns_load(kr, vr, sc, 0, tid); ns_store(L, 0, kr, vr, tid); ns_load(kr, vr, sc, nct > 1 ? 64 : 0, tid); __syncthreads();
    auto step2 = [&](const int ci, u32x4& kA, u32x4& vA, u32x4& kB, u32x4& vB) {
      ns_load(kB, vB, sc, 64 * (ci + 2 < nct ? ci + 2 : nct - 1), tid);
      f32x16 p0, p1; ns_qk(p0, p1, L + NS_K + (ci & 1) * 8192, qf, r32, hi);
      if (t0 + 8 * w - 31 - 16 * (64 * ci + 63) >= 1513) {
        const float bm = ((const LAS float*)(L + NS_BIAS))[31 * 4 + hd] - m_c;
#pragma unroll
        for (int r = 0; r < 16; ++r) { p0[r] = ex2(p0[r] + bm) * inv_lc; p1[r] = ex2(p1[r] + bm) * inv_lc; }
      } else {
#pragma unroll
      for (int hf = 0; hf < 2; ++hf)
#pragma unroll
        for (int r = 0; r < 16; ++r) { const int n = 64 * ci + 32 * hf + crow(r, hi); const int dist = t - 16 * n - 31;
          const float s = (hf ? p1[r] : p0[r]) + ns_bias(L, hd, dist); const float p = dist >= 0 ? ex2(s - m_c) * inv_lc : 0.f; if (hf) p1[r] = p; else p0[r] = p; }
      }
      ns_pv(oc, L + NS_V + (ci & 1) * 8192, p0, p1, lane);
      float x[2][4];
#pragma unroll
      for (int rr = 0; rr < 4; ++rr) { x[0][rr] = __shfl_xor(p0[4 * rr + 3], 32); x[1][rr] = __shfl_xor(p1[4 * rr + 3], 32); }
#pragma unroll
      for (int hf = 0; hf < 2; ++hf)
#pragma unroll
        for (int rr = 0; rr < 4; ++rr) {
          const f32x16& pp = hf ? p1 : p0;
          float part = pp[4 * rr] + pp[4 * rr + 1] + pp[4 * rr + 2] + 0.5f * pp[4 * rr + 3];
          const float prev_lo = rr > 0 ? x[hf][rr > 0 ? rr - 1 : 0] : (hf ? x[0][3] : carry);
          const float cross = hi ? x[hf][rr] : prev_lo;
          part += 0.5f * cross;
          part += __shfl_xor(part, 1); part += __shfl_xor(part, 2);
          if (hd == 0) IMP[(8 * w + tokl) * IMP_P + 16 * ci + 8 * hf + 2 * rr + hi] = part;
        }
      carry = x[1][3];
      ns_store(L, (ci + 1) & 1, kA, vA, tid);
      __syncthreads();
    };
    for (int ci = 0; ci < nct; ci += 2) { step2(ci, kr, vr, kr2, vr2); if (ci + 1 < nct) step2(ci + 1, kr2, vr2, kr, vr); }
#pragma unroll
    for (int dt = 0; dt < 2; ++dt)
#pragma unroll
      for (int r = 0; r < 16; ++r) tot[dt][r] = gate[0] * oc[dt][r];
  }
  {
    const int tk = 8 * w + (lane >> 3), seg = lane & 7;
    unsigned m0 = 0, m1 = 0, m2 = 0, m3 = 0;
    auto setbit = [&](int j) { const unsigned bit = 1u << (j & 31); const int wd = j >> 5; m0 |= wd == 0 ? bit : 0u; m1 |= wd == 1 ? bit : 0u; m2 |= wd == 2 ? bit : 0u; m3 |= wd == 3 ? bit : 0u; };
    if (cur <= 15) { m0 = (2u << cur) - 1u; }
    else {
      const LAS float* IMP = (const LAS float*)(L + NS_IMP) + tk * IMP_P + 16 * seg;
      int top[16];
#pragma unroll
      for (int i = 0; i < 16; ++i) { const int j = 16 * seg + i; const int key = (int)((__float_as_uint(IMP[i]) & ~127u) | (unsigned)(127 - j)); top[i] = (j >= 1 && j <= cur - 2) ? key : -1; }
      sort16_desc(top);
#pragma unroll
      for (int o = 1; o < 8; o <<= 1) { int oth[16];
#pragma unroll
        for (int i = 0; i < 16; ++i) oth[i] = __shfl_xor(top[i], o);
        merge16_top(top, oth); }
      setbit(0); setbit(cur); setbit(cur - 1);
#pragma unroll
      for (int i = 0; i < 13; ++i) setbit(127 - (top[i] & 127));
    }
    if (seg == 0) *(LAS u32x4*)(L + NS_MASK + tk * 16) = (u32x4){m0, m1, m2, m3};
  }
  __syncthreads();
  const u32x4 mk = *(const LAS u32x4*)(L + NS_MASK + (8 * w + tokl) * 16);

  {
    TileSrc ss; ss.k = Z + (size_t)b * T * ZP + C_KS + g * 64; ss.v = Z + (size_t)b * T * ZP + C_VS + g * 64; ss.pitch = ZP;
    float m_s = -1e30f, l_s = 0.f; f32x16 os[2] = {};
    const int npair = (cur >> 1) + 1;
    auto selbit = [&](int j) -> bool { const unsigned wsel = (j >> 5) == 0 ? mk.x : ((j >> 5) == 1 ? mk.y : ((j >> 5) == 2 ? mk.z : mk.w)); return ((wsel >> (j & 31)) & 1u) != 0u; };
    auto bias_mask = [&](f32x16& p0, f32x16& p1, const int j, const bool sel) -> float {
      float mt = -1e30f;
      const int dmin = t0 + 8 * w - (64 * j + 63), dmax = t0 + 8 * w + 7 - 64 * j;
      if (dmin >= 246) {
        const int blo = *(const LAS unsigned char*)(L + NS_BUCK + dmin), bhi = *(const LAS unsigned char*)(L + NS_BUCK + dmax);
        float b_lo = ((const LAS float*)(L + NS_BIAS))[blo * 4 + hd], b_hi = ((const LAS float*)(L + NS_BIAS))[bhi * 4 + hd];
        b_lo = sel ? b_lo : -INFINITY; b_hi = sel ? b_hi : -INFINITY;
        if (blo == bhi) {
#pragma unroll
          for (int r = 0; r < 16; ++r) { p0[r] += b_lo; p1[r] += b_lo; mt = fmaxf(mt, fmaxf(p0[r], p1[r])); }
        } else {
          const int thr = ((const LAS int*)(L + NS_THR))[bhi]; const int db = t - 64 * j - 4 * hi;
#pragma unroll
          for (int r = 0; r < 16; ++r) { const int d0 = db - ((r & 3) + 8 * (r >> 2));
            p0[r] += (d0 >= thr) ? b_hi : b_lo; p1[r] += (d0 - 32 >= thr) ? b_hi : b_lo; mt = fmaxf(mt, fmaxf(p0[r], p1[r])); }
        }
      } else {
#pragma unroll
        for (int hf = 0; hf < 2; ++hf)
#pragma unroll
          for (int r = 0; r < 16; ++r) { const int dist = t - (64 * j + 32 * hf + crow(r, hi));
            float sv = (hf ? p1[r] : p0[r]) + ns_bias(L, hd, dist); sv = (sel && dist >= 0) ? sv : -INFINITY; if (hf) p1[r] = sv; else p0[r] = sv; mt = fmaxf(mt, sv); }
      }
      return mt;
    };
    auto new_max = [&](float mt) {
      mt = fmaxf(mt, __shfl_xor(mt, 32));
      if (__any(mt > m_s)) {
        const float mn = fmaxf(m_s, mt), al = ex2(m_s - mn); l_s *= al; m_s = mn;
#pragma unroll
        for (int dt = 0; dt < 2; ++dt)
#pragma unroll
          for (int r = 0; r < 16; ++r) os[dt][r] *= al;
      }
    };
    auto expsum = [&](f32x16& p0, f32x16& p1) { float sum = 0.f;
#pragma unroll
      for (int r = 0; r < 16; ++r) { p0[r] = ex2(p0[r] - m_s); p1[r] = ex2(p1[r] - m_s); sum += p0[r] + p1[r]; }
      l_s += sum; };
    auto kslot = [&](int pp, int idx) -> int { const int q = pp % 3; return (q == 2 ? NS_X3 : NS_K + q * 16384) + idx * 8192; };
    auto vslot = [&](int pp, int idx) -> int { const int q = pp % 3; return (q == 2 ? NS_X3 + 16384 : NS_V + q * 16384) + idx * 8192; };
    auto issue = [&](int pp) { const int ja = 2 * pp <= cur ? 2 * pp : cur, jb = 2 * pp + 1 <= cur ? 2 * pp + 1 : cur;
      ns_dma(L, kslot(pp, 0), vslot(pp, 0), ss, 64 * ja, lane, w); ns_dma(L, kslot(pp, 1), vslot(pp, 1), ss, 64 * jb, lane, w); };
    issue(0); issue(1);
    for (int pp = 0; pp < npair; ++pp) {
      const int ja = 2 * pp, jb = ja + 1;
      asm volatile("s_waitcnt vmcnt(4) ; NSA_SLC_WAIT" ::: "memory");
      __builtin_amdgcn_s_barrier();
      asm volatile("" ::: "memory");
      issue(pp + 2);
      const int ka = kslot(pp, 0), kb = kslot(pp, 1), va = vslot(pp, 0), vb = vslot(pp, 1);
      const bool sela = selbit(ja), selb = (jb <= cur) && selbit(jb);
      const bool needa = __any(sela), needb = __any(selb);
      if (needa && needb) {
        f32x16 pa0, pa1, pb0, pb1;
        ns_qk(pa0, pa1, L + ka, qf, r32, hi); ns_qk(pb0, pb1, L + kb, qf, r32, hi);
        const float mta = bias_mask(pa0, pa1, ja, sela), mtb = bias_mask(pb0, pb1, jb, selb);
        new_max(fmaxf(mta, mtb));
        expsum(pa0, pa1); ns_pv(os, L + va, pa0, pa1, lane);
        expsum(pb0, pb1); ns_pv(os, L + vb, pb0, pb1, lane);
      } else if (needa || needb) {
        const int j1 = needa ? ja : jb, k1 = needa ? ka : kb, v1 = needa ? va : vb; const bool sel1 = needa ? sela : selb;
        f32x16 p0, p1; ns_qk(p0, p1, L + k1, qf, r32, hi);
        new_max(bias_mask(p0, p1, j1, sel1));
        expsum(p0, p1); ns_pv(os, L + v1, p0, p1, lane);
      }
      asm volatile("s_waitcnt lgkmcnt(0)" ::: "memory");
    }
    asm volatile("s_waitcnt vmcnt(0)" ::: "memory");
    __syncthreads();
    l_s += __shfl_xor(l_s, 32);
    const float sc_ = gate[1] / l_s;
#pragma unroll
    for (int dt = 0; dt < 2; ++dt)
#pragma unroll
      for (int r = 0; r < 16; ++r) tot[dt][r] += EN_SLC * sc_ * os[dt][r];
  }
  {
    TileSrc sw; sw.k = Z + (size_t)b * T * ZP + C_KW + g * 64; sw.v = Z + (size_t)b * T * ZP + C_VW + g * 64; sw.pitch = ZP;
    const int j0 = cur >= 8 ? cur - 8 : 0;
    float m_w = -1e30f, l_w = 0.f; f32x16 ow[2] = {};
    ns_load(kr, vr, sw, 64 * j0, tid); ns_store(L, 0, kr, vr, tid); ns_load(kr, vr, sw, 64 * (j0 < cur ? j0 + 1 : j0), tid); __syncthreads();
    auto step = [&](const int j, u32x4& kA, u32x4& vA, u32x4& kB, u32x4& vB) {
      const int bi = (j - j0) & 1;
      ns_load(kB, vB, sw, 64 * (j + 2 <= cur ? j + 2 : cur), tid);
      f32x16 p0, p1; ns_qk(p0, p1, L + NS_K + bi * 8192, qf, r32, hi);
      float mt = -1e30f;
      { const LAS float* WB = (const LAS float*)(L + NS_WB) + hd * 577; const int db = t - 64 * j - 4 * hi;
#pragma unroll
        for (int r = 0; r < 16; ++r) { const unsigned d0 = (unsigned)(db - ((r & 3) + 8 * (r >> 2))), d1 = d0 - 32u;
          const float s0 = p0[r] + WB[d0 < 575u ? d0 : 575u], s1 = p1[r] + WB[d1 < 575u ? d1 : 575u];
          p0[r] = d0 < 512u ? s0 : -INFINITY; p1[r] = d1 < 512u ? s1 : -INFINITY; mt = fmaxf(mt, fmaxf(p0[r], p1[r])); } }
      mt = fmaxf(mt, __shfl_xor(mt, 32));
      if (__any(mt > m_w)) {
        const float mn = fmaxf(m_w, mt), al = ex2(m_w - mn); l_w *= al; m_w = mn;
#pragma unroll
        for (int dt = 0; dt < 2; ++dt)
#pragma unroll
          for (int r = 0; r < 16; ++r) ow[dt][r] *= al;
      }
      { float sum = 0.f;
#pragma unroll
        for (int r = 0; r < 16; ++r) { p0[r] = ex2(p0[r] - m_w); p1[r] = ex2(p1[r] - m_w); sum += p0[r] + p1[r]; }
        l_w += sum; }
      ns_pv(ow, L + NS_V + bi * 8192, p0, p1, lane);
      ns_store(L, bi ^ 1, kA, vA, tid);
      __syncthreads();
    };
    for (int j = j0; j <= cur; j += 2) { step(j, kr, vr, kr2, vr2); if (j + 1 <= cur) step(j + 1, kr2, vr2, kr, vr); }
    l_w += __shfl_xor(l_w, 32);
    const float sc_ = gate[2] / l_w;
#pragma unroll
    for (int dt = 0; dt < 2; ++dt)
#pragma unroll
      for (int r = 0; r < 16; ++r) tot[dt][r] += EN_WIN * sc_ * ow[dt][r];
  }
  bf16_t* dst = (bf16_t*)(F.ws + WS_OCAT) + mrow * DM + 512 + head * 64;
#pragma unroll
  for (int dt = 0; dt < 2; ++dt)
#pragma unroll
    for (int rr = 0; rr < 4; ++rr) { u32x2 wv; wv.x = cvtpk(tot[dt][4 * rr], tot[dt][4 * rr + 1]); wv.y = cvtpk(tot[dt][4 * rr + 2], tot[dt][4 * rr + 3]); *(u32x2*)(dst + 32 * dt + 8 * rr + 4 * hi) = wv; }
}

DI int ordkey(float f) { const int s = __builtin_bit_cast(int, f); return s ^ ((s >> 31) & 0x7fffffff); }
DI float unordkey(int k) { const int s = k ^ ((k >> 31) & 0x7fffffff); return __builtin_bit_cast(float, s); }
DI void ins16(int (&top)[16], int v) {
#pragma unroll
  for (int i = 0; i < 16; ++i) { const int h = max(top[i], v); v = min(top[i], v); top[i] = h; }
}
DI void merge_pair(int (&a)[16]) {
  int c[16];
#pragma unroll
  for (int i = 0; i < 16; ++i) c[i] = max(a[i], __shfl_xor(a[15 - i], 32));
#pragma unroll
  for (int st = 8; st >= 1; st >>= 1)
#pragma unroll
    for (int i = 0; i < 16; ++i) if ((i & st) == 0) { const int x = c[i], y = c[i + st]; c[i] = max(x, y); c[i + st] = min(x, y); }
#pragma unroll
  for (int i = 0; i < 16; ++i) a[i] = c[i];
}
DI void peer_key_tile(int (&g)[16], const bf16_t* SKhp, const bf16x8 (&qf)[4], int kt, int r32, int hi) {
  f32x16 acc = {};
#pragma unroll
  for (int ks = 0; ks < 4; ++ks) { const bf16x8 a = *(const bf16x8*)(SKhp + (size_t)(32 * kt + r32) * 64 + 16 * ks + 8 * hi); acc = MFMA32(a, qf[ks], acc); }
#pragma unroll
  for (int r = 0; r < 16; ++r) { const int kidx = 32 * kt + crow(r, hi); g[r] = (ordkey(acc[r]) & ~127) | (127 - kidx); }
  sort16_desc(g);
}
DI void peer_half_topk(int (&lst)[16], const bf16_t* SKhp, const bf16_t* qrow, int r32, int hi) {
  bf16x8 qf[4];
#pragma unroll
  for (int ks = 0; ks < 4; ++ks) qf[ks] = *(const bf16x8*)(qrow + 16 * ks + 8 * hi);
  int g1[16];
  peer_key_tile(lst, SKhp, qf, 0, r32, hi); peer_key_tile(g1, SKhp, qf, 1, r32, hi); merge16_top(lst, g1);
  { int g2[16]; peer_key_tile(g1, SKhp, qf, 2, r32, hi); peer_key_tile(g2, SKhp, qf, 3, r32, hi); merge16_top(g1, g2); }
  merge16_top(lst, g1);
  merge_pair(lst);
}
constexpr int PS_IDX = 0;
DI void peer_select_unit(const Ctx& F0, const int u) {
  const Ctx F = fresh(F0);
  const int lane = F.lane, w = F.wave, r32 = lane & 31, hi = lane >> 5;
  const int tok = (u >> 1) * 256 + 32 * w + r32, hg = u & 1;
  const bf16_t* QP = (const bf16_t*)(F.ws + WS_QP) + (size_t)tok * DM;
  const bf16_t* SK = (const bf16_t*)(F.ws + WS_SK);
  LAS unsigned char* IDX = F.lds + PS_IDX + F.tid * 32;
  unsigned short* EI = (unsigned short*)(F.ws + WS_EIDX) + (size_t)tok * 128; float* GT = (float*)(F.ws + WS_GATE) + (size_t)tok * 128;
  __syncthreads();
  for (int pair = 0; pair < 2; ++pair) {
    const int hA = 4 * hg + 2 * pair;
    int l00[16], l01[16], l10[16], l11[16];
    peer_half_topk(l00, SK + (size_t)((hA * 2 + 0) * 128) * 64, QP + hA * 128, r32, hi);
    peer_half_topk(l01, SK + (size_t)((hA * 2 + 1) * 128) * 64, QP + hA * 128 + 64, r32, hi);
    peer_half_topk(l10, SK + (size_t)(((hA + 1) * 2 + 0) * 128) * 64, QP + (hA + 1) * 128, r32, hi);
    peer_half_topk(l11, SK + (size_t)(((hA + 1) * 2 + 1) * 128) * 64, QP + (hA + 1) * 128 + 64, r32, hi);
    const int hsel = hA + hi;
    float fa[16], fb[16];
#pragma unroll
    for (int i = 0; i < 16; ++i) { const int ka = hi ? l10[i] : l00[i], kb = hi ? l11[i] : l01[i];
      fa[i] = unordkey(ka & ~127); fb[i] = unordkey(kb & ~127); IDX[i] = (unsigned char)(127 - (ka & 127)); IDX[16 + i] = (unsigned char)(127 - (kb & 127)); }
    auto cand = [&](int i, int j) -> int { return (ordkey(fa[i] + fb[j]) & ~255) | (255 - (i * 16 + j)); };
    const int NEG = (int)0x80000000;
    int top[16], c1[16];
#pragma unroll
    for (int j = 0; j < 16; ++j) top[j] = cand(0, j);
    { int k = 0;
#pragma unroll
      for (int j = 0; j < 8; ++j) c1[k++] = cand(1, j);
#pragma unroll
      for (int j = 0; j < 5; ++j) c1[k++] = cand(2, j);
      c1[13] = NEG; c1[14] = NEG; c1[15] = NEG; }
    sort16_desc(c1); merge16_top(top, c1);
    c1[0] = cand(3, 0); c1[1] = cand(3, 1); c1[2] = cand(3, 2); c1[3] = cand(3, 3); c1[4] = cand(4, 0); c1[5] = cand(4, 1); c1[6] = cand(4, 2);
    c1[7] = cand(5, 0); c1[8] = cand(5, 1); c1[9] = cand(6, 0); c1[10] = cand(6, 1); c1[11] = cand(7, 0); c1[12] = cand(7, 1); c1[13] = NEG; c1[14] = NEG; c1[15] = NEG;
    sort16_desc(c1); merge16_top(top, c1);
#pragma unroll
    for (int i = 0; i < 8; ++i) { c1[i] = cand(8 + i, 0); c1[8 + i] = NEG; }
    merge16_top(top, c1);
    float sc[16]; float mx = -INFINITY;
#pragma unroll
    for (int k = 0; k < 16; ++k) { sc[k] = unordkey(top[k] & ~255); mx = fmaxf(mx, sc[k]); }
    float sum = 0.f;
#pragma unroll
    for (int k = 0; k < 16; ++k) { sc[k] = __expf(sc[k] - mx); sum += sc[k]; }
    const float inv = 1.f / sum;
    asm volatile("s_waitcnt lgkmcnt(0)" ::: "memory");
#pragma unroll
    for (int k = 0; k < 16; ++k) { const int cid = 255 - (top[k] & 255); const int e = (int)IDX[cid >> 4] * 128 + (int)IDX[16 + (cid & 15)];
      EI[hsel * 16 + k] = (unsigned short)e; GT[hsel * 16 + k] = sc[k] * inv; }
  }
}

DI void fp8x16_to_f32(const u32x4& w, float (&f)[16]) {
#pragma unroll
  for (int q = 0; q < 4; ++q) { const f32x2 lo = __builtin_amdgcn_cvt_pk_f32_fp8((int)w[q], false), hi = __builtin_amdgcn_cvt_pk_f32_fp8((int)w[q], true); f[4 * q] = lo.x; f[4 * q + 1] = lo.y; f[4 * q + 2] = hi.x; f[4 * q + 3] = hi.y; }
}
DI void treduce16(const float (&v)[16], int sel, int s, float (&w2)[2]) {
  float w8[8], w4[4];
  { const bool up = (sel & 4) != 0;
#pragma unroll
    for (int i = 0; i < 8; ++i) { const float keep = up ? v[i + 8] : v[i], send = up ? v[i] : v[i + 8]; w8[i] = keep + __shfl_xor(send, 4 * s); } }
  { const bool up = (sel & 2) != 0;
#pragma unroll
    for (int i = 0; i < 4; ++i) { const float keep = up ? w8[i + 4] : w8[i], send = up ? w8[i] : w8[i + 4]; w4[i] = keep + __shfl_xor(send, 2 * s); } }
  { const bool up = (sel & 1) != 0;
#pragma unroll
    for (int i = 0; i < 2; ++i) { const float keep = up ? w4[i + 2] : w4[i], send = up ? w4[i] : w4[i + 2]; w2[i] = keep + __shfl_xor(send, s); } }
}
struct PeerIds { unsigned ep[8]; };
struct PeerRows { u32x4 d[16]; unsigned ap[8]; u32x4 xa, xb; unsigned h; };
DI void peer_load_ids(const Ctx& F, int tok, int g, PeerIds& I) {
  const unsigned short* EI = (const unsigned short*)(F.ws + WS_EIDX) + (size_t)tok * 128 + 16 * g;
  const u32x4 a = *(const u32x4*)EI, b = *(const u32x4*)(EI + 8); I.ep[0] = a.x; I.ep[1] = a.y; I.ep[2] = a.z; I.ep[3] = a.w; I.ep[4] = b.x; I.ep[5] = b.y; I.ep[6] = b.z; I.ep[7] = b.w;
}
DI unsigned peer_eid(const PeerIds& I, int i) { return (i & 1) ? (I.ep[i >> 1] >> 16) : (I.ep[i >> 1] & 0xffffu); }
DI float peer_act(const PeerRows& R, int i) { return (i & 1) ? bfhi(R.ap[i >> 1]) : bflo(R.ap[i >> 1]); }
template <int PASS> DI void peer_load_rows(const Ctx& F, const unsigned char* TB, unsigned lo, int slice, int tok, int g, int c, const PeerIds& I, PeerRows& R) {
#pragma unroll
  for (int i = 0; i < 16; ++i) R.d[i] = *(const u32x4*)(TB + ((peer_eid(I, i) << 7) | lo));
  if (PASS == 0) { const bf16_t* xn = (const bf16_t*)(F.ws + WS_HN) + (size_t)tok * DM + 128 * slice + 16 * c; R.xa = *(const u32x4*)xn; R.xb = *(const u32x4*)(xn + 8); }
  else { const bf16_t* AC = (const bf16_t*)(F.ws + WS_ACTH) + (size_t)tok * 128 + 16 * g;
    const u32x4 a = *(const u32x4*)AC, b = *(const u32x4*)(AC + 8); R.ap[0] = a.x; R.ap[1] = a.y; R.ap[2] = a.z; R.ap[3] = a.w; R.ap[4] = b.x; R.ap[5] = b.y; R.ap[6] = b.z; R.ap[7] = b.w;
    R.h = *(const unsigned*)((const bf16_t*)(F.ws + WS_HN) + (size_t)tok * DM + 128 * slice + 16 * c + 2 * g); }
}
template <int PASS> DI void peer_compute(const Ctx& F, int slice, int tok, int g, int c, const PeerRows& R) {
  float acc[16]; float w2[2];
  if (PASS == 0) {
    float x[16];
    { const unsigned xw[8] = {R.xa.x, R.xa.y, R.xa.z, R.xa.w, R.xb.x, R.xb.y, R.xb.z, R.xb.w};
#pragma unroll
      for (int q = 0; q < 8; ++q) { x[2 * q] = bflo(xw[q]); x[2 * q + 1] = bfhi(xw[q]); } }
    float dep = 0.f;
#pragma unroll
    for (int i = 0; i < 16; ++i) { u32x4 w = R.d[i]; asm volatile("" : "+v"(w.x), "+v"(w.y), "+v"(w.z), "+v"(w.w) : "v"(dep));
      float f[16]; fp8x16_to_f32(w, f); float a = 0.f, b = 0.f;
#pragma unroll
      for (int j = 0; j < 8; ++j) { a += f[2 * j] * x[2 * j]; b += f[2 * j + 1] * x[2 * j + 1]; }
      acc[i] = a + b; dep = acc[i]; }
    treduce16(acc, c, 1, w2);
    *(f32x2*)((float*)(F.ws + WS_PART) + ((size_t)slice * NTOK + tok) * 128 + 16 * g + 2 * c) = (f32x2){w2[0], w2[1]};
  } else {
#pragma unroll
    for (int j = 0; j < 16; ++j) acc[j] = 0.f;
#pragma unroll
    for (int i = 0; i < 16; ++i) { u32x4 w = R.d[i]; asm volatile("" : "+v"(w.x), "+v"(w.y), "+v"(w.z), "+v"(w.w) : "v"(acc[15]));
      float f[16]; fp8x16_to_f32(w, f);
      const float ai = peer_act(R, i);
#pragma unroll
      for (int j = 0; j < 16; ++j) acc[j] += ai * f[j]; }
    treduce16(acc, g, 8, w2);
    *(unsigned*)((bf16_t*)(F.ws + WS_HN) + (size_t)tok * DM + 128 * slice + 16 * c + 2 * g) = cvtpk(bflo(R.h) + w2[0], bfhi(R.h) + w2[1]);
  }
}
constexpr int PEER_NBIG = (NTOK * 3 / 4) / 32, PEER_NSMALL = (NTOK / 4) / 8;
template <int PASS>
DI void peer_sliced_pass(const Ctx& F0, unsigned* cnt) {
  const Ctx F = fresh(F0);
  const int lane = F.lane, g = lane >> 3, c = lane & 7;
  const unsigned xcc = (unsigned)__builtin_amdgcn_s_getreg((3 << 11) | 20) & 7u;
  for (int s = 0; s < 8; ++s) {
    const int slice = (int)((xcc + (unsigned)s) & 7u);
    const unsigned char* TB = F.ws + (PASS == 0 ? WS_PDOWN8 : WS_PUP8) + (size_t)slice * 16384 * 128; const unsigned lo = (unsigned)(16 * c);
    for (;;) {
      unsigned ch = 0;
      if (lane == 0) ch = atomicAdd(cnt + 64 * slice, 1u);
      const int chunk = __builtin_amdgcn_readfirstlane((int)ch);
      if (chunk >= PEER_NBIG + PEER_NSMALL) break;
      const int tok0 = chunk < PEER_NBIG ? chunk * 32 : PEER_NBIG * 32 + (chunk - PEER_NBIG) * 8;
      const int nch = chunk < PEER_NBIG ? 32 : 8;
      PeerIds E0, E1; PeerRows RA, RB;
      peer_load_ids(F, tok0, g, E0);
      peer_load_ids(F, tok0 + 1, g, E1);
      peer_load_rows<PASS>(F, TB, lo, slice, tok0, g, c, E0, RA);
#pragma unroll 1
      for (int i = 0; i < nch; i += 2) {
        const int t0 = tok0 + i, t1 = t0 + 1, t2 = (i + 2 < nch) ? t0 + 2 : t0, t3 = (i + 3 < nch) ? t0 + 3 : t1;
        peer_load_rows<PASS>(F, TB, lo, slice, t1, g, c, E1, RB);
        peer_load_ids(F, t2, g, E0);
        peer_compute<PASS>(F, slice, t0, g, c, RA);
        peer_load_rows<PASS>(F, TB, lo, slice, t2, g, c, E0, RA);
        peer_load_ids(F, t3, g, E1);
        peer_compute<PASS>(F, slice, t1, g, c, RB);
      }
    }
  }
}
DI void peer_computeA_lds(LAS float* part_row, int g, int c, const PeerRows& R) {
  float acc[16]; float w2[2]; float x[16];
  { const unsigned xw[8] = {R.xa.x, R.xa.y, R.xa.z, R.xa.w, R.xb.x, R.xb.y, R.xb.z, R.xb.w};
#pragma unroll
    for (int q = 0; q < 8; ++q) { x[2 * q] = bflo(xw[q]); x[2 * q + 1] = bfhi(xw[q]); } }
  float dep = 0.f;
#pragma unroll
  for (int i = 0; i < 16; ++i) { u32x4 w = R.d[i]; asm volatile("" : "+v"(w.x), "+v"(w.y), "+v"(w.z), "+v"(w.w) : "v"(dep));
    float f[16]; fp8x16_to_f32(w, f); float a = 0.f, b = 0.f;
#pragma unroll
    for (int j = 0; j < 8; ++j) { a += f[2 * j] * x[2 * j]; b += f[2 * j + 1] * x[2 * j + 1]; }
    acc[i] = a + b; dep = acc[i]; }
  treduce16(acc, c, 1, w2);
  LAS f32x2* pp = (LAS f32x2*)(part_row + 16 * g + 2 * c);
  const f32x2 o = *pp; *pp = (f32x2){o.x + w2[0], o.y + w2[1]};
}
DI void peer_load_rowsC_lds(const Ctx& F, const unsigned char* TB, unsigned lo, int slice, int tok, const LAS unsigned* act_row, int g, int c, const PeerIds& I, PeerRows& R) {
#pragma unroll
  for (int i = 0; i < 16; ++i) R.d[i] = *(const u32x4*)(TB + ((peer_eid(I, i) << 7) | lo));
#pragma unroll
  for (int k = 0; k < 8; ++k) R.ap[k] = act_row[8 * g + k];
  R.h = *(const unsigned*)((const bf16_t*)(F.ws + WS_HN) + (size_t)tok * DM + 128 * slice + 16 * c + 2 * g);
}
DI void final_norm_token(const Ctx& F, const int tok);
DI void peer_fused_phase(const Ctx& F0) {
  const Ctx F = fresh(F0);
  const int lane = F.lane, g = lane >> 3, c = lane & 7, w = F.wave;
  const unsigned xcc = (unsigned)__builtin_amdgcn_s_getreg((3 << 11) | 20) & 7u;
  LAS float* PARTS = (LAS float*)(F.lds + w * 8192);
  LAS unsigned* ACTS = (LAS unsigned*)(F.lds + 65536 + w * 4096);
  const unsigned lo = (unsigned)(16 * c);
  __syncthreads();
#pragma unroll 1
  for (int grp = F.gw; grp < NTOK / 16; grp += F.NGW) {
    const int tok0 = grp * 16;
#pragma unroll
    for (int i = 0; i < 32; ++i) PARTS[i * 64 + lane] = 0.f;
    {
      auto tbl = [&](int q) -> const unsigned char* { return F.ws + WS_PDOWN8 + (size_t)((xcc + (unsigned)(q >> 4)) & 7u) * 16384 * 128; };
      auto slc = [&](int q) -> int { return (int)((xcc + (unsigned)(q >> 4)) & 7u); };
      PeerIds E0, E1; PeerRows RA, RB;
      peer_load_ids(F, tok0, g, E0); peer_load_ids(F, tok0 + 1, g, E1);
      peer_load_rows<0>(F, tbl(0), lo, slc(0), tok0, g, c, E0, RA);
#pragma unroll 1
      for (int q = 0; q < 128; q += 2) {
        const int q2 = q + 2 < 128 ? q + 2 : q, q3 = q + 3 < 128 ? q + 3 : q + 1;
        peer_load_rows<0>(F, tbl(q + 1), lo, slc(q + 1), tok0 + ((q + 1) & 15), g, c, E1, RB);
        peer_load_ids(F, tok0 + (q2 & 15), g, E0);
        peer_computeA_lds(PARTS + (q & 15) * 128, g, c, RA);
        peer_load_rows<0>(F, tbl(q2), lo, slc(q2), tok0 + (q2 & 15), g, c, E0, RA);
        peer_load_ids(F, tok0 + (q3 & 15), g, E1);
        peer_computeA_lds(PARTS + ((q + 1) & 15) * 128, g, c, RB);
      }
    }
    {
      const float* DSC = (const float*)(F.ws + WS_DSC); const float* USC = (const float*)(F.ws + WS_USC);
#pragma unroll 1
      for (int ti = 0; ti < 16; ++ti) { const int tok = tok0 + ti; const int p0 = 16 * g + 2 * c;
        const unsigned ee = *(const unsigned*)((const unsigned short*)(F.ws + WS_EIDX) + (size_t)tok * 128 + p0); const unsigned e0 = ee & 0xffffu, e1 = ee >> 16;
        const f32x2 gt = *(const f32x2*)((const float*)(F.ws + WS_GATE) + (size_t)tok * 128 + p0);
        const f32x2 sd = *(const LAS f32x2*)(PARTS + ti * 128 + p0);
        const float rs = pg8::row_rstd((const float*)(F.ws + WS_SSP), tok);
        ACTS[ti * 64 + 8 * g + c] = cvtpk(gelu_tanh(sd.x * rs * DSC[e0]) * gt.x * USC[e0], gelu_tanh(sd.y * rs * DSC[e1]) * gt.y * USC[e1]); }
    }
    {
      auto tbl = [&](int q) -> const unsigned char* { return F.ws + WS_PUP8 + (size_t)((xcc + (unsigned)(q >> 4)) & 7u) * 16384 * 128; };
      auto slc = [&](int q) -> int { return (int)((xcc + (unsigned)(q >> 4)) & 7u); };
      PeerIds E0, E1; PeerRows RA, RB;
      peer_load_ids(F, tok0, g, E0); peer_load_ids(F, tok0 + 1, g, E1);
      peer_load_rowsC_lds(F, tbl(0), lo, slc(0), tok0, ACTS, g, c, E0, RA);
#pragma unroll 1
      for (int q = 0; q < 128; q += 2) {
        const int q2 = q + 2 < 128 ? q + 2 : q, q3 = q + 3 < 128 ? q + 3 : q + 1;
        peer_load_rowsC_lds(F, tbl(q + 1), lo, slc(q + 1), tok0 + ((q + 1) & 15), ACTS + ((q + 1) & 15) * 64, g, c, E1, RB);
        peer_load_ids(F, tok0 + (q2 & 15), g, E0);
        peer_compute<1>(F, slc(q), tok0 + (q & 15), g, c, RA);
        peer_load_rowsC_lds(F, tbl(q2), lo, slc(q2), tok0 + (q2 & 15), ACTS + (q2 & 15) * 64, g, c, E0, RA);
        peer_load_ids(F, tok0 + (q3 & 15), g, E1);
        peer_compute<1>(F, slc(q + 1), tok0 + ((q + 1) & 15), g, c, RB);
      }
    }
    asm volatile("s_waitcnt vmcnt(0)" ::: "memory");
    __builtin_amdgcn_fence(__ATOMIC_ACQUIRE, "agent");
#pragma unroll 1
    for (int ti = 0; ti < 16; ++ti) final_norm_token(F, tok0 + ti);
  }
}
DI void peer_act_pass(const Ctx& F0) {
  const Ctx F = fresh(F0);
  const float* PT = (const float*)(F.ws + WS_PART); const u32x2* EI = (const u32x2*)(F.ws + WS_EIDX); const f32x4* GT = (const f32x4*)(F.ws + WS_GATE);
  const float* DSC = (const float*)(F.ws + WS_DSC); const float* USC = (const float*)(F.ws + WS_USC); u32x2* AH = (u32x2*)(F.ws + WS_ACTH);
  for (size_t i = (size_t)blockIdx.x * NTHREADS + F.tid; i < (size_t)NTOK * 32; i += (size_t)F.G * NTHREADS) {
    f32x4 s = {0.f, 0.f, 0.f, 0.f};
#pragma unroll
    for (int x = 0; x < 8; ++x) s += *(const f32x4*)(PT + (size_t)x * NTOK * 128 + 4 * i);
    const u32x2 ee = EI[i]; const unsigned e0 = ee.x & 0xffffu, e1 = ee.x >> 16, e2 = ee.y & 0xffffu, e3 = ee.y >> 16; const f32x4 gt = GT[i];
    const float rs = pg8::row_rstd((const float*)(F.ws + WS_SSP), (int)(i >> 5));
    u32x2 o; o.x = cvtpk(gelu_tanh(s.x * rs * DSC[e0]) * gt.x * USC[e0], gelu_tanh(s.y * rs * DSC[e1]) * gt.y * USC[e1]);
    o.y = cvtpk(gelu_tanh(s.z * rs * DSC[e2]) * gt.z * USC[e2], gelu_tanh(s.w * rs * DSC[e3]) * gt.w * USC[e3]);
    AH[i] = o;
  }
}
DI void renorm_pass(const Ctx& F0, const float* g) {
  const Ctx F = fresh(F0);
#pragma unroll 1
  for (int m = F.gw; m < NTOK; m += F.NGW) rms_row_bf16(F.H + (size_t)m * DM, g, (bf16_t*)(F.ws + WS_HN) + (size_t)m * DM, F.lane);
}
DI void final_norm_token(const Ctx& F, const int tok) {
  const int lane = F.lane; const bf16_t* hrow = (const bf16_t*)(F.ws + WS_HN) + (size_t)tok * DM; float* orow = F.H + (size_t)tok * DM; const float* gf = F.in[I_NFIN];
  f32x4 v[4]; float ss = 0.f;
#pragma unroll
  for (int j = 0; j < 4; ++j) { const u32x2 hb = ((const u32x2*)hrow)[lane + 64 * j]; v[j] = (f32x4){bflo(hb.x), bfhi(hb.x), bflo(hb.y), bfhi(hb.y)}; ss += v[j].x * v[j].x + v[j].y * v[j].y + v[j].z * v[j].z + v[j].w * v[j].w; }
  const float r = rsqrtf(wave_sum(ss) * (1.f / DM) + EPS);
#pragma unroll
  for (int j = 0; j < 4; ++j) ((f32x4*)orow)[lane + 64 * j] = v[j] * r * ((const f32x4*)gf)[lane + 64 * j];
}

#define XB_TMO      128
#define XB_XCNT(j)  (256  + 64 * (j))
#define XB_XSUB(j)  (1280 + 64 * (j))
#define XB_XGEN(j)  (2304 + 64 * (j))
#define XB_TOP      3328
#define XB_TOPGEN   3392
#define XCD_BAR_WORDS 3456
#define XB_SPIN_CAP (1u << 22)
DI unsigned xb_ld(unsigned* p)              { return __hip_atomic_load(p, __ATOMIC_RELAXED, __HIP_MEMORY_SCOPE_AGENT); }
DI unsigned xb_add(unsigned* p, unsigned v) { return __hip_atomic_fetch_add(p, v, __ATOMIC_RELAXED, __HIP_MEMORY_SCOPE_AGENT); }
DI unsigned xb_xcc_id() { return (unsigned)__builtin_amdgcn_s_getreg((3 << 11) | 20) & 0xFu; }
#define XB_SPIN(cond, bar) do { unsigned _sp = 0; while (cond) { __builtin_amdgcn_s_sleep(1); \
    if ((++_sp & 255u) == 0u) { if (xb_ld(&(bar)[XB_TMO])) break; if (_sp > XB_SPIN_CAP) { atomicAdd(&(bar)[XB_TMO], 1u); break; } } } } while (0)
struct XcdBarrier { unsigned* bar; unsigned x; volatile LAS unsigned* st; };
DI XcdBarrier xcd_barrier_post(unsigned* bar, volatile LAS unsigned* st) {
  XcdBarrier b; b.bar = bar; b.x = xb_xcc_id(); b.st = st;
  if (threadIdx.x == 0) (void)xb_add(&bar[XB_XCNT(b.x)], 1u);
  return b;
}
DI void xcd_barrier_complete(unsigned* bar, unsigned x, unsigned& nloc, unsigned& nx) {
  const unsigned G = gridDim.x * gridDim.y * gridDim.z;
  unsigned sum, cnt, mine, sp = 0u;
  for (;;) {
    sum = 0u; cnt = 0u; mine = 0u;
#pragma unroll
    for (unsigned j = 0; j < 16; ++j) { const unsigned c = xb_ld(&bar[XB_XCNT(j)]); sum += c; cnt += (c > 0u) ? 1u : 0u; mine = (j == x) ? c : mine; }
    if (sum == G) break;
    __builtin_amdgcn_s_sleep(1);
    if ((++sp & 255u) == 0u) { if (xb_ld(&bar[XB_TMO])) break; if (sp > XB_SPIN_CAP) { atomicAdd(&bar[XB_TMO], 1u); break; } }
  }
  nloc = mine > 0u ? mine : 1u; nx = cnt > 0u ? cnt : 1u;
}
DI void xcd_barrier(const XcdBarrier& b) {
  asm volatile("s_waitcnt vmcnt(0)" ::: "memory");
  __syncthreads();
  if (threadIdx.x == 0) {
    unsigned* bar = b.bar;
    __builtin_amdgcn_s_waitcnt(0);
    unsigned nloc = b.st[0], nx = b.st[1];
    if (nloc == 0u) { xcd_barrier_complete(bar, b.x, nloc, nx); b.st[0] = nloc; b.st[1] = nx; }
    const unsigned old = xb_add(&bar[XB_XSUB(b.x)], 1u);
    const unsigned gen = old / nloc;
    if (old + 1u == (gen + 1u) * nloc) {
      __builtin_amdgcn_fence(__ATOMIC_RELEASE, "agent");
      asm volatile("s_waitcnt vmcnt(0)" ::: "memory");
      const unsigned og = xb_add(&bar[XB_TOP], 1u);
      const unsigned tg = og / nx;
      if (og + 1u == (tg + 1u) * nx) xb_add(&bar[XB_TOPGEN], 1u);
      else XB_SPIN(xb_ld(&bar[XB_TOPGEN]) == tg, bar);
      __builtin_amdgcn_fence(__ATOMIC_ACQUIRE, "agent");
      xb_add(&bar[XB_XGEN(b.x)], 1u);
      asm volatile("s_waitcnt vmcnt(0)" ::: "memory");
    } else {
      XB_SPIN(xb_ld(&bar[XB_XGEN(b.x)]) == gen, bar);
      __builtin_amdgcn_fence(__ATOMIC_ACQUIRE, "agent");
      asm volatile("s_waitcnt vmcnt(0)" ::: "memory");
    }
  }
  __syncthreads();
}
constexpr int CW_BAR = 4096, CW_QA = 16384, CW_QC = 16384 + 1024, CW_QN = 16384 + 2048;

__global__ void __launch_bounds__(NTHREADS, 2) mega(Params p) {
  extern __shared__ __attribute__((aligned(16))) unsigned char lds_raw[];
  cg::grid_group grid = cg::this_grid();
  Ctx F;
  F.lds = (LAS unsigned char*)lds_raw;
  F.tid = threadIdx.x; F.lane = F.tid & 63; F.wave = __builtin_amdgcn_readfirstlane(F.tid >> 6);
  F.G = gridDim.x; F.gw = blockIdx.x * NWAVES + F.wave; F.NGW = F.G * NWAVES;
  F.in = p.in; F.H = p.out; F.ws = p.ws;
  unsigned char* ws = p.ws;
  const int bx = blockIdx.x;
  if (F.tid < 8) ((LAS unsigned*)(F.lds + LDSCTL_OFF))[F.tid] = 0u;
  __syncthreads();
  const XcdBarrier bar = xcd_barrier_post((unsigned*)(ws + WS_CTL) + CW_BAR, (volatile LAS unsigned*)(F.lds + LDSCTL_OFF));
#define GRID_BAR() xcd_barrier(bar)

  prologue(F);
  if (p.pad0 == 0x5eed) grid.sync();
  GRID_BAR();
  {
    pg8::PlainOrder S; S.init(ws + WS_HN, ws + WS_WIN, NTOK, ZP, DM, DM, F.G, bx);
    pg8::EpiBf16 E{(bf16_t*)(ws + WS_Z), ZP, 0};
    pg8::gemm_phase(F.lds, DM, DM, DM, S, E);
  }
  GRID_BAR();
  gla_phase<0>(F);
#if EN_NSA
  for (int cu = (bx + 128) % F.G; cu < 256; cu += F.G) nsa_compress_unit(F, cu);
#endif
  GRID_BAR();
  gla_scan(F);
#if EN_XATTN
  {
    pg8::MemProjOrder S{(const char*)(ws + WS_MEMN), (const char*)(ws + WS_XWK), (const char*)(ws + WS_XWV), F.G, (bx + 192) % F.G};
    pg8::EpiBf16 E{(bf16_t*)(ws + WS_KX), DM, 0};
    pg8::gemm_phase(F.lds, DM, DM, DM, S, E);
  }
#endif
#if EN_NSA
  {
    unsigned* qn = (unsigned*)(ws + WS_CTL) + CW_QN;
    volatile LAS int* slot = (volatile LAS int*)(F.lds + LDSCTL_OFF + 16);
    const unsigned xcc = xb_xcc_id() & 7u;
    for (int s8 = 0; s8 < 8; ++s8) {
      const int bg = (int)((xcc + (unsigned)s8) & 7u);
      for (;;) {
        __syncthreads();
        if (F.tid == 0) *slot = (int)atomicAdd(qn + 64 * bg, 1u);
        __syncthreads();
        const int u = *slot;
        if (u >= 128) break;
        nsa_unit(F, bg, 127 - u);
      }
    }
  }
#else
  for (int m = F.gw; m < NTOK; m += F.NGW) { u32x4* o = (u32x4*)((bf16_t*)(ws + WS_OCAT) + (size_t)m * DM + 512) + F.lane; *o = (u32x4){0, 0, 0, 0}; }
#endif
  GRID_BAR();
#if EN_XATTN
  {
    pg8::FoldOrder S{(const char*)(ws + WS_KX), (const char*)(ws + WS_XWQ), (const char*)(ws + WS_XWO), (const char*)(ws + WS_VXT), F.G, bx};
    pg8::EpiBf16 E{(bf16_t*)(ws + WS_MT), DM, 0};
    pg8::gemm_phase(F.lds, 256, DM, DM, S, E);
  }
#endif
  gla_phase<1>(F);
  GRID_BAR();
  {
    pg8::PlainOrder S; S.init(ws + WS_OCAT, ws + WS_WOUT, NTOK, DM, DM, DM, F.G, bx);
    pg8::EpiRes E{p.in[I_X], (bf16_t*)(ws + WS_HN), (float*)(ws + WS_SSP)};
    pg8::gemm_phase(F.lds, DM, DM, DM, S, E);
  }
  GRID_BAR();
#if EN_XATTN
  {
    pg8::XaBatchOrder S{(const char*)(ws + WS_HN), (const char*)(ws + WS_MT), F.G, bx};
    pg8::EpiSoftmax E{(bf16_t*)(ws + WS_XP), (const float*)(ws + WS_SSP), (LAS float*)(F.lds + 131072)};
    pg8::gemm_phase(F.lds, DM, DM, DM, S, E);
  }
  GRID_BAR();
  {
    pg8::XaBatchOrder S{(const char*)(ws + WS_XP), (const char*)(ws + WS_VWT), F.G, bx};
    pg8::EpiRes E{nullptr, (bf16_t*)(ws + WS_HN), (float*)(ws + WS_SSP)};
    pg8::gemm_phase(F.lds, DM, DM, DM, S, E);
  }
  GRID_BAR();
#endif
#if EN_PEER
  {
    pg8::PlainOrder S; S.init(ws + WS_HN, ws + WS_PWQ, NTOK, DM, DM, DM, F.G, bx);
    pg8::EpiBf16RS E{(bf16_t*)(ws + WS_QP), (const float*)(ws + WS_SSP)};
    pg8::gemm_phase(F.lds, DM, DM, DM, S, E);
  }
  GRID_BAR();
  for (int u = bx; u < 256; u += F.G) peer_select_unit(F, u);
  GRID_BAR();
  peer_fused_phase(F);
#else
  { const Ctx Ff = fresh(F);
#pragma unroll 1
    for (int m = Ff.gw; m < NTOK; m += Ff.NGW) final_norm_token(Ff, m); }
#endif
}

extern "C" void kernel_launch(void* const* d_in, const int* in_sizes, int n_in, void* d_out, int out_size, void* d_ws, size_t ws_size, hipStream_t stream) {
  static int grid_blocks = 0;
  if (!grid_blocks) {
    int dev = 0, cus = 0, per_cu = 0;
    (void)hipGetDevice(&dev);
    (void)hipDeviceGetAttribute(&cus, hipDeviceAttributeMultiprocessorCount, dev);
    (void)hipFuncSetAttribute((const void*)mega, hipFuncAttributeMaxDynamicSharedMemorySize, LDS_BYTES);
    (void)hipOccupancyMaxActiveBlocksPerMultiprocessor(&per_cu, (const void*)mega, NTHREADS, LDS_BYTES);
    if (per_cu < 1) { fprintf(stderr, "kernel_launch: occupancy query says %d blocks per CU\n", per_cu); per_cu = 1; }
    grid_blocks = cus;
    if (n_in != 27 || ws_size < WS_END) { fprintf(stderr, "kernel_launch: n_in %d ws %zu (need %zu)\n", n_in, ws_size, (size_t)WS_END); }
    fprintf(stderr, "kernel_launch: grid %d x %d, per_cu %d, ws %zu MiB\n", grid_blocks, NTHREADS, per_cu, ws_size >> 20);
  }
  (void)hipMemsetAsync((char*)d_ws + WS_CTL, 0, 1 * MiB, stream);
  Params p{};
  for (int i = 0; i < 27 && i < n_in; ++i) p.in[i] = (const float*)d_in[i];
  p.out = (float*)d_out; p.ws = (unsigned char*)d_ws;
  void* args[] = {&p};
  hipError_t e = hipLaunchCooperativeKernel((void*)mega, dim3(grid_blocks), dim3(NTHREADS), args, LDS_BYTES, stream);
  if (e != hipSuccess) fprintf(stderr, "cooperative launch failed: %s (grid %d)\n", hipGetErrorString(e), grid_blocks);
}
```

```cpp
#include <hip/hip_runtime.h>
#include <hip/hip_cooperative_groups.h>
#include <cstdio>
#include <cstdint>
namespace cg = cooperative_groups;

#ifndef EN_NSA
#define EN_NSA 1
#endif
#ifndef EN_SLC
#define EN_SLC 1.f
#endif
#ifndef EN_WIN
#define EN_WIN 1.f
#endif
#ifndef EN_XATTN
#define EN_XATTN 1
#endif
#ifndef EN_PEER
#define EN_PEER 1
#endif

#define LAS __attribute__((address_space(3)))
#define DI __device__ __forceinline__
typedef unsigned short bf16_t;
typedef short bf16x8 __attribute__((ext_vector_type(8)));
typedef short s16x4 __attribute__((ext_vector_type(4)));
typedef float f32x2 __attribute__((ext_vector_type(2)));
typedef float f32x4 __attribute__((ext_vector_type(4)));
typedef float f32x16 __attribute__((ext_vector_type(16)));
typedef unsigned u32x2 __attribute__((ext_vector_type(2)));
typedef unsigned u32x4 __attribute__((ext_vector_type(4)));
typedef __bf16 bf16x2_t __attribute__((ext_vector_type(2)));
typedef short v4i16_t __attribute__((ext_vector_type(4)));

constexpr int NB = 4, T = 8192, NTOK = NB * T, DM = 1024;
constexpr int ZP = 3072;
constexpr int C_GQ = 0, C_GK = 256, C_GV = 512, C_GR = 1024, C_GLR = 1536, C_NQ = 1552, C_KC = 2064, C_VC = 2192,
              C_KS = 2320, C_VS = 2448, C_KW = 2576, C_VW = 2704, C_NG = 2832, IN_COLS = 2856;
constexpr float EPS = 1e-6f;
constexpr int NTHREADS = 512, NWAVES = 8;
constexpr int LDS_BYTES = 147456;
constexpr int LDSCTL_OFF = 139264;

constexpr size_t MiB = 1u << 20;
constexpr size_t WS_CTL = 0;
constexpr size_t WS_XL = 256 * 1024;
constexpr size_t WS_BUCK = 1 * MiB;
constexpr size_t WS_C1 = 1 * MiB + 16 * 1024;
constexpr size_t WS_W2T = 1 * MiB + 32 * 1024;
constexpr size_t WS_SK = 1 * MiB + 128 * 1024;
constexpr size_t WS_DL = 1 * MiB + 512 * 1024;
constexpr size_t WS_KCMP = 2 * MiB;
constexpr size_t WS_VCMP = 2 * MiB + 512 * 1024;
constexpr size_t WS_W1T = 3 * MiB;
constexpr size_t WS_WIN = 4 * MiB;
constexpr size_t WS_WOUT = 10 * MiB, WS_XWQ = 12 * MiB, WS_XWK = 14 * MiB, WS_XWV = 16 * MiB, WS_XWO = 18 * MiB, WS_PWQ = 20 * MiB;
constexpr size_t WS_MEMN = 22 * MiB, WS_KX = 24 * MiB, WS_VXT = 26 * MiB;
constexpr size_t WS_PDOWN8 = 32 * MiB, WS_PUP8 = 48 * MiB;
constexpr size_t WS_DSC = 1 * MiB + 64 * 1024, WS_USC = 1 * MiB + 384 * 1024;
constexpr size_t WS_SSP = 28 * MiB;
constexpr size_t WS_PART = 256 * MiB;
constexpr size_t WS_HN = 96 * MiB;
constexpr size_t WS_GU = 96 * MiB;
constexpr size_t WS_Z = 160 * MiB;
constexpr size_t WS_QX = 160 * MiB, WS_XP = 224 * MiB, WS_OX = 288 * MiB;
constexpr size_t WS_QP = 160 * MiB, WS_EIDX = 224 * MiB, WS_ACTH = 232 * MiB, WS_GATE = 240 * MiB;
constexpr size_t WS_OCAT = 352 * MiB;
constexpr size_t WS_GS = 416 * MiB;
constexpr size_t WS_MT = 448 * MiB;
constexpr size_t WS_VWT = 456 * MiB;
constexpr size_t WS_GQ = 464 * MiB, WS_GK = 480 * MiB;
constexpr size_t WS_END = 496 * MiB;

DI unsigned f2bf(float f) { unsigned u = __builtin_bit_cast(unsigned, f); return (u + 0x7fffu + ((u >> 16) & 1u)) >> 16; }
DI float bf2f(unsigned short b) { return __builtin_bit_cast(float, (unsigned)b << 16); }
DI float bflo(unsigned w) { return __builtin_bit_cast(float, w << 16); }
DI float bfhi(unsigned w) { return __builtin_bit_cast(float, w & 0xffff0000u); }
DI unsigned cvtpk(float lo, float hi) { f32x2 v = {lo, hi}; bf16x2_t b = __builtin_convertvector(v, bf16x2_t); return __builtin_bit_cast(unsigned, b); }
DI float wave_sum(float v) {
#pragma unroll
  for (int o = 1; o < 64; o <<= 1) v += __shfl_xor(v, o);
  return v;
}
DI int crow(int r, int hi) { return (r & 3) + 8 * (r >> 2) + 4 * hi; }
DI s16x4 vtr(const LAS unsigned char* p) { return __builtin_bit_cast(s16x4, __builtin_amdgcn_ds_read_tr16_b64_v4i16((LAS v4i16_t*)p)); }
DI bf16x8 cat8(s16x4 a, s16x4 b) { return __builtin_shufflevector(a, b, 0, 1, 2, 3, 4, 5, 6, 7); }
#define MFMA32(a, b, c) __builtin_amdgcn_mfma_f32_32x32x16_bf16((a), (b), (c), 0, 0, 0)
DI bf16x8 pack8(const f32x16& x, int s) {
  u32x4 p; p[0] = cvtpk(x[8 * s], x[8 * s + 1]); p[1] = cvtpk(x[8 * s + 2], x[8 * s + 3]); p[2] = cvtpk(x[8 * s + 4], x[8 * s + 5]); p[3] = cvtpk(x[8 * s + 6], x[8 * s + 7]);
  return __builtin_bit_cast(bf16x8, p);
}
DI float gelu_tanh(float x) {
  const float y = 0.7978845608028654f * (x + 0.044715f * x * x * x);
  const float e = __expf(2.f * y);
  const float th = 1.f - 2.f / (1.f + e);
  return 0.5f * x * (1.f + th);
}
DI float sigmoidf_(float x) { return 1.f / (1.f + __expf(-x)); }

DI void sort16_desc(int (&x)[16]) {
#define CE_(a, b) { const int h_ = max(x[a], x[b]); const int l_ = min(x[a], x[b]); x[a] = h_; x[b] = l_; }
  CE_(0,1); CE_(2,3); CE_(0,2); CE_(1,3); CE_(1,2); CE_(4,5); CE_(6,7); CE_(4,6); CE_(5,7); CE_(5,6); CE_(0,4); CE_(2,6); CE_(2,4); CE_(1,5); CE_(3,7); CE_(3,5); CE_(1,2); CE_(3,4); CE_(5,6); CE_(8,9); CE_(10,11); CE_(8,10); CE_(9,11); CE_(9,10); CE_(12,13); CE_(14,15); CE_(12,14); CE_(13,15); CE_(13,14); CE_(8,12); CE_(10,14); CE_(10,12); CE_(9,13); CE_(11,15); CE_(11,13); CE_(9,10); CE_(11,12); CE_(13,14); CE_(0,8); CE_(4,12); CE_(4,8); CE_(2,10); CE_(6,14); CE_(6,10); CE_(2,4); CE_(6,8); CE_(10,12); CE_(1,9); CE_(5,13); CE_(5,9); CE_(3,11); CE_(7,15); CE_(7,11); CE_(3,5); CE_(7,9); CE_(11,13); CE_(1,2); CE_(3,4); CE_(5,6); CE_(7,8); CE_(9,10); CE_(11,12); CE_(13,14);
#undef CE_
}
DI void merge16_top(int (&a)[16], const int (&b)[16]) {
  int c[16];
#pragma unroll
  for (int i = 0; i < 16; ++i) c[i] = max(a[i], b[15 - i]);
#pragma unroll
  for (int st = 8; st >= 1; st >>= 1)
#pragma unroll
    for (int i = 0; i < 16; ++i) if ((i & st) == 0) { const int x = c[i], y = c[i + st]; c[i] = max(x, y); c[i + st] = min(x, y); }
#pragma unroll
  for (int i = 0; i < 16; ++i) a[i] = c[i];
}

struct Params {
  const float* in[27];
  float* out;
  unsigned char* ws;
  int pad0, pad1;
};
enum { I_X = 0, I_MEM, I_RELB, I_NMIX, I_WIN, I_GW2, I_GB, I_GON, I_POSK, I_POSV, I_CKW1, I_CKW2, I_CVW1, I_CVW2, I_WOUT, I_NXA, I_NMEM,
       I_XWQ, I_XWK, I_XWV, I_XWO, I_NFFN, I_PWQ, I_PSK, I_PDOWN, I_PUP, I_NFIN };

namespace pg8 {
constexpr int BM = 256, BK = 64, HALF = 128, HTB = HALF * BK * 2, STAGE_BYTES = 8 * HTB;
DI int lds_byte(int r, int c) { const int st = (r >> 4) * 2 + (c >> 5), rr = r & 15, cc = c & 31, ob = rr * 64 + cc * 2; return st * 1024 + (ob ^ (((ob >> 9) & 1) << 5)); }
DI void stage_rc(int b, int& R, int& C) { const int st = b / 1024, sb = b % 1024, swz = sb ^ (((sb >> 9) & 1) << 5); R = (st >> 1) * 16 + swz / 64; C = (st & 1) * 32 + (swz % 64) / 2; }
DI int perm32(int rho) { const int n = rho >> 4, i = rho & 15; return 8 * (i >> 2) + 4 * n + (i & 3); }
struct Unit { const char* a; const char* b; int pm, pn; };
DI const char* uni_ptr(const char* p) { const unsigned long long v = (unsigned long long)p; const unsigned lo = __builtin_amdgcn_readfirstlane((unsigned)v), hi = __builtin_amdgcn_readfirstlane((unsigned)(v >> 32)); return (const char*)(((unsigned long long)hi << 32) | lo); }

template <class Epi, class Sched>
DI void gemm_phase(LAS unsigned char* lds, const int K, const int lda, const int ldb, const Sched& S, const Epi& E) {
  constexpr bool ALIGN_EPI = true;
  int tid_ = threadIdx.x; asm volatile("" : "+v"(tid_));
  const int tid = tid_, wid = __builtin_amdgcn_readfirstlane(tid >> 6), lane = tid & 63, wr = wid >> 2, wc = wid & 3, fr = lane & 15, fq = lane >> 4;
  const int nt = K / BK;
  unsigned voffA[2], voffB[2];
#pragma unroll
  for (int i = 0; i < 2; ++i) { int R, C; stage_rc(tid * 16 + i * 8192, R, C); const int Rb = Epi::PERM ? ((R & ~31) + perm32(R & 31)) : R;
    voffA[i] = (unsigned)(R * lda + C) * 2u; voffB[i] = (unsigned)(Rb * ldb + C) * 2u; }
  const size_t kstep = (size_t)(BK * 2);
  const size_t hstepA = (size_t)HALF * lda * 2, hstepB = (size_t)HALF * ldb * 2;
  const unsigned ldsw = (unsigned)wid * 1024u;
  const int aoff = lds_byte(wr * 64 + fr, fq * 8), boff = lds_byte(wc * 32 + fr, fq * 8);
#define PG8_SA(b, h) (((b) * 2 + (h)) * HTB)
#define PG8_SB(b, h) ((4 + (b) * 2 + (h)) * HTB)
#define PG8_STAGE(bufoff, gbase, voff) do { _Pragma("unroll") for (int _i = 0; _i < 2; ++_i) \
        __builtin_amdgcn_global_load_lds((const unsigned*)((const char*)(gbase) + (voff)[_i]), (LAS unsigned*)(lds + (bufoff) + ldsw + _i * 8192), 16, 0, 0); } while (0)
#define PG8_LDA(dst, b, h) do { _Pragma("unroll") for (int m = 0; m < 4; ++m) _Pragma("unroll") for (int k = 0; k < 2; ++k) dst[m][k] = *(const LAS bf16x8*)(lds + PG8_SA(b, h) + aoff + m * 2048 + k * 1024); } while (0)
#define PG8_LDB(dst, b, h) do { _Pragma("unroll") for (int n = 0; n < 2; ++n) _Pragma("unroll") for (int k = 0; k < 2; ++k) dst[n][k] = *(const LAS bf16x8*)(lds + PG8_SB(b, h) + boff + n * 2048 + k * 1024); } while (0)
#define PG8_MMA(ai, bj, At, Bt) do { __builtin_amdgcn_s_setprio(1); _Pragma("unroll") for (int m = 0; m < 4; ++m) _Pragma("unroll") for (int n = 0; n < 2; ++n) _Pragma("unroll") for (int k = 0; k < 2; ++k) \
        acc[ai][bj][m][n] = __builtin_amdgcn_mfma_f32_16x16x32_bf16(Bt[n][k], At[m][k], acc[ai][bj][m][n], 0, 0, 0); __builtin_amdgcn_s_setprio(0); } while (0)
#define PG8_WAIT_V(n) asm volatile("s_waitcnt vmcnt(" #n ")" ::: "memory")
#define PG8_WAIT_L(n) asm volatile("s_waitcnt lgkmcnt(" #n ")" ::: "memory")
#define PG8_BAR __builtin_amdgcn_s_barrier()
#define PG8_SCHED __builtin_amdgcn_sched_barrier(0)
  __syncthreads();
  Unit cur, nxt; int ui = 0;
  if (!S.next(0, cur)) return;
  f32x4 acc[2][2][4][2];
#pragma unroll
  for (int a = 0; a < 2; ++a)
#pragma unroll
    for (int b = 0; b < 2; ++b)
#pragma unroll
      for (int m = 0; m < 4; ++m)
#pragma unroll
        for (int n = 0; n < 2; ++n) acc[a][b][m][n] = (f32x4){0.f, 0.f, 0.f, 0.f};
  bf16x8 At[4][2], B0[2][2], B1[2][2];
  const char* cA = uni_ptr(cur.a); const char* cB = uni_ptr(cur.b);
  PG8_STAGE(PG8_SB(0, 0), cB, voffB); PG8_STAGE(PG8_SB(0, 1), cB + hstepB, voffB); PG8_STAGE(PG8_SA(0, 0), cA, voffA); PG8_STAGE(PG8_SA(0, 1), cA + hstepA, voffA);
  if (wr == 1) PG8_BAR;
  PG8_WAIT_V(2); PG8_BAR;
  PG8_STAGE(PG8_SB(1, 0), cB + kstep, voffB); PG8_STAGE(PG8_SA(1, 0), cA + kstep, voffA); PG8_STAGE(PG8_SB(1, 1), cB + hstepB + kstep, voffB);
  PG8_WAIT_V(6); PG8_BAR;
  for (;;) {
    const bool has_next = S.next(ui + 1, nxt);
    const char* nA = has_next ? uni_ptr(nxt.a) : cA; const char* nB = has_next ? uni_ptr(nxt.b) : cB;
#pragma unroll 1
    for (int t = 0; t < nt; t += 2) {
      const bool last = (t == nt - 2);
      const char* a1 = cA + (size_t)(t + 1) * kstep;
      const char* a2 = last ? nA : cA + (size_t)(t + 2) * kstep; const char* b2 = last ? nB : cB + (size_t)(t + 2) * kstep;
      const char* a3 = a2 + kstep; const char* b3 = b2 + kstep;
      PG8_LDB(B0, 0, 0); PG8_LDB(B1, 0, 1); PG8_SCHED; PG8_LDA(At, 0, 0); PG8_STAGE(PG8_SA(1, 1), a1 + hstepA, voffA);
      PG8_WAIT_V(8); PG8_WAIT_L(0); PG8_BAR; PG8_MMA(0, 0, At, B0); PG8_MMA(0, 1, At, B1); PG8_BAR; PG8_SCHED;
      PG8_LDA(At, 0, 1); PG8_STAGE(PG8_SB(0, 0), b2, voffB); PG8_STAGE(PG8_SB(0, 1), b2 + hstepB, voffB); PG8_STAGE(PG8_SA(0, 0), a2, voffA);
      PG8_WAIT_V(8); PG8_WAIT_L(0); PG8_BAR; PG8_MMA(1, 0, At, B0); PG8_MMA(1, 1, At, B1); PG8_BAR; PG8_SCHED;
      PG8_LDB(B0, 1, 0); PG8_LDB(B1, 1, 1); PG8_SCHED; PG8_LDA(At, 1, 0); PG8_STAGE(PG8_SA(0, 1), a2 + hstepA, voffA);
      PG8_WAIT_V(8); PG8_WAIT_L(0); PG8_BAR; PG8_MMA(0, 0, At, B0); PG8_MMA(0, 1, At, B1); PG8_BAR; PG8_SCHED;
      PG8_LDA(At, 1, 1); PG8_STAGE(PG8_SB(1, 0), b3, voffB); PG8_STAGE(PG8_SB(1, 1), b3 + hstepB, voffB); PG8_STAGE(PG8_SA(1, 0), a3, voffA);
      PG8_WAIT_V(8); PG8_WAIT_L(0); PG8_BAR; PG8_MMA(1, 0, At, B0); PG8_MMA(1, 1, At, B1); PG8_BAR; PG8_SCHED;
    }
    if constexpr (ALIGN_EPI) { if (wr == 0) PG8_BAR; }
    E(acc, cur, wr, wc, fr, fq);
    if (!has_next) break;
#pragma unroll
    for (int a = 0; a < 2; ++a)
#pragma unroll
      for (int b = 0; b < 2; ++b)
#pragma unroll
        for (int m = 0; m < 4; ++m)
#pragma unroll
          for (int n = 0; n < 2; ++n) acc[a][b][m][n] = (f32x4){0.f, 0.f, 0.f, 0.f};
    cur = nxt; cA = nA; cB = nB; ++ui;
    if constexpr (ALIGN_EPI) { if (wr == 1) PG8_BAR; }
  }
  PG8_WAIT_V(0);
  if constexpr (!ALIGN_EPI) { if (wr == 0) PG8_BAR; }
  PG8_BAR;
#undef PG8_SA
#undef PG8_SB
#undef PG8_STAGE
#undef PG8_LDA
#undef PG8_LDB
#undef PG8_MMA
#undef PG8_WAIT_V
#undef PG8_WAIT_L
#undef PG8_BAR
#undef PG8_SCHED
}

struct EpiBf16 {
  static constexpr bool PERM = true;
  bf16_t* O; int ldc; int coloff;
  DI void operator()(const f32x4 (&acc)[2][2][4][2], const Unit& u, int wr, int wc, int fr, int fq) const {
    const int row0 = u.pm * BM + wr * 64 + fr; const int col0 = coloff + u.pn * BM + wc * 32 + 8 * fq;
#pragma unroll
    for (int ai = 0; ai < 2; ++ai)
#pragma unroll
      for (int m = 0; m < 4; ++m) { bf16_t* rowp = O + (size_t)(row0 + ai * HALF + m * 16) * ldc + col0;
#pragma unroll
        for (int bj = 0; bj < 2; ++bj) { const f32x4 v0 = acc[ai][bj][m][0], v1 = acc[ai][bj][m][1];
          u32x4 w; w.x = cvtpk(v0[0], v0[1]); w.y = cvtpk(v0[2], v0[3]); w.z = cvtpk(v1[0], v1[1]); w.w = cvtpk(v1[2], v1[3]);
          *(u32x4*)(rowp + bj * HALF) = w; } }
  }
};
struct EpiRes {
  static constexpr bool PERM = false;
  const float* ResF; bf16_t* HB; float* SSP;
  DI void operator()(const f32x4 (&acc)[2][2][4][2], const Unit& u, int wr, int wc, int fr, int fq) const {
    const int row0 = u.pm * BM + wr * 64 + fr; const int col0 = u.pn * BM + wc * 32 + 4 * fq;
#pragma unroll
    for (int ai = 0; ai < 2; ++ai)
#pragma unroll
      for (int m = 0; m < 4; ++m) { const int row = row0 + ai * HALF + m * 16; const size_t off = (size_t)row * DM + col0; float ss = 0.f;
#pragma unroll
        for (int bj = 0; bj < 2; ++bj)
#pragma unroll
          for (int n = 0; n < 2; ++n) { f32x4 r;
            if (ResF) r = *(const f32x4*)(ResF + off + bj * HALF + n * 16);
            else { const u32x2 rb = *(const u32x2*)(HB + off + bj * HALF + n * 16); r = (f32x4){bflo(rb.x), bfhi(rb.x), bflo(rb.y), bfhi(rb.y)}; }
            const f32x4 o = r + acc[ai][bj][m][n];
            u32x2 w; w.x = cvtpk(o[0], o[1]); w.y = cvtpk(o[2], o[3]); *(u32x2*)(HB + off + bj * HALF + n * 16) = w;
            const float q0 = bflo(w.x), q1 = bfhi(w.x), q2 = bflo(w.y), q3 = bfhi(w.y);
            ss += (q0 * q0 + q1 * q1) + (q2 * q2 + q3 * q3); }
        ss += __shfl_xor(ss, 16); ss += __shfl_xor(ss, 32);
        if (fq == 0) SSP[(size_t)row * 16 + u.pn * 4 + wc] = ss; }
  }
};
DI float row_rstd(const float* SSP, int row) {
  const f32x4* p = (const f32x4*)(SSP + (size_t)row * 16); const f32x4 a = p[0], b = p[1], c = p[2], d = p[3];
  const float s = ((a[0] + a[1]) + (a[2] + a[3])) + ((b[0] + b[1]) + (b[2] + b[3])) + ((c[0] + c[1]) + (c[2] + c[3])) + ((d[0] + d[1]) + (d[2] + d[3]));
  return rsqrtf(s * (1.f / DM) + EPS);
}
struct EpiBf16RS {
  static constexpr bool PERM = true;
  bf16_t* O; const float* SSP;
  DI void operator()(const f32x4 (&acc)[2][2][4][2], const Unit& u, int wr, int wc, int fr, int fq) const {
    const int row0 = u.pm * BM + wr * 64 + fr; const int col0 = u.pn * BM + wc * 32 + 8 * fq;
#pragma unroll
    for (int ai = 0; ai < 2; ++ai)
#pragma unroll
      for (int m = 0; m < 4; ++m) { const int row = row0 + ai * HALF + m * 16; bf16_t* rowp = O + (size_t)row * DM + col0; const float rs = row_rstd(SSP, row);
#pragma unroll
        for (int bj = 0; bj < 2; ++bj) { const f32x4 v0 = acc[ai][bj][m][0] * rs, v1 = acc[ai][bj][m][1] * rs;
          u32x4 w; w.x = cvtpk(v0[0], v0[1]); w.y = cvtpk(v0[2], v0[3]); w.z = cvtpk(v1[0], v1[1]); w.w = cvtpk(v1[2], v1[3]);
          *(u32x4*)(rowp + bj * HALF) = w; } }
  }
};
struct EpiSoftmax {
  static constexpr bool PERM = true;
  bf16_t* P; const float* SSP; LAS float* xch;
  DI void operator()(f32x4 (&acc)[2][2][4][2], const Unit& u, int wr, int wc, int fr, int fq) const {
    const int row0 = u.pm * BM + wr * 64 + fr; const int col0 = u.pn * BM + wc * 32 + 8 * fq;
#pragma unroll
    for (int ai = 0; ai < 2; ++ai)
#pragma unroll
      for (int m = 0; m < 4; ++m) { const int row = row0 + ai * HALF + m * 16; const float rs = row_rstd(SSP, row) * 1.4426950408889634f; float s = 0.f;
#pragma unroll
        for (int bj = 0; bj < 2; ++bj)
#pragma unroll
          for (int n = 0; n < 2; ++n) { f32x4 v = acc[ai][bj][m][n] * rs;
#pragma unroll
            for (int q = 0; q < 4; ++q) v[q] = __builtin_amdgcn_exp2f(v[q]);
            acc[ai][bj][m][n] = v; s += (v[0] + v[1]) + (v[2] + v[3]); }
        s += __shfl_xor(s, 16); s += __shfl_xor(s, 32);
        if (fq == 0) xch[(wr * 64 + ai * HALF + m * 16 + fr) * 4 + wc] = s; }
    asm volatile("s_waitcnt lgkmcnt(0)" ::: "memory"); __builtin_amdgcn_s_barrier(); asm volatile("" ::: "memory");
#pragma unroll
    for (int ai = 0; ai < 2; ++ai)
#pragma unroll
      for (int m = 0; m < 4; ++m) { const int rl = wr * 64 + ai * HALF + m * 16 + fr; const f32x4 ps = *(const LAS f32x4*)(xch + rl * 4); const float inv = 1.f / ((ps[0] + ps[1]) + (ps[2] + ps[3]));
        bf16_t* rowp = P + (size_t)(row0 + ai * HALF + m * 16) * DM + col0;
#pragma unroll
        for (int bj = 0; bj < 2; ++bj) { const f32x4 v0 = acc[ai][bj][m][0] * inv, v1 = acc[ai][bj][m][1] * inv;
          u32x4 w; w.x = cvtpk(v0[0], v0[1]); w.y = cvtpk(v0[2], v0[3]); w.z = cvtpk(v1[0], v1[1]); w.w = cvtpk(v1[2], v1[3]);
          *(u32x4*)(rowp + bj * HALF) = w; } }
    asm volatile("s_waitcnt lgkmcnt(0)" ::: "memory"); __builtin_amdgcn_s_barrier(); asm volatile("" ::: "memory");
  }
};

struct PlainOrder {
  const char* A; const char* Bt; size_t tstepA, tstepB; int nM, nN, nwg, G, c;
  DI void init(const void* A_, const void* Bt_, int M, int N, int lda, int ldb, int G_, int c_) { A = (const char*)A_; Bt = (const char*)Bt_; tstepA = (size_t)BM * lda * 2; tstepB = (size_t)BM * ldb * 2; nM = M / BM; nN = N / BM; nwg = nM * nN; G = G_; c = c_; }
  DI bool next(int i, Unit& u) const {
    const long L = (long)i * G + c; if (L >= nwg) return false;
    int wgid = (int)L; { const int q = nwg / 8, r = nwg % 8, xcd = wgid % 8, off = wgid / 8; wgid = (xcd < r ? xcd * (q + 1) : r * (q + 1) + (xcd - r) * q) + off; }
    constexpr int WGM = 8;
    const int nig = WGM * nN, gid = wgid / nig, fm = gid * WGM, gsz = (nM - fm) < WGM ? (nM - fm) : WGM;
    u.pm = fm + ((wgid % nig) % gsz); u.pn = (wgid % nig) / gsz; u.a = A + (size_t)u.pm * tstepA; u.b = Bt + (size_t)u.pn * tstepB; return true;
  }
};
struct XaBatchOrder {
  const char* A; const char* Bb; int G, c;
  DI bool next(int i, Unit& u) const { const int L = i * G + c; if (L >= 512) return false; u.pm = L >> 2; u.pn = L & 3; const int b = u.pm >> 5;
    u.a = A + (size_t)u.pm * 256 * DM * 2; u.b = Bb + ((size_t)(b * 1024 + u.pn * 256) * DM) * 2; return true; }
};
struct FoldOrder {
  const char* KX; const char* WQO; const char* WOT; const char* VX; int G, c;
  DI bool next(int i, Unit& u) const { const int L = i * G + c; if (L >= 128) return false; const int t = L >> 6, b = (L >> 4) & 3, h = (L >> 2) & 3, q = L & 3;
    if (t == 0) { u.pm = b * 4 + h; u.pn = q; u.a = KX + ((size_t)(b * 256) * DM + h * 256) * 2; u.b = WQO + ((size_t)(q * 256) * DM + h * 256) * 2; }
    else { u.pm = 16 + b * 4 + q; u.pn = h; u.a = WOT + ((size_t)(q * 256) * DM + h * 256) * 2; u.b = VX + ((size_t)(b * 256) * DM + h * 256) * 2; }
    return true; }
};
struct MemProjOrder {
  const char* MEMN; const char* WKT; const char* WVT; int G, c;
  DI bool next(int i, Unit& u) const { const int L = i * G + c; if (L >= 32) return false; const int t = L >> 4, m = (L >> 2) & 3, n = L & 3;
    u.pm = t * 4 + m; u.pn = n; u.a = MEMN + (size_t)(m * 256) * DM * 2; u.b = (t ? WVT : WKT) + (size_t)(n * 256) * DM * 2; return true; }
};
}

struct Ctx {
  LAS unsigned char* lds;
  int tid, lane, wave, G, gw, NGW;
  const float* const* in;
  float* H;
  unsigned char* ws;
};
DI Ctx fresh(const Ctx& F) { Ctx R = F; int t = threadIdx.x; asm volatile("" : "+v"(t)); R.tid = t; R.lane = t & 63; R.wave = __builtin_amdgcn_readfirstlane(t >> 6); R.gw = blockIdx.x * NWAVES + R.wave; return R; }

DI void transpose_item(const float* W, int K, int Nsrc, int ldw, bf16_t* WT, int nblk, LAS float* scr, int item, int lane, int mode, const float* kgain = nullptr) {
  const int kb = item / nblk, nb = item % nblk, k0 = 64 * kb, n0 = 32 * nb;
  const int ncol = n0 + (lane & 31);
  float sc = 1.f;
  if (mode == 1) { if (ncol < 256) sc = 0.125f; else if (ncol >= C_NQ && ncol < C_NQ + 512) sc = 0.125f * 1.4426950408889634f; }
  if (mode == 2) sc = 0.0625f;
  float tv[32];
#pragma unroll
  for (int i = 0; i < 32; ++i) { const int kk = 2 * i + (lane >> 5); tv[i] = ncol < Nsrc ? W[(size_t)(k0 + kk) * ldw + ncol] : 0.f; }
#pragma unroll
  for (int i = 0; i < 32; ++i) { const int kk = 2 * i + (lane >> 5); const float gk = kgain ? kgain[k0 + kk] : 1.f; scr[kk * 33 + (lane & 31)] = tv[i] * (sc * gk); }
  asm volatile("s_waitcnt lgkmcnt(0)" ::: "memory");
  const int c = lane & 7;
#pragma unroll
  for (int j = 0; j < 4; ++j) { const int n = (lane >> 3) + 8 * j; const LAS float* s = scr + (8 * c) * 33 + n;
    u32x4 o; o.x = cvtpk(s[0 * 33], s[1 * 33]); o.y = cvtpk(s[2 * 33], s[3 * 33]); o.z = cvtpk(s[4 * 33], s[5 * 33]); o.w = cvtpk(s[6 * 33], s[7 * 33]);
    *(u32x4*)(WT + (size_t)(n0 + n) * K + k0 + 8 * c) = o; }
  asm volatile("s_waitcnt lgkmcnt(0)" ::: "memory");
}
DI void rms_row_bf16(const float* xrow, const float* g, bf16_t* orow, int lane) {
  const f32x4* xr = (const f32x4*)xrow + lane;
  f32x4 v[4]; float s = 0.f;
#pragma unroll
  for (int j = 0; j < 4; ++j) { v[j] = xr[64 * j]; s += (v[j].x * v[j].x + v[j].y * v[j].y) + (v[j].z * v[j].z + v[j].w * v[j].w); }
  const float r = rsqrtf(wave_sum(s) * (1.f / DM) + EPS);
  u32x2* o8 = (u32x2*)orow + lane;
#pragma unroll
  for (int j = 0; j < 4; ++j) { const f32x4 gg = ((const f32x4*)g)[lane + 64 * j]; u32x2 w; w.x = cvtpk(v[j].x * r * gg.x, v[j].y * r * gg.y); w.y = cvtpk(v[j].z * r * gg.z, v[j].w * r * gg.w); o8[64 * j] = w; }
}
DI void cvt_row_fp8(const float* xrow, unsigned char* orow, float* inv_scale, int lane, const float* cgain = nullptr) {
  const f32x4* xr = (const f32x4*)xrow + lane; unsigned* o4 = (unsigned*)orow + lane;
  f32x4 v[4]; float mx = 0.f;
#pragma unroll
  for (int j = 0; j < 4; ++j) { v[j] = xr[64 * j]; if (cgain) v[j] = v[j] * ((const f32x4*)cgain)[lane + 64 * j]; mx = fmaxf(mx, fmaxf(fmaxf(fabsf(v[j].x), fabsf(v[j].y)), fmaxf(fabsf(v[j].z), fabsf(v[j].w)))); }
#pragma unroll
  for (int o = 1; o < 64; o <<= 1) mx = fmaxf(mx, __shfl_xor(mx, o));
  const float sc = mx > 0.f ? 256.f / mx : 1.f;
#pragma unroll
  for (int j = 0; j < 4; ++j) { int w = 0; w = __builtin_amdgcn_cvt_pk_fp8_f32(v[j].x * sc, v[j].y * sc, w, false); w = __builtin_amdgcn_cvt_pk_fp8_f32(v[j].z * sc, v[j].w * sc, w, true); o4[64 * j] = (unsigned)w; }
  if (lane == 0) *inv_scale = mx > 0.f ? mx * (1.f / 256.f) : 1.f;
}
DI void cvt_row_bf16(const float* xrow, bf16_t* orow, int lane) {
  const f32x4* xr = (const f32x4*)xrow + lane; u32x2* o8 = (u32x2*)orow + lane;
#pragma unroll
  for (int j = 0; j < 4; ++j) { const f32x4 v = xr[64 * j]; u32x2 w; w.x = cvtpk(v.x, v.y); w.y = cvtpk(v.z, v.w); o8[64 * j] = w; }
}

DI void rows4_load(f32x4 (&v)[4][4], const float* x, const int (&rows)[4], int lane) {
#pragma unroll
  for (int q = 0; q < 4; ++q) { const f32x4* xr = (const f32x4*)(x + (size_t)rows[q] * DM) + lane;
#pragma unroll
    for (int j = 0; j < 4; ++j) v[q][j] = xr[64 * j]; }
}
DI void rms_rows4_bf16(f32x4 (&v)[4][4], const float* g, bf16_t* o, const int (&rows)[4], int lane) {
#pragma unroll
  for (int q = 0; q < 4; ++q) { float s = 0.f;
#pragma unroll
    for (int j = 0; j < 4; ++j) s += (v[q][j].x * v[q][j].x + v[q][j].y * v[q][j].y) + (v[q][j].z * v[q][j].z + v[q][j].w * v[q][j].w);
    const float r = rsqrtf(wave_sum(s) * (1.f / DM) + EPS);
    u32x2* o8 = (u32x2*)(o + (size_t)rows[q] * DM) + lane;
#pragma unroll
    for (int j = 0; j < 4; ++j) { const f32x4 gg = ((const f32x4*)g)[lane + 64 * j]; u32x2 w; w.x = cvtpk(v[q][j].x * r * gg.x, v[q][j].y * r * gg.y); w.y = cvtpk(v[q][j].z * r * gg.z, v[q][j].w * r * gg.w); o8[64 * j] = w; } }
}
DI void cvt_rows4_fp8(f32x4 (&v)[4][4], unsigned char* o, float* inv_scale, const int (&rows)[4], int lane, const float* cgain) {
#pragma unroll
  for (int q = 0; q < 4; ++q) { float mx = 0.f;
#pragma unroll
    for (int j = 0; j < 4; ++j) { if (cgain) v[q][j] = v[q][j] * ((const f32x4*)cgain)[lane + 64 * j]; mx = fmaxf(mx, fmaxf(fmaxf(fabsf(v[q][j].x), fabsf(v[q][j].y)), fmaxf(fabsf(v[q][j].z), fabsf(v[q][j].w)))); }
#pragma unroll
    for (int o_ = 1; o_ < 64; o_ <<= 1) mx = fmaxf(mx, __shfl_xor(mx, o_));
    const float sc = mx > 0.f ? 256.f / mx : 1.f;
#pragma unroll
    for (int j = 0; j < 4; ++j) { int w = 0; w = __builtin_amdgcn_cvt_pk_fp8_f32(v[q][j].x * sc, v[q][j].y * sc, w, false); w = __builtin_amdgcn_cvt_pk_fp8_f32(v[q][j].z * sc, v[q][j].w * sc, w, true);
      const int col = 4 * (lane + 64 * j); *(unsigned*)(o + ((size_t)(col >> 7) * 16384 + rows[q]) * 128 + (col & 127)) = (unsigned)w; }
    if (lane == 0) inv_scale[rows[q]] = mx > 0.f ? mx * (1.f / 256.f) : 1.f; }
}
struct BigItem { const float* src; int kind; int rows[4]; };

DI void prologue(const Ctx& F0) {
  const Ctx F = fresh(F0);
  LAS float* scr = (LAS float*)(F.lds + F.wave * 16384);
  unsigned char* ws = F.ws;
  auto do_transposes = [&]() {
  constexpr int I_IN = 16 * 96, I_SQ = 16 * 32, I_W1 = 32 * 4, I_W2 = 2 * 2;
  constexpr int NT_ITEMS = I_IN + 5 * I_SQ + 2 * I_W1 + 2 * I_W2;
  for (int it = F.gw; it < NT_ITEMS; it += F.NGW) {
    int r = it;
    if (r < I_IN) { transpose_item(F.in[I_WIN], 1024, IN_COLS, IN_COLS, (bf16_t*)(ws + WS_WIN), 96, scr, r, F.lane, 1); continue; } r -= I_IN;
    if (r < I_SQ) { transpose_item(F.in[I_WOUT], 1024, 1024, 1024, (bf16_t*)(ws + WS_WOUT), 32, scr, r, F.lane, 0); continue; } r -= I_SQ;
    if (r < I_SQ) { transpose_item(F.in[I_XWK], 1024, 1024, 1024, (bf16_t*)(ws + WS_XWK), 32, scr, r, F.lane, 0); continue; } r -= I_SQ;
    if (r < I_SQ) { transpose_item(F.in[I_XWV], 1024, 1024, 1024, (bf16_t*)(ws + WS_XWV), 32, scr, r, F.lane, 0); continue; } r -= I_SQ;
    if (r < I_SQ) { transpose_item(F.in[I_XWO], 1024, 1024, 1024, (bf16_t*)(ws + WS_XWO), 32, scr, r, F.lane, 0); continue; } r -= I_SQ;
    if (r < I_SQ) { transpose_item(F.in[I_PWQ], 1024, 1024, 1024, (bf16_t*)(ws + WS_PWQ), 32, scr, r, F.lane, 0, F.in[I_NFFN]); continue; } r -= I_SQ;
    if (r < I_W1) { transpose_item(F.in[I_CKW1], 2048, 128, 128, (bf16_t*)(ws + WS_W1T), 4, scr, r, F.lane, 0); continue; } r -= I_W1;
    if (r < I_W1) { transpose_item(F.in[I_CVW1], 2048, 128, 128, (bf16_t*)(ws + WS_W1T) + 128 * 2048, 4, scr, r, F.lane, 0); continue; } r -= I_W1;
    if (r < I_W2) { transpose_item(F.in[I_CKW2], 128, 64, 64, (bf16_t*)(ws + WS_W2T), 2, scr, r, F.lane, 0); continue; } r -= I_W2;
    transpose_item(F.in[I_CVW2], 128, 64, 64, (bf16_t*)(ws + WS_W2T) + 64 * 128, 2, scr, r, F.lane, 0);
  }
  };
  auto do_bigrows = [&]() {
  {
    const int step = 4 * F.NGW, nx = (NTOK + step - 1) / step, nt = (16384 + step - 1) / step, J = nx + 2 * nt;
    auto item = [&](int j, BigItem& I) -> bool {
      int r0, nmax;
      if (j < nx) { I.src = F.in[I_X]; I.kind = 0; r0 = F.gw + j * step; nmax = NTOK; }
      else { const int jj = j - nx; I.kind = 1 + (jj & 1); I.src = F.in[(jj & 1) ? I_PUP : I_PDOWN]; r0 = F.gw + (jj >> 1) * step; nmax = 16384; }
      if (r0 >= nmax) return false;
#pragma unroll
      for (int q = 0; q < 4; ++q) I.rows[q] = min(r0 + q * F.NGW, nmax - 1);
      return true; };
    auto proc = [&](f32x4 (&v)[4][4], const BigItem& I) {
      if (I.kind == 0) rms_rows4_bf16(v, F.in[I_NMIX], (bf16_t*)(ws + WS_HN), I.rows, F.lane);
      else if (I.kind == 1) cvt_rows4_fp8(v, ws + WS_PDOWN8, (float*)(ws + WS_DSC), I.rows, F.lane, F.in[I_NFFN]);
      else cvt_rows4_fp8(v, ws + WS_PUP8, (float*)(ws + WS_USC), I.rows, F.lane, nullptr); };
    f32x4 VA[4][4], VB[4][4]; BigItem IA, IB;
    bool ha = item(0, IA); if (ha) rows4_load(VA, IA.src, IA.rows, F.lane);
#pragma unroll 1
    for (int j = 0; j < J; j += 2) {
      const bool hb = (j + 1 < J) && item(j + 1, IB); if (hb) rows4_load(VB, IB.src, IB.rows, F.lane);
      if (ha) proc(VA, IA);
      ha = (j + 2 < J) && item(j + 2, IA); if (ha) rows4_load(VA, IA.src, IA.rows, F.lane);
      if (hb) proc(VB, IB);
    }
  }
  };
  if (F.wave & 1) { do_bigrows(); do_transposes(); } else { do_transposes(); do_bigrows(); }
  constexpr int R_MEM = 1024, R_WQ = 1024, R_SK = 128, R_C1 = 256, R_BK = 8;
  constexpr int NR_ITEMS = R_MEM + R_WQ + R_SK + R_C1 + R_BK;
  for (int it = F.gw; it < NR_ITEMS; it += F.NGW) {
    int r = it;
    if (r < R_MEM) { rms_row_bf16(F.in[I_MEM] + (size_t)r * DM, F.in[I_NMEM], (bf16_t*)(ws + WS_MEMN) + (size_t)r * DM, F.lane); continue; } r -= R_MEM;
    if (r < R_WQ) {
      const float sck = F.in[I_NXA][r] * 0.0625f; const f32x4* xr = (const f32x4*)(F.in[I_XWQ] + (size_t)r * DM) + F.lane; u32x2* o8 = (u32x2*)((bf16_t*)(ws + WS_XWQ) + (size_t)r * DM) + F.lane;
#pragma unroll
      for (int j = 0; j < 4; ++j) { const f32x4 v = xr[64 * j] * sck; u32x2 w; w.x = cvtpk(v.x, v.y); w.y = cvtpk(v.z, v.w); o8[64 * j] = w; }
      continue; } r -= R_WQ;
    if (r < R_SK) { cvt_row_bf16(F.in[I_PSK] + (size_t)r * 1024, (bf16_t*)(ws + WS_SK) + (size_t)r * 1024, F.lane); continue; } r -= R_SK;
    if (r < R_C1) {
      const int kv = r >> 7, hid = r & 127; const float* pos = F.in[kv ? I_POSV : I_POSK]; const float* w1 = F.in[kv ? I_CVW1 : I_CKW1];
      float s = 0.f;
      for (int i = F.lane; i < 2048; i += 64) s += pos[i] * w1[(size_t)i * 128 + hid];
      s = wave_sum(s);
      if (F.lane == 0) ((float*)(ws + WS_C1))[kv * 128 + hid] = s;
      continue; } r -= R_C1;
    {
      unsigned char* bk = ws + WS_BUCK;
      for (int i = F.lane; i < 1024; i += 64) { const int d = r * 1024 + i;
        int b = d;
        if (d >= 16) { b = 16; const int thr[15] = {22, 30, 40, 54, 73, 99, 134, 182, 246, 332, 450, 609, 825, 1117, 1513};
#pragma unroll
          for (int k = 0; k < 15; ++k) b += (d >= thr[k]) ? 1 : 0; }
        bk[d] = (unsigned char)b; }
    }
  }
}

constexpr int GL_LA = 0, GL_SEG = 16384, GL_GLR = 18432, GL_W2 = 22528, GL_BIAS = 26624, GL_QT = 27648, GL_KT = 35840, GL_KTT = 44032, GL_V = 52224, GL_O = 68608;
constexpr int G0_STRIDE = 68608;
constexpr int G1_QT = 0, G1_KT = 8192, G1_V = 16384, G1_O = 32768, G1_STRIDE = 66560;
template <int MODE>
DI void gla_pair(const Ctx& F, const int ua, const int ub) {
  const int tid = F.tid, lane = F.lane, w = F.wave;
  const bf16_t* Z = (const bf16_t*)(F.ws + WS_Z);
  const int t = tid >> 3, c8 = tid & 7;
  const int r32 = lane & 31, hi = lane >> 5, i16 = lane & 15, g16 = lane >> 4;
  const int un[2] = {ua, ub};
  __syncthreads();
  if constexpr (MODE == 0) {
    u32x4 q8[2], k8[2];
#pragma unroll
    for (int s = 0; s < 2; ++s) {
      const int unit = un[s], c = unit & 127, h = (unit >> 7) & 3, b = unit >> 9; const size_t m0 = (size_t)b * T + (size_t)c * 64;
      LAS unsigned char* L = F.lds + s * G0_STRIDE;
      const bf16_t* zrow = Z + (m0 + t) * ZP;
      q8[s] = *(const u32x4*)(zrow + C_GQ + h * 64 + c8 * 8); k8[s] = *(const u32x4*)(zrow + C_GK + h * 64 + c8 * 8);
      const u32x4 v0 = *(const u32x4*)(zrow + C_GV + h * 128 + c8 * 8), v1 = *(const u32x4*)(zrow + C_GV + h * 128 + 64 + c8 * 8);
      *(LAS u32x4*)(L + GL_V + t * 256 + c8 * 16) = v0; *(LAS u32x4*)(L + GL_V + t * 256 + 128 + c8 * 16) = v1;
      if (tid < 128) { const int tt = tid >> 1, hf = tid & 1; const u32x4 g = *(const u32x4*)(Z + (m0 + tt) * ZP + C_GLR + hf * 8);
        LAS float* o = (LAS float*)(L + GL_GLR) + tt * 16 + hf * 8; o[0] = bflo(g.x); o[1] = bfhi(g.x); o[2] = bflo(g.y); o[3] = bfhi(g.y); o[4] = bflo(g.z); o[5] = bfhi(g.z); o[6] = bflo(g.w); o[7] = bfhi(g.w); }
      if (tid < 256) { const int r = tid >> 4, c4 = tid & 15; *(LAS f32x4*)((LAS float*)(L + GL_W2) + r * 64 + c4 * 4) = *(const f32x4*)(F.in[I_GW2] + r * 256 + h * 64 + c4 * 4); }
      if (tid < 64) ((LAS float*)(L + GL_BIAS))[tid] = F.in[I_GB][h * 64 + tid];
    }
    __syncthreads();
#pragma unroll
    for (int s = 0; s < 2; ++s) {
      LAS unsigned char* L = F.lds + s * G0_STRIDE;
      LAS float* LA = (LAS float*)(L + GL_LA); const LAS float* GLR = (const LAS float*)(L + GL_GLR); const LAS float* W2 = (const LAS float*)(L + GL_W2); const LAS float* BIAS = (const LAS float*)(L + GL_BIAS);
      float z[8];
#pragma unroll
      for (int j = 0; j < 8; ++j) z[j] = BIAS[c8 * 8 + j];
#pragma unroll
      for (int r = 0; r < 16; ++r) { const float g = GLR[t * 16 + r];
#pragma unroll
        for (int j = 0; j < 8; ++j) z[j] += g * W2[r * 64 + c8 * 8 + j]; }
#pragma unroll
      for (int j = 0; j < 8; ++j) { const float zz = z[j]; const float ls = fminf(zz, 0.f) - __logf(1.f + __expf(-fabsf(zz))); LA[t * 64 + c8 * 8 + j] = ls * (1.f / 16.f); }
    }
    __syncthreads();
    {
      const int d = tid & 63, seg = tid >> 6; float v[2][8];
#pragma unroll
      for (int s = 0; s < 2; ++s) { LAS unsigned char* L = F.lds + s * G0_STRIDE; const LAS float* LA = (const LAS float*)(L + GL_LA); float run = 0.f;
#pragma unroll
        for (int i = 0; i < 8; ++i) { run += LA[(seg * 8 + i) * 64 + d]; v[s][i] = run; }
        ((LAS float*)(L + GL_SEG))[seg * 64 + d] = run; }
      __syncthreads();
#pragma unroll
      for (int s = 0; s < 2; ++s) { LAS unsigned char* L = F.lds + s * G0_STRIDE; LAS float* LA = (LAS float*)(L + GL_LA); const LAS float* SEG = (const LAS float*)(L + GL_SEG); float off = 0.f;
#pragma unroll
        for (int q = 0; q < 8; ++q) off += (q < seg) ? SEG[q * 64 + d] : 0.f;
#pragma unroll
        for (int i = 0; i < 8; ++i) LA[(seg * 8 + i) * 64 + d] = v[s][i] + off; }
    }
    __syncthreads();
#pragma unroll
    for (int s = 0; s < 2; ++s) {
      const int unit = un[s]; LAS unsigned char* L = F.lds + s * G0_STRIDE; const LAS float* LA = (const LAS float*)(L + GL_LA);
      float bb[8];
#pragma unroll
      for (int j = 0; j < 8; ++j) bb[j] = LA[t * 64 + c8 * 8 + j];
      const unsigned qw[4] = {q8[s].x, q8[s].y, q8[s].z, q8[s].w}, kw[4] = {k8[s].x, k8[s].y, k8[s].z, k8[s].w};
      u32x4 qo, ko; unsigned kk16[8];
#pragma unroll
      for (int p = 0; p < 4; ++p) {
        const float e0 = __expf(bb[2 * p]), e1 = __expf(bb[2 * p + 1]);
        const unsigned qp = cvtpk(bflo(qw[p]) * e0, bfhi(qw[p]) * e1), kp = cvtpk(bflo(kw[p]) / e0, bfhi(kw[p]) / e1);
        qo[p] = qp; ko[p] = kp; kk16[2 * p] = kp & 0xffffu; kk16[2 * p + 1] = kp >> 16;
      }
      *(u32x4*)((bf16_t*)(F.ws + WS_GQ) + (size_t)unit * 4096 + t * 64 + c8 * 8) = qo;
      *(u32x4*)((bf16_t*)(F.ws + WS_GK) + (size_t)unit * 4096 + t * 64 + c8 * 8) = ko;
#pragma unroll
      for (int j = 0; j < 8; ++j) { const int d = c8 * 8 + j; *(LAS unsigned short*)(L + GL_KTT + d * 128 + (((t >> 3) ^ (d & 7)) << 4) + (t & 7) * 2) = (unsigned short)kk16[j]; }
    }
    __syncthreads();
#pragma unroll
    for (int s = 0; s < 2; ++s) {
      const int unit = un[s]; LAS unsigned char* L = F.lds + s * G0_STRIDE;
      const int dvt = w >> 1, dt = w & 1; f32x16 acc = {}; const int dcol = 32 * dt + r32;
#pragma unroll
      for (int ks = 0; ks < 4; ++ks) {
        const LAS unsigned char* vp = L + GL_V + (16 * ks + 8 * hi + (i16 >> 2)) * 256 + (32 * dvt + 16 * (g16 & 1) + 4 * (i16 & 3)) * 2;
        const bf16x8 a = cat8(vtr(vp), vtr(vp + 4 * 256));
        const bf16x8 bfr = *(const LAS bf16x8*)(L + GL_KTT + dcol * 128 + (((2 * ks + hi) ^ (dcol & 7)) << 4));
        acc = MFMA32(a, bfr, acc);
      }
      float* U = (float*)(F.ws + WS_GU) + (size_t)unit * 8192;
#pragma unroll
      for (int r = 0; r < 16; ++r) U[(32 * dvt + crow(r, hi)) * 64 + dcol] = acc[r];
      if (tid < 64) ((float*)(F.ws + WS_DL))[unit * 64 + tid] = __expf(((const LAS float*)(L + GL_LA))[63 * 64 + tid]);
    }
  } else {
    u32x4 gr0[2], gr1[2]; bf16x8 sf[2][4];
#pragma unroll
    for (int s = 0; s < 2; ++s) {
      const int unit = un[s], c = unit & 127, h = (unit >> 7) & 3, b = unit >> 9; const size_t m0 = (size_t)b * T + (size_t)c * 64;
      LAS unsigned char* L = F.lds + s * G1_STRIDE;
      const bf16_t* zrow = Z + (m0 + t) * ZP;
      const u32x4 qo = *(const u32x4*)((const bf16_t*)(F.ws + WS_GQ) + (size_t)unit * 4096 + t * 64 + c8 * 8);
      const u32x4 ko = *(const u32x4*)((const bf16_t*)(F.ws + WS_GK) + (size_t)unit * 4096 + t * 64 + c8 * 8);
      const u32x4 v0 = *(const u32x4*)(zrow + C_GV + h * 128 + c8 * 8), v1 = *(const u32x4*)(zrow + C_GV + h * 128 + 64 + c8 * 8);
      const int seg = tid & 7;
      gr0[s] = *(const u32x4*)(zrow + C_GR + h * 128 + seg * 16); gr1[s] = *(const u32x4*)(zrow + C_GR + h * 128 + seg * 16 + 8);
      const bf16_t* S = (const bf16_t*)(F.ws + WS_GS) + (size_t)unit * 8192;
#pragma unroll
      for (int kd = 0; kd < 4; ++kd) sf[s][kd] = *(const bf16x8*)(S + (32 * (w >> 1) + r32) * 64 + 16 * kd + 8 * hi);
      const int swz = (c8 ^ (t & 7)) << 4;
      *(LAS u32x4*)(L + G1_QT + t * 128 + swz) = qo; *(LAS u32x4*)(L + G1_KT + t * 128 + swz) = ko;
      *(LAS u32x4*)(L + G1_V + t * 256 + c8 * 16) = v0; *(LAS u32x4*)(L + G1_V + t * 256 + 128 + c8 * 16) = v1;
    }
    __syncthreads();
#pragma unroll
    for (int s = 0; s < 2; ++s) {
      const int unit = un[s], c = unit & 127; LAS unsigned char* L = F.lds + s * G1_STRIDE;
      const int dvt = w >> 1, tt = w & 1; f32x16 o = {}; const int tcol = 32 * tt + r32;
      for (int st = 0; st <= tt; ++st) {
        f32x16 x = {}; const int srow = 32 * st + r32;
#pragma unroll
        for (int kd = 0; kd < 4; ++kd) {
          const bf16x8 a = *(const LAS bf16x8*)(L + G1_KT + srow * 128 + (((2 * kd + hi) ^ (srow & 7)) << 4));
          const bf16x8 bfr = *(const LAS bf16x8*)(L + G1_QT + tcol * 128 + (((2 * kd + hi) ^ (tcol & 7)) << 4));
          x = MFMA32(a, bfr, x);
        }
        if (st == tt) {
#pragma unroll
          for (int r = 0; r < 16; ++r) if (crow(r, hi) > r32) x[r] = 0.f;
        }
#pragma unroll
        for (int ks2 = 0; ks2 < 2; ++ks2) {
          const LAS unsigned char* vp = L + G1_V + (32 * st + 16 * ks2 + 4 * hi + (i16 >> 2)) * 256 + (32 * dvt + 16 * (g16 & 1) + 4 * (i16 & 3)) * 2;
          const bf16x8 a = cat8(vtr(vp), vtr(vp + 8 * 256));
          o = MFMA32(a, pack8(x, ks2), o);
        }
      }
      if (c > 0) {
#pragma unroll
        for (int kd = 0; kd < 4; ++kd) {
          const bf16x8 bfr = *(const LAS bf16x8*)(L + G1_QT + tcol * 128 + (((2 * kd + hi) ^ (tcol & 7)) << 4));
          o = MFMA32(sf[s][kd], bfr, o);
        }
      }
      LAS float* OL = (LAS float*)(L + G1_O);
#pragma unroll
      for (int r = 0; r < 16; ++r) OL[tcol * 129 + 32 * dvt + crow(r, hi)] = o[r];
    }
    __syncthreads();
#pragma unroll
    for (int s = 0; s < 2; ++s) {
      const int unit = un[s], c = unit & 127, h = (unit >> 7) & 3, b = unit >> 9; const size_t m0 = (size_t)b * T + (size_t)c * 64;
      const LAS float* OL = (const LAS float*)(F.lds + s * G1_STRIDE + G1_O);
      const int seg = tid & 7; float v[16]; float ss = 0.f;
#pragma unroll
      for (int j = 0; j < 16; ++j) { v[j] = OL[t * 129 + seg * 16 + j]; ss += v[j] * v[j]; }
      ss += __shfl_xor(ss, 1); ss += __shfl_xor(ss, 2); ss += __shfl_xor(ss, 4);
      const float rs = rsqrtf(ss * (1.f / 128.f) + EPS);
      const unsigned gw_[8] = {gr0[s].x, gr0[s].y, gr0[s].z, gr0[s].w, gr1[s].x, gr1[s].y, gr1[s].z, gr1[s].w};
      const float* on = F.in[I_GON] + seg * 16;
      unsigned ow[8];
#pragma unroll
      for (int p = 0; p < 8; ++p) { const float ga = bflo(gw_[p]), gb = bfhi(gw_[p]);
        const float oa = v[2 * p] * rs * on[2 * p] * (ga * sigmoidf_(ga)), ob = v[2 * p + 1] * rs * on[2 * p + 1] * (gb * sigmoidf_(gb)); ow[p] = cvtpk(oa, ob); }
      bf16_t* dst = (bf16_t*)(F.ws + WS_OCAT) + (m0 + t) * DM + h * 128 + seg * 16;
      *(u32x4*)dst = (u32x4){ow[0], ow[1], ow[2], ow[3]}; *(u32x4*)(dst + 8) = (u32x4){ow[4], ow[5], ow[6], ow[7]};
    }
  }
}
template <int MODE>
DI void gla_phase(const Ctx& F0) {
  const Ctx F = fresh(F0);
  const int bx = blockIdx.x, G = F.G;
  const int nu = bx < 2048 ? (2048 - bx + G - 1) / G : 0;
#pragma unroll 1
  for (int i = 0; i < nu; i += 2) gla_pair<MODE>(F, bx + i * G, bx + (i + 1 < nu ? i + 1 : i) * G);
}
DI void gla_scan(const Ctx& F0) {
  const Ctx F = fresh(F0);
  const float* U = (const float*)(F.ws + WS_GU); const float* DL = (const float*)(F.ws + WS_DL); bf16_t* GS = (bf16_t*)(F.ws + WS_GS);
  for (int e = blockIdx.x * NTHREADS + F.tid; e < 16 * 8192; e += F.G * NTHREADS) {
    const int bh = e >> 13, rem = e & 8191, d = e & 63;
    float S = 0.f;
#pragma unroll 8
    for (int c = 0; c < 128; ++c) { const size_t unit = (size_t)bh * 128 + c;
      GS[unit * 8192 + rem] = (bf16_t)f2bf(S);
      S = DL[unit * 64 + d] * (S + U[unit * 8192 + rem]); }
  }
}

DI void nsa_compress_unit(const Ctx& F0, const int wt) {
  const Ctx F = fresh(F0);
  const int lane = F.lane, w = F.wave, r32 = lane & 31, hi = lane >> 5;
  const int kv = wt >> 7, nt = wt & 127, bg = nt >> 4, n0 = (nt & 15) * 32, b = bg >> 1, g = bg & 1;
  const bf16_t* Z = (const bf16_t*)(F.ws + WS_Z);
  const bf16_t* W1T = (const bf16_t*)(F.ws + WS_W1T) + (size_t)kv * 128 * 2048;
  const bf16_t* W2T = (const bf16_t*)(F.ws + WS_W2T) + (size_t)kv * 64 * 128;
  const float* C1 = (const float*)(F.ws + WS_C1) + kv * 128;
  const int col0 = (kv ? C_VC : C_KC) + g * 64;
  const int n = n0 + r32;
  LAS float* RED = (LAS float*)F.lds;
  __syncthreads();
  f32x16 acc[4] = {};
#pragma unroll
  for (int ll = 0; ll < 4; ++ll) {
    const int l = 4 * w + ll;
    int trow = 16 * n + l; trow = trow > T - 1 ? T - 1 : trow;
    const bf16_t* src = Z + ((size_t)b * T + trow) * ZP + col0 + 8 * hi;
#pragma unroll
    for (int q = 0; q < 4; ++q) {
      const int ks = 4 * l + q;
      const bf16x8 bfr = *(const bf16x8*)(src + 16 * q);
#pragma unroll
      for (int ht = 0; ht < 4; ++ht) { const bf16x8 a = *(const bf16x8*)(W1T + (size_t)(32 * ht + r32) * 2048 + 16 * ks + 8 * hi); acc[ht] = MFMA32(a, bfr, acc[ht]); }
    }
  }
#pragma unroll
  for (int ht = 0; ht < 4; ++ht)
#pragma unroll
    for (int r = 0; r < 16; ++r) RED[w * 4096 + (ht * 16 + r) * 64 + lane] = acc[ht][r];
  __syncthreads();
  if (w == 0) {
    bf16x8 pb[4][2];
#pragma unroll
    for (int ht = 0; ht < 4; ++ht) {
#pragma unroll
      for (int r = 0; r < 16; ++r) { float sm = 0.f;
#pragma unroll
        for (int ww = 0; ww < 8; ++ww) sm += RED[ww * 4096 + (ht * 16 + r) * 64 + lane];
        acc[ht][r] = gelu_tanh(sm + C1[32 * ht + crow(r, hi)]); }
      pb[ht][0] = pack8(acc[ht], 0); pb[ht][1] = pack8(acc[ht], 1);
    }
    bf16_t* OUT = (bf16_t*)(F.ws + (kv ? WS_VCMP : WS_KCMP)) + ((size_t)bg * 512 + n) * 64;
#pragma unroll
    for (int dt = 0; dt < 2; ++dt) {
      f32x16 o = {};
#pragma unroll
      for (int ht = 0; ht < 4; ++ht)
#pragma unroll
        for (int ks2 = 0; ks2 < 2; ++ks2) {
          const bf16_t* wp = W2T + (size_t)(32 * dt + r32) * 128 + 32 * ht + 16 * ks2 + 4 * hi;
          const u32x2 lo = *(const u32x2*)wp, hi2 = *(const u32x2*)(wp + 8);
          const u32x4 aw = {lo.x, lo.y, hi2.x, hi2.y};
          o = MFMA32(__builtin_bit_cast(bf16x8, aw), pb[ht][ks2], o);
        }
#pragma unroll
      for (int rr = 0; rr < 4; ++rr) { u32x2 wv; wv.x = cvtpk(o[4 * rr], o[4 * rr + 1]); wv.y = cvtpk(o[4 * rr + 2], o[4 * rr + 3]); *(u32x2*)(OUT + 32 * dt + 8 * rr + 4 * hi) = wv; }
    }
  }
  __syncthreads();
}

constexpr int NS_K = 0, NS_V = 32768, NS_IMP = 65536, NS_MASK = 99328, NS_BUCK = 100352, NS_BIAS = 108544, NS_THR = 109056, NS_WB = 109184;
constexpr int IMP_P = 132;
constexpr int NS_X3 = NS_IMP;
struct TileSrc { const bf16_t* k; const bf16_t* v; int pitch; };
DI void ns_load(u32x4& kr, u32x4& vr, const TileSrc& s, int row0, int tid) {
  const int key = tid >> 3, c8 = tid & 7;
  kr = *(const u32x4*)(s.k + (size_t)(row0 + key) * s.pitch + c8 * 8);
  vr = *(const u32x4*)(s.v + (size_t)(row0 + key) * s.pitch + c8 * 8);
}
DI void ns_store(LAS unsigned char* L, int buf, const u32x4& kr, const u32x4& vr, int tid) {
  const int key = tid >> 3, c8 = tid & 7;
  *(LAS u32x4*)(L + NS_K + buf * 8192 + key * 128 + ((c8 ^ ((key >> 1) & 7)) << 4)) = kr;
  *(LAS u32x4*)(L + NS_V + buf * 8192 + key * 128 + ((c8 * 16) ^ (((key >> 1) & 1) << 6))) = vr;
}
DI void ns_qk(f32x16& p0, f32x16& p1, const LAS unsigned char* Kb, const bf16x8 (&qf)[4], int r32, int hi) {
  p0 = (f32x16){}; p1 = (f32x16){};
#pragma unroll
  for (int ks = 0; ks < 4; ++ks) {
    const bf16x8 a0 = *(const LAS bf16x8*)(Kb + r32 * 128 + (((2 * ks + hi) ^ ((r32 >> 1) & 7)) << 4));
    const bf16x8 a1 = *(const LAS bf16x8*)(Kb + (32 + r32) * 128 + (((2 * ks + hi) ^ ((r32 >> 1) & 7)) << 4));
    p0 = MFMA32(a0, qf[ks], p0); p1 = MFMA32(a1, qf[ks], p1);
  }
}
DI void ns_pv(f32x16 (&o)[2], const LAS unsigned char* Vb, const f32x16& p0, const f32x16& p1, int lane) {
  const int hi = lane >> 5, i16 = lane & 15, g16 = lane >> 4;
#pragma unroll
  for (int ks = 0; ks < 4; ++ks) {
    const bf16x8 pb = pack8(ks < 2 ? p0 : p1, ks & 1);
#pragma unroll
    for (int dt = 0; dt < 2; ++dt) {
      const int vrow = 16 * ks + 4 * hi + (i16 >> 2);
      const LAS unsigned char* vp = Vb + vrow * 128 + (((32 * dt + 16 * (g16 & 1) + 4 * (i16 & 3)) * 2) ^ (((vrow >> 1) & 1) << 6));
      o[dt] = MFMA32(cat8(vtr(vp), vtr(vp + 8 * 128)), pb, o[dt]);
    }
  }
}
DI void ns_dma(LAS unsigned char* L, int kslot_off, int vslot_off, const TileSrc& s, int row0, int lane, int w) {
  const int row = 8 * w + (lane >> 3), pc = lane & 7;
  const bf16_t* kp = s.k + (size_t)(row0 + row) * s.pitch + ((pc ^ ((row >> 1) & 7)) << 3);
  const bf16_t* vp = s.v + (size_t)(row0 + row) * s.pitch + ((pc ^ (((row >> 1) & 1) << 2)) << 3);
  __builtin_amdgcn_global_load_lds((const unsigned*)kp, (LAS unsigned*)(L + kslot_off + w * 1024), 16, 0, 0);
  __builtin_amdgcn_global_load_lds((const unsigned*)vp, (LAS unsigned*)(L + vslot_off + w * 1024), 16, 0, 0);
}
DI float ns_bias(const LAS unsigned char* L, int hd, int dist) {
  const int dc = dist < 0 ? 0 : dist;
  const int bk = *(const LAS unsigned char*)(L + NS_BUCK + dc);
  return ((const LAS float*)(L + NS_BIAS))[bk * 4 + hd];
}
DI float ex2(float x) { return __builtin_amdgcn_exp2f(x); }

DI void nsa_unit(const Ctx& F0, const int bg, const int tile, int& tab_g) {
  const Ctx F = fresh(F0);
  const int tid = F.tid, lane = F.lane, w = F.wave, r32 = lane & 31, hi = lane >> 5;
  const int b = bg >> 1, g = bg & 1, t0 = tile * 64, cur = tile;
  LAS unsigned char* L = F.lds;
  const bf16_t* Z = (const bf16_t*)(F.ws + WS_Z);
  const int tokl = r32 >> 2, hd = r32 & 3, head = g * 4 + hd;
  const int t = t0 + 8 * w + tokl;
  const size_t mrow = (size_t)b * T + t;
  __syncthreads();
  if (tab_g != g) {
  for (int i = tid; i < 2048; i += NTHREADS) ((LAS unsigned*)(L + NS_BUCK))[i] = ((const unsigned*)(F.ws + WS_BUCK))[i];
  if (tid < 128) ((LAS float*)(L + NS_BIAS))[tid] = F.in[I_RELB][(tid >> 2) * 8 + g * 4 + (tid & 3)] * 1.4426950408889634f;
  if (tid < 32) { const int thr[32] = {0, 1, 2, 3, 4, 5, 6, 7, 8, 9, 10, 11, 12, 13, 14, 15, 16, 22, 30, 40, 54, 73, 99, 134, 182, 246, 332, 450, 609, 825, 1117, 1513};
    int v = 0;
#pragma unroll
    for (int k = 0; k < 32; ++k) v = (tid == k) ? thr[k] : v;
    ((LAS int*)(L + NS_THR))[tid] = v; }
  __syncthreads();
  for (int i = tid; i < 4 * 576; i += NTHREADS) { const int hh = i / 576, d = i - hh * 576; ((LAS float*)(L + NS_WB))[hh * 577 + d] = ((const LAS float*)(L + NS_BIAS))[(int)*(const LAS unsigned char*)(L + NS_BUCK + d) * 4 + hh]; }
  tab_g = g; }
  bf16x8 qf[4];
#pragma unroll
  for (int ks = 0; ks < 4; ++ks) qf[ks] = *(const bf16x8*)(Z + mrow * ZP + C_NQ + head * 64 + 16 * ks + 8 * hi);
  float gate[3];
#pragma unroll
  for (int i = 0; i < 3; ++i) gate[i] = sigmoidf_(bf2f(Z[mrow * ZP + C_NG + head * 3 + i]));
  f32x16 tot[2] = {};
  u32x4 kr, vr;

  const int nmax = (t0 + 32) >> 4;
  const int nct = (nmax >> 6) + 1;
  TileSrc sc; sc.k = (const bf16_t*)(F.ws + WS_KCMP) + (size_t)bg * 512 * 64; sc.v = (const bf16_t*)(F.ws + WS_VCMP) + (size_t)bg * 512 * 64; sc.pitch = 64;
  float m_c = -1e30f, l_c = 0.f;
  u32x4 kr2 = {}, vr2 = {};
  ns_load(kr, vr, sc, 0, tid); ns_store(L, 0, kr, vr, tid); ns_load(kr, vr, sc, nct > 1 ? 64 : 0, tid); __syncthreads();
  auto step1 = [&](const int ci, u32x4& kA, u32x4& vA, u32x4& kB, u32x4& vB) {
    ns_load(kB, vB, sc, 64 * (ci + 2 < nct ? ci + 2 : nct - 1), tid);
    f32x16 p0, p1; ns_qk(p0, p1, L + NS_K + (ci & 1) * 8192, qf, r32, hi);
    float mt = -1e30f, kb = 0.f;
    if (t0 + 8 * w - 31 - 16 * (64 * ci + 63) >= 1513) {
      const float b31 = ((const LAS float*)(L + NS_BIAS))[31 * 4 + hd];
      float ma = -1e30f, mb = -1e30f;
#pragma unroll
      for (int r = 0; r < 16; r += 2) { ma = fmaxf(fmaxf(ma, p0[r]), p1[r]); mb = fmaxf(fmaxf(mb, p0[r + 1]), p1[r + 1]); }
      kb = b31; mt = fmaxf(ma, mb) + b31;
    } else {
#pragma unroll
    for (int hf = 0; hf < 2; ++hf)
#pragma unroll
      for (int r = 0; r < 16; ++r) { const int n = 64 * ci + 32 * hf + crow(r, hi); const int dist = t - 16 * n - 31;
        float s = (hf ? p1[r] : p0[r]) + ns_bias(L, hd, dist); s = dist >= 0 ? s : -INFINITY; if (hf) p1[r] = s; else p0[r] = s; mt = fmaxf(mt, s); }
    }
    const float mn = fmaxf(m_c, mt); float sum = 0.f; const float kc = kb - mn;
#pragma unroll
    for (int r = 0; r < 16; ++r) sum += ex2(p0[r] + kc) + ex2(p1[r] + kc);
    l_c = l_c * ex2(m_c - mn) + sum; m_c = mn;
    ns_store(L, (ci + 1) & 1, kA, vA, tid);
    __syncthreads();
  };
  for (int ci = 0; ci < nct; ci += 2) { step1(ci, kr, vr, kr2, vr2); if (ci + 1 < nct) step1(ci + 1, kr2, vr2, kr, vr); }
  { const float mo = __shfl_xor(m_c, 32), lo = __shfl_xor(l_c, 32); const float mn = fmaxf(m_c, mo); l_c = l_c * ex2(m_c - mn) + lo * ex2(mo - mn); m_c = mn; }
  const float inv_lc = l_c > 0.f ? 1.f / l_c : 0.f;
  {
    f32x16 oc[2] = {};
    float carry = 0.f;
    LAS float* IMP = (LAS float*)(L + NS_IMP);
    ns_load(kr, vr, sc, 0, tid); ns_store(L, 0, kr, vr, tid); ns_load(kr, vr, sc, nct > 1 ? 64 : 0, tid); __syncthreads();
    auto step2 = [&](const int ci, u32x4& kA, u32x4& vA, u32x4& kB, u32x4& vB) {
      ns_load(kB, vB, sc, 64 * (ci + 2 < nct ? ci + 2 : nct - 1), tid);
      f32x16 p0, p1; ns_qk(p0, p1, L + NS_K + (ci & 1) * 8192, qf, r32, hi);
      if (t0 + 8 * w - 31 - 16 * (64 * ci + 63) >= 1513) {
        const float bm = ((const LAS float*)(L + NS_BIAS))[31 * 4 + hd] - m_c;
#pragma unroll
        for (int r = 0; r < 16; ++r) { p0[r] = ex2(p0[r] + bm) * inv_lc; p1[r] = ex2(p1[r] + bm) * inv_lc; }
      } else {
#pragma unroll
      for (int hf = 0; hf < 2; ++hf)
#pragma unroll
        for (int r = 0; r < 16; ++r) { const int n = 64 * ci + 32 * hf + crow(r, hi); const int dist = t - 16 * n - 31;
          const float s = (hf ? p1[r] : p0[r]) + ns_bias(L, hd, dist); const float p = dist >= 0 ? ex2(s - m_c) * inv_lc : 0.f; if (hf) p1[r] = p; else p0[r] = p; }
      }
      ns_pv(oc, L + NS_V + (ci & 1) * 8192, p0, p1, lane);
      float x[2][4];
#pragma unroll
      for (int rr = 0; rr < 4; ++rr) { x[0][rr] = __shfl_xor(p0[4 * rr + 3], 32); x[1][rr] = __shfl_xor(p1[4 * rr + 3], 32); }
#pragma unroll
      for (int hf = 0; hf < 2; ++hf)
#pragma unroll
        for (int rr = 0; rr < 4; ++rr) {
          const f32x16& pp = hf ? p1 : p0;
          float part = pp[4 * rr] + pp[4 * rr + 1] + pp[4 * rr + 2] + 0.5f * pp[4 * rr + 3];
          const float prev_lo = rr > 0 ? x[hf][rr > 0 ? rr - 1 : 0] : (hf ? x[0][3] : carry);
          const float cross = hi ? x[hf][rr] : prev_lo;
          part += 0.5f * cross;
          part += __shfl_xor(part, 1); part += __shfl_xor(part, 2);
          if (hd == 0) IMP[(8 * w + tokl) * IMP_P + 16 * ci + 8 * hf + 2 * rr + hi] = part;
        }
      carry = x[1][3];
      ns_store(L, (ci + 1) & 1, kA, vA, tid);
      __syncthreads();
    };
    for (int ci = 0; ci < nct; ci += 2) { step2(ci, kr, vr, kr2, vr2); if (ci + 1 < nct) step2(ci + 1, kr2, vr2, kr, vr); }
#pragma unroll
    for (int dt = 0; dt < 2; ++dt)
#pragma unroll
      for (int r = 0; r < 16; ++r) tot[dt][r] = gate[0] * oc[dt][r];
  }
  {
    const int tk = 8 * w + (lane >> 3), seg = lane & 7;
    unsigned m0 = 0, m1 = 0, m2 = 0, m3 = 0;
    auto setbit = [&](int j) { const unsigned bit = 1u << (j & 31); const int wd = j >> 5; m0 |= wd == 0 ? bit : 0u; m1 |= wd == 1 ? bit : 0u; m2 |= wd == 2 ? bit : 0u; m3 |= wd == 3 ? bit : 0u; };
    if (cur <= 15) { m0 = (2u << cur) - 1u; }
    else {
      const LAS float* IMP = (const LAS float*)(L + NS_IMP) + tk * IMP_P + 16 * seg;
      int top[16];
#pragma unroll
      for (int i = 0; i < 16; ++i) { const int j = 16 * seg + i; const int key = (int)((__float_as_uint(IMP[i]) & ~127u) | (unsigned)(127 - j)); top[i] = (j >= 1 && j <= cur - 2) ? key : -1; }
      sort16_desc(top);
#pragma unroll
      for (int o = 1; o < 8; o <<= 1) { int oth[16];
#pragma unroll
        for (int i = 0; i < 16; ++i) oth[i] = __shfl_xor(top[i], o);
        merge16_top(top, oth); }
      setbit(0); setbit(cur); setbit(cur - 1);
#pragma unroll
      for (int i = 0; i < 13; ++i) setbit(127 - (top[i] & 127));
    }
    if (seg == 0) *(LAS u32x4*)(L + NS_MASK + tk * 16) = (u32x4){m0, m1, m2, m3};
  }
  __syncthreads();
  const u32x4 mk = *(const LAS u32x4*)(L + NS_MASK + (8 * w + tokl) * 16);

  {
    TileSrc ss; ss.k = Z + (size_t)b * T * ZP + C_KS + g * 64; ss.v = Z + (size_t)b * T * ZP + C_VS + g * 64; ss.pitch = ZP;
    float m_s = -1e30f, l_s = 0.f; f32x16 os[2] = {};
    const int npair = (cur >> 1) + 1;
    auto selbit = [&](int j) -> bool { const unsigned wsel = (j >> 5) == 0 ? mk.x : ((j >> 5) == 1 ? mk.y : ((j >> 5) == 2 ? mk.z : mk.w)); return ((wsel >> (j & 31)) & 1u) != 0u; };
    auto bias_mask = [&](f32x16& p0, f32x16& p1, const int j, const bool sel, float& cb) -> float {
      float mt = -1e30f; cb = 0.f;
      const int dmin = t0 + 8 * w - (64 * j + 63), dmax = t0 + 8 * w + 7 - 64 * j;
      if (dmin >= 246) {
        const int blo = *(const LAS unsigned char*)(L + NS_BUCK + dmin), bhi = *(const LAS unsigned char*)(L + NS_BUCK + dmax);
        float b_lo = ((const LAS float*)(L + NS_BIAS))[blo * 4 + hd], b_hi = ((const LAS float*)(L + NS_BIAS))[bhi * 4 + hd];
        b_lo = sel ? b_lo : -INFINITY; b_hi = sel ? b_hi : -INFINITY;
        if (blo == bhi) {
          float ma = -1e30f, mb = -1e30f;
#pragma unroll
          for (int r = 0; r < 16; r += 2) { ma = fmaxf(fmaxf(ma, p0[r]), p1[r]); mb = fmaxf(fmaxf(mb, p0[r + 1]), p1[r + 1]); }
          cb = b_lo; mt = fmaxf(ma, mb) + b_lo;
        } else {
          const int thr = ((const LAS int*)(L + NS_THR))[bhi]; const int db = t - 64 * j - 4 * hi;
#pragma unroll
          for (int r = 0; r < 16; ++r) { const int d0 = db - ((r & 3) + 8 * (r >> 2));
            p0[r] += (d0 >= thr) ? b_hi : b_lo; p1[r] += (d0 - 32 >= thr) ? b_hi : b_lo; mt = fmaxf(mt, fmaxf(p0[r], p1[r])); }
        }
      } else {
#pragma unroll
        for (int hf = 0; hf < 2; ++hf)
#pragma unroll
          for (int r = 0; r < 16; ++r) { const int dist = t - (64 * j + 32 * hf + crow(r, hi));
            float sv = (hf ? p1[r] : p0[r]) + ns_bias(L, hd, dist); sv = (sel && dist >= 0) ? sv : -INFINITY; if (hf) p1[r] = sv; else p0[r] = sv; mt = fmaxf(mt, sv); }
      }
      return mt;
    };
    auto new_max = [&](float mt) {
      mt = fmaxf(mt, __shfl_xor(mt, 32));
      if (__any(mt > m_s)) {
        const float mn = fmaxf(m_s, mt), al = ex2(m_s - mn); l_s *= al; m_s = mn;
#pragma unroll
        for (int dt = 0; dt < 2; ++dt)
#pragma unroll
          for (int r = 0; r < 16; ++r) os[dt][r] *= al;
      }
    };
    auto expsum = [&](f32x16& p0, f32x16& p1, const float cb) { float sum = 0.f; const float kc = cb - m_s;
#pragma unroll
      for (int r = 0; r < 16; ++r) { p0[r] = ex2(p0[r] + kc); p1[r] = ex2(p1[r] + kc); sum += p0[r] + p1[r]; }
      l_s += sum; };
    auto kslot = [&](int pp, int idx) -> int { const int q = pp % 3; return (q == 2 ? NS_X3 : NS_K + q * 16384) + idx * 8192; };
    auto vslot = [&](int pp, int idx) -> int { const int q = pp % 3; return (q == 2 ? NS_X3 + 16384 : NS_V + q * 16384) + idx * 8192; };
    auto issue = [&](int pp) { const int ja = 2 * pp <= cur ? 2 * pp : cur, jb = 2 * pp + 1 <= cur ? 2 * pp + 1 : cur;
      ns_dma(L, kslot(pp, 0), vslot(pp, 0), ss, 64 * ja, lane, w); ns_dma(L, kslot(pp, 1), vslot(pp, 1), ss, 64 * jb, lane, w); };
    issue(0); issue(1);
    for (int pp = 0; pp < npair; ++pp) {
      const int ja = 2 * pp, jb = ja + 1;
      asm volatile("s_waitcnt vmcnt(4) ; NSA_SLC_WAIT" ::: "memory");
      __builtin_amdgcn_s_barrier();
      asm volatile("" ::: "memory");
      issue(pp + 2);
      const int ka = kslot(pp, 0), kb = kslot(pp, 1), va = vslot(pp, 0), vb = vslot(pp, 1);
      const bool sela = selbit(ja), selb = (jb <= cur) && selbit(jb);
      const bool needa = __any(sela), needb = __any(selb);
      if (needa && needb) {
        f32x16 pa0, pa1, pb0, pb1;
        ns_qk(pa0, pa1, L + ka, qf, r32, hi); ns_qk(pb0, pb1, L + kb, qf, r32, hi);
        float cba, cbb;
        const float mta = bias_mask(pa0, pa1, ja, sela, cba), mtb = bias_mask(pb0, pb1, jb, selb, cbb);
        new_max(fmaxf(mta, mtb));
        expsum(pa0, pa1, cba); ns_pv(os, L + va, pa0, pa1, lane);
        expsum(pb0, pb1, cbb); ns_pv(os, L + vb, pb0, pb1, lane);
      } else if (needa || needb) {
        const int j1 = needa ? ja : jb, k1 = needa ? ka : kb, v1 = needa ? va : vb; const bool sel1 = needa ? sela : selb;
        f32x16 p0, p1; ns_qk(p0, p1, L + k1, qf, r32, hi);
        float cb1;
        new_max(bias_mask(p0, p1, j1, sel1, cb1));
        expsum(p0, p1, cb1); ns_pv(os, L + v1, p0, p1, lane);
      }
      asm volatile("s_waitcnt lgkmcnt(0)" ::: "memory");
    }
    asm volatile("s_waitcnt vmcnt(0)" ::: "memory");
    __syncthreads();
    l_s += __shfl_xor(l_s, 32);
    const float sc_ = gate[1] / l_s;
#pragma unroll
    for (int dt = 0; dt < 2; ++dt)
#pragma unroll
      for (int r = 0; r < 16; ++r) tot[dt][r] += EN_SLC * sc_ * os[dt][r];
  }
  {
    TileSrc sw; sw.k = Z + (size_t)b * T * ZP + C_KW + g * 64; sw.v = Z + (size_t)b * T * ZP + C_VW + g * 64; sw.pitch = ZP;
    const int j0 = cur >= 8 ? cur - 8 : 0;
    float m_w = -1e30f, l_w = 0.f; f32x16 ow[2] = {};
    ns_load(kr, vr, sw, 64 * j0, tid); ns_store(L, 0, kr, vr, tid); ns_load(kr, vr, sw, 64 * (j0 < cur ? j0 + 1 : j0), tid); __syncthreads();
    auto step = [&](const int j, u32x4& kA, u32x4& vA, u32x4& kB, u32x4& vB) {
      const int bi = (j - j0) & 1;
      ns_load(kB, vB, sw, 64 * (j + 2 <= cur ? j + 2 : cur), tid);
      f32x16 p0, p1; ns_qk(p0, p1, L + NS_K + bi * 8192, qf, r32, hi);
      float mt = -1e30f;
      { const LAS float* WB = (const LAS float*)(L + NS_WB) + hd * 577; const int db = t - 64 * j - 4 * hi;
#pragma unroll
        for (int r = 0; r < 16; ++r) { const unsigned d0 = (unsigned)(db - ((r & 3) + 8 * (r >> 2))), d1 = d0 - 32u;
          const float s0 = p0[r] + WB[d0 < 575u ? d0 : 575u], s1 = p1[r] + WB[d1 < 575u ? d1 : 575u];
          p0[r] = d0 < 512u ? s0 : -INFINITY; p1[r] = d1 < 512u ? s1 : -INFINITY; mt = fmaxf(mt, fmaxf(p0[r], p1[r])); } }
      mt = fmaxf(mt, __shfl_xor(mt, 32));
      if (__any(mt > m_w)) {
        const float mn = fmaxf(m_w, mt), al = ex2(m_w - mn); l_w *= al; m_w = mn;
#pragma unroll
        for (int dt = 0; dt < 2; ++dt)
#pragma unroll
          for (int r = 0; r < 16; ++r) ow[dt][r] *= al;
      }
      { float sum = 0.f;
#pragma unroll
        for (int r = 0; r < 16; ++r) { p0[r] = ex2(p0[r] - m_w); p1[r] = ex2(p1[r] - m_w); sum += p0[r] + p1[r]; }
        l_w += sum; }
      ns_pv(ow, L + NS_V + bi * 8192, p0, p1, lane);
      ns_store(L, bi ^ 1, kA, vA, tid);
      __syncthreads();
    };
    for (int j = j0; j <= cur; j += 2) { step(j, kr, vr, kr2, vr2); if (j + 1 <= cur) step(j + 1, kr2, vr2, kr, vr); }
    l_w += __shfl_xor(l_w, 32);
    const float sc_ = gate[2] / l_w;
#pragma unroll
    for (int dt = 0; dt < 2; ++dt)
#pragma unroll
      for (int r = 0; r < 16; ++r) tot[dt][r] += EN_WIN * sc_ * ow[dt][r];
  }
  bf16_t* dst = (bf16_t*)(F.ws + WS_OCAT) + mrow * DM + 512 + head * 64;
#pragma unroll
  for (int dt = 0; dt < 2; ++dt)
#pragma unroll
    for (int rr = 0; rr < 4; ++rr) { u32x2 wv; wv.x = cvtpk(tot[dt][4 * rr], tot[dt][4 * rr + 1]); wv.y = cvtpk(tot[dt][4 * rr + 2], tot[dt][4 * rr + 3]); *(u32x2*)(dst + 32 * dt + 8 * rr + 4 * hi) = wv; }
}

DI int ordkey(float f) { const int s = __builtin_bit_cast(int, f); return s ^ ((s >> 31) & 0x7fffffff); }
DI float unordkey(int k) { const int s = k ^ ((k >> 31) & 0x7fffffff); return __builtin_bit_cast(float, s); }
DI void ins16(int (&top)[16], int v) {
#pragma unroll
  for (int i = 0; i < 16; ++i) { const int h = max(top[i], v); v = min(top[i], v); top[i] = h; }
}
DI void merge_pair(int (&a)[16]) {
  int c[16];
#pragma unroll
  for (int i = 0; i < 16; ++i) c[i] = max(a[i], __shfl_xor(a[15 - i], 32));
#pragma unroll
  for (int st = 8; st >= 1; st >>= 1)
#pragma unroll
    for (int i = 0; i < 16; ++i) if ((i & st) == 0) { const int x = c[i], y = c[i + st]; c[i] = max(x, y); c[i + st] = min(x, y); }
#pragma unroll
  for (int i = 0; i < 16; ++i) a[i] = c[i];
}
DI void peer_key_tile(int (&g)[16], const bf16_t* SKhp, const bf16x8 (&qf)[4], int kt, int r32, int hi) {
  f32x16 acc = {};
#pragma unroll
  for (int ks = 0; ks < 4; ++ks) { const bf16x8 a = *(const bf16x8*)(SKhp + (size_t)(32 * kt + r32) * 64 + 16 * ks + 8 * hi); acc = MFMA32(a, qf[ks], acc); }
#pragma unroll
  for (int r = 0; r < 16; ++r) { const int kidx = 32 * kt + crow(r, hi); g[r] = (ordkey(acc[r]) & ~127) | (127 - kidx); }
  sort16_desc(g);
}
DI void peer_half_topk(int (&lst)[16], const bf16_t* SKhp, const bf16_t* qrow, int r32, int hi) {
  bf16x8 qf[4];
#pragma unroll
  for (int ks = 0; ks < 4; ++ks) qf[ks] = *(const bf16x8*)(qrow + 16 * ks + 8 * hi);
  int g1[16];
  peer_key_tile(lst, SKhp, qf, 0, r32, hi); peer_key_tile(g1, SKhp, qf, 1, r32, hi); merge16_top(lst, g1);
  { int g2[16]; peer_key_tile(g1, SKhp, qf, 2, r32, hi); peer_key_tile(g2, SKhp, qf, 3, r32, hi); merge16_top(g1, g2); }
  merge16_top(lst, g1);
  merge_pair(lst);
}
constexpr int PS_IDX = 0;
DI void peer_select_unit(const Ctx& F0, const int u) {
  const Ctx F = fresh(F0);
  const int lane = F.lane, w = F.wave, r32 = lane & 31, hi = lane >> 5;
  const int tok = (u >> 1) * 256 + 32 * w + r32, hg = u & 1;
  const bf16_t* QP = (const bf16_t*)(F.ws + WS_QP) + (size_t)tok * DM;
  const bf16_t* SK = (const bf16_t*)(F.ws + WS_SK);
  LAS unsigned char* IDX = F.lds + PS_IDX + F.tid * 32;
  unsigned short* EI = (unsigned short*)(F.ws + WS_EIDX) + (size_t)tok * 128; float* GT = (float*)(F.ws + WS_GATE) + (size_t)tok * 128;
  __syncthreads();
  for (int pair = 0; pair < 2; ++pair) {
    const int hA = 4 * hg + 2 * pair;
    int l00[16], l01[16], l10[16], l11[16];
    peer_half_topk(l00, SK + (size_t)((hA * 2 + 0) * 128) * 64, QP + hA * 128, r32, hi);
    peer_half_topk(l01, SK + (size_t)((hA * 2 + 1) * 128) * 64, QP + hA * 128 + 64, r32, hi);
    peer_half_topk(l10, SK + (size_t)(((hA + 1) * 2 + 0) * 128) * 64, QP + (hA + 1) * 128, r32, hi);
    peer_half_topk(l11, SK + (size_t)(((hA + 1) * 2 + 1) * 128) * 64, QP + (hA + 1) * 128 + 64, r32, hi);
    const int hsel = hA + hi;
    float fa[16], fb[16];
#pragma unroll
    for (int i = 0; i < 16; ++i) { const int ka = hi ? l10[i] : l00[i], kb = hi ? l11[i] : l01[i];
      fa[i] = unordkey(ka & ~127); fb[i] = unordkey(kb & ~127); IDX[i] = (unsigned char)(127 - (ka & 127)); IDX[16 + i] = (unsigned char)(127 - (kb & 127)); }
    auto cand = [&](int i, int j) -> int { return (ordkey(fa[i] + fb[j]) & ~255) | (255 - (i * 16 + j)); };
    const int NEG = (int)0x80000000;
    int top[16], c1[16];
#pragma unroll
    for (int j = 0; j < 16; ++j) top[j] = cand(0, j);
    { int k = 0;
#pragma unroll
      for (int j = 0; j < 8; ++j) c1[k++] = cand(1, j);
#pragma unroll
      for (int j = 0; j < 5; ++j) c1[k++] = cand(2, j);
      c1[13] = NEG; c1[14] = NEG; c1[15] = NEG; }
    sort16_desc(c1); merge16_top(top, c1);
    c1[0] = cand(3, 0); c1[1] = cand(3, 1); c1[2] = cand(3, 2); c1[3] = cand(3, 3); c1[4] = cand(4, 0); c1[5] = cand(4, 1); c1[6] = cand(4, 2);
    c1[7] = cand(5, 0); c1[8] = cand(5, 1); c1[9] = cand(6, 0); c1[10] = cand(6, 1); c1[11] = cand(7, 0); c1[12] = cand(7, 1); c1[13] = NEG; c1[14] = NEG; c1[15] = NEG;
    sort16_desc(c1); merge16_top(top, c1);
#pragma unroll
    for (int i = 0; i < 8; ++i) { c1[i] = cand(8 + i, 0); c1[8 + i] = NEG; }
    merge16_top(top, c1);
    float sc[16]; float mx = -INFINITY;
#pragma unroll
    for (int k = 0; k < 16; ++k) { sc[k] = unordkey(top[k] & ~255); mx = fmaxf(mx, sc[k]); }
    float sum = 0.f;
#pragma unroll
    for (int k = 0; k < 16; ++k) { sc[k] = __expf(sc[k] - mx); sum += sc[k]; }
    const float inv = 1.f / sum;
    asm volatile("s_waitcnt lgkmcnt(0)" ::: "memory");
#pragma unroll
    for (int k = 0; k < 16; ++k) { const int cid = 255 - (top[k] & 255); const int e = (int)IDX[cid >> 4] * 128 + (int)IDX[16 + (cid & 15)];
      EI[hsel * 16 + k] = (unsigned short)e; GT[hsel * 16 + k] = sc[k] * inv; }
  }
}

DI void fp8x16_to_f32(const u32x4& w, float (&f)[16]) {
#pragma unroll
  for (int q = 0; q < 4; ++q) { const f32x2 lo = __builtin_amdgcn_cvt_pk_f32_fp8((int)w[q], false), hi = __builtin_amdgcn_cvt_pk_f32_fp8((int)w[q], true); f[4 * q] = lo.x; f[4 * q + 1] = lo.y; f[4 * q + 2] = hi.x; f[4 * q + 3] = hi.y; }
}
DI void treduce16(const float (&v)[16], int sel, int s, float (&w2)[2]) {
  float w8[8], w4[4];
  { const bool up = (sel & 4) != 0;
#pragma unroll
    for (int i = 0; i < 8; ++i) { const float keep = up ? v[i + 8] : v[i], send = up ? v[i] : v[i + 8]; w8[i] = keep + __shfl_xor(send, 4 * s); } }
  { const bool up = (sel & 2) != 0;
#pragma unroll
    for (int i = 0; i < 4; ++i) { const float keep = up ? w8[i + 4] : w8[i], send = up ? w8[i] : w8[i + 4]; w4[i] = keep + __shfl_xor(send, 2 * s); } }
  { const bool up = (sel & 1) != 0;
#pragma unroll
    for (int i = 0; i < 2; ++i) { const float keep = up ? w4[i + 2] : w4[i], send = up ? w4[i] : w4[i + 2]; w2[i] = keep + __shfl_xor(send, s); } }
}
struct PeerIds { unsigned ep[8]; };
struct PeerRows { u32x4 d[16]; unsigned ap[8]; u32x4 xa, xb; unsigned h; };
DI void peer_load_ids(const Ctx& F, int tok, int g, PeerIds& I) {
  const unsigned short* EI = (const unsigned short*)(F.ws + WS_EIDX) + (size_t)tok * 128 + 16 * g;
  const u32x4 a = *(const u32x4*)EI, b = *(const u32x4*)(EI + 8); I.ep[0] = a.x; I.ep[1] = a.y; I.ep[2] = a.z; I.ep[3] = a.w; I.ep[4] = b.x; I.ep[5] = b.y; I.ep[6] = b.z; I.ep[7] = b.w;
}
DI unsigned peer_eid(const PeerIds& I, int i) { return (i & 1) ? (I.ep[i >> 1] >> 16) : (I.ep[i >> 1] & 0xffffu); }
DI float peer_act(const PeerRows& R, int i) { return (i & 1) ? bfhi(R.ap[i >> 1]) : bflo(R.ap[i >> 1]); }
template <int PASS> DI void peer_load_rows(const Ctx& F, const unsigned char* TB, unsigned lo, int slice, int tok, int g, int c, const PeerIds& I, PeerRows& R) {
#pragma unroll
  for (int i = 0; i < 16; ++i) R.d[i] = *(const u32x4*)(TB + ((peer_eid(I, i) << 7) | lo));
  if (PASS == 0) { const bf16_t* xn = (const bf16_t*)(F.ws + WS_HN) + (size_t)tok * DM + 128 * slice + 16 * c; R.xa = *(const u32x4*)xn; R.xb = *(const u32x4*)(xn + 8); }
  else { const bf16_t* AC = (const bf16_t*)(F.ws + WS_ACTH) + (size_t)tok * 128 + 16 * g;
    const u32x4 a = *(const u32x4*)AC, b = *(const u32x4*)(AC + 8); R.ap[0] = a.x; R.ap[1] = a.y; R.ap[2] = a.z; R.ap[3] = a.w; R.ap[4] = b.x; R.ap[5] = b.y; R.ap[6] = b.z; R.ap[7] = b.w;
    R.h = *(const unsigned*)((const bf16_t*)(F.ws + WS_HN) + (size_t)tok * DM + 128 * slice + 16 * c + 2 * g); }
}
template <int PASS> DI void peer_compute(const Ctx& F, int slice, int tok, int g, int c, const PeerRows& R) {
  float acc[16]; float w2[2];
  if (PASS == 0) {
    float x[16];
    { const unsigned xw[8] = {R.xa.x, R.xa.y, R.xa.z, R.xa.w, R.xb.x, R.xb.y, R.xb.z, R.xb.w};
#pragma unroll
      for (int q = 0; q < 8; ++q) { x[2 * q] = bflo(xw[q]); x[2 * q + 1] = bfhi(xw[q]); } }
    float dep = 0.f;
#pragma unroll
    for (int i = 0; i < 16; ++i) { u32x4 w = R.d[i]; asm volatile("" : "+v"(w.x), "+v"(w.y), "+v"(w.z), "+v"(w.w) : "v"(dep));
      float f[16]; fp8x16_to_f32(w, f); float a = 0.f, b = 0.f;
#pragma unroll
      for (int j = 0; j < 8; ++j) { a += f[2 * j] * x[2 * j]; b += f[2 * j + 1] * x[2 * j + 1]; }
      acc[i] = a + b; dep = acc[i]; }
    treduce16(acc, c, 1, w2);
    *(f32x2*)((float*)(F.ws + WS_PART) + ((size_t)slice * NTOK + tok) * 128 + 16 * g + 2 * c) = (f32x2){w2[0], w2[1]};
  } else {
#pragma unroll
    for (int j = 0; j < 16; ++j) acc[j] = 0.f;
#pragma unroll
    for (int i = 0; i < 16; ++i) { u32x4 w = R.d[i]; asm volatile("" : "+v"(w.x), "+v"(w.y), "+v"(w.z), "+v"(w.w) : "v"(acc[15]));
      float f[16]; fp8x16_to_f32(w, f);
      const float ai = peer_act(R, i);
#pragma unroll
      for (int j = 0; j < 16; ++j) acc[j] += ai * f[j]; }
    treduce16(acc, g, 8, w2);
    *(unsigned*)((bf16_t*)(F.ws + WS_HN) + (size_t)tok * DM + 128 * slice + 16 * c + 2 * g) = cvtpk(bflo(R.h) + w2[0], bfhi(R.h) + w2[1]);
  }
}
constexpr int PEER_NBIG = (NTOK * 3 / 4) / 32, PEER_NSMALL = (NTOK / 4) / 8;
template <int PASS>
DI void peer_sliced_pass(const Ctx& F0, unsigned* cnt) {
  const Ctx F = fresh(F0);
  const int lane = F.lane, g = lane >> 3, c = lane & 7;
  const unsigned xcc = (unsigned)__builtin_amdgcn_s_getreg((3 << 11) | 20) & 7u;
  for (int s = 0; s < 8; ++s) {
    const int slice = (int)((xcc + (unsigned)s) & 7u);
    const unsigned char* TB = F.ws + (PASS == 0 ? WS_PDOWN8 : WS_PUP8) + (size_t)slice * 16384 * 128; const unsigned lo = (unsigned)(16 * c);
    for (;;) {
      unsigned ch = 0;
      if (lane == 0) ch = atomicAdd(cnt + 64 * slice, 1u);
      const int chunk = __builtin_amdgcn_readfirstlane((int)ch);
      if (chunk >= PEER_NBIG + PEER_NSMALL) break;
      const int tok0 = chunk < PEER_NBIG ? chunk * 32 : PEER_NBIG * 32 + (chunk - PEER_NBIG) * 8;
      const int nch = chunk < PEER_NBIG ? 32 : 8;
      PeerIds E0, E1; PeerRows RA, RB;
      peer_load_ids(F, tok0, g, E0);
      peer_load_ids(F, tok0 + 1, g, E1);
      peer_load_rows<PASS>(F, TB, lo, slice, tok0, g, c, E0, RA);
#pragma unroll 1
      for (int i = 0; i < nch; i += 2) {
        const int t0 = tok0 + i, t1 = t0 + 1, t2 = (i + 2 < nch) ? t0 + 2 : t0, t3 = (i + 3 < nch) ? t0 + 3 : t1;
        peer_load_rows<PASS>(F, TB, lo, slice, t1, g, c, E1, RB);
        peer_load_ids(F, t2, g, E0);
        peer_compute<PASS>(F, slice, t0, g, c, RA);
        peer_load_rows<PASS>(F, TB, lo, slice, t2, g, c, E0, RA);
        peer_load_ids(F, t3, g, E1);
        peer_compute<PASS>(F, slice, t1, g, c, RB);
      }
    }
  }
}
DI void peer_computeA_lds(LAS float* part_row, int g, int c, const PeerRows& R) {
  float acc[16]; float w2[2]; float x[16];
  { const unsigned xw[8] = {R.xa.x, R.xa.y, R.xa.z, R.xa.w, R.xb.x, R.xb.y, R.xb.z, R.xb.w};
#pragma unroll
    for (int q = 0; q < 8; ++q) { x[2 * q] = bflo(xw[q]); x[2 * q + 1] = bfhi(xw[q]); } }
  float dep = 0.f;
#pragma unroll
  for (int i = 0; i < 16; ++i) { u32x4 w = R.d[i]; asm volatile("" : "+v"(w.x), "+v"(w.y), "+v"(w.z), "+v"(w.w) : "v"(dep));
    float f[16]; fp8x16_to_f32(w, f); float a = 0.f, b = 0.f;
#pragma unroll
    for (int j = 0; j < 8; ++j) { a += f[2 * j] * x[2 * j]; b += f[2 * j + 1] * x[2 * j + 1]; }
    acc[i] = a + b; dep = acc[i]; }
  treduce16(acc, c, 1, w2);
  LAS f32x2* pp = (LAS f32x2*)(part_row + 16 * g + 2 * c);
  const f32x2 o = *pp; *pp = (f32x2){o.x + w2[0], o.y + w2[1]};
}
DI void peer_load_rowsC_lds(const Ctx& F, const unsigned char* TB, unsigned lo, int slice, int tok, const LAS unsigned* act_row, int g, int c, const PeerIds& I, PeerRows& R) {
#pragma unroll
  for (int i = 0; i < 16; ++i) R.d[i] = *(const u32x4*)(TB + ((peer_eid(I, i) << 7) | lo));
#pragma unroll
  for (int k = 0; k < 8; ++k) R.ap[k] = act_row[8 * g + k];
  R.h = *(const unsigned*)((const bf16_t*)(F.ws + WS_HN) + (size_t)tok * DM + 128 * slice + 16 * c + 2 * g);
}
DI void final_norm_token(const Ctx& F, const int tok);
DI void peer_fused_phase(const Ctx& F0) {
  const Ctx F = fresh(F0);
  const int lane = F.lane, g = lane >> 3, c = lane & 7, w = F.wave;
  const unsigned xcc = (unsigned)__builtin_amdgcn_s_getreg((3 << 11) | 20) & 7u;
  LAS float* PARTS = (LAS float*)(F.lds + w * 8192);
  LAS unsigned* ACTS = (LAS unsigned*)(F.lds + 65536 + w * 4096);
  const unsigned lo = (unsigned)(16 * c);
  __syncthreads();
#pragma unroll 1
  for (int grp = F.gw; grp < NTOK / 16; grp += F.NGW) {
    const int tok0 = grp * 16;
#pragma unroll
    for (int i = 0; i < 32; ++i) PARTS[i * 64 + lane] = 0.f;
    {
      auto tbl = [&](int q) -> const unsigned char* { return F.ws + WS_PDOWN8 + (size_t)((xcc + (unsigned)(q >> 4)) & 7u) * 16384 * 128; };
      auto slc = [&](int q) -> int { return (int)((xcc + (unsigned)(q >> 4)) & 7u); };
      PeerIds E0, E1; PeerRows RA, RB;
      peer_load_ids(F, tok0, g, E0); peer_load_ids(F, tok0 + 1, g, E1);
      peer_load_rows<0>(F, tbl(0), lo, slc(0), tok0, g, c, E0, RA);
#pragma unroll 1
      for (int q = 0; q < 128; q += 2) {
        const int q2 = q + 2 < 128 ? q + 2 : q, q3 = q + 3 < 128 ? q + 3 : q + 1;
        peer_load_rows<0>(F, tbl(q + 1), lo, slc(q + 1), tok0 + ((q + 1) & 15), g, c, E1, RB);
        peer_load_ids(F, tok0 + (q2 & 15), g, E0);
        peer_computeA_lds(PARTS + (q & 15) * 128, g, c, RA);
        peer_load_rows<0>(F, tbl(q2), lo, slc(q2), tok0 + (q2 & 15), g, c, E0, RA);
        peer_load_ids(F, tok0 + (q3 & 15), g, E1);
        peer_computeA_lds(PARTS + ((q + 1) & 15) * 128, g, c, RB);
      }
    }
    {
      const float* DSC = (const float*)(F.ws + WS_DSC); const float* USC = (const float*)(F.ws + WS_USC);
#pragma unroll 1
      for (int ti = 0; ti < 16; ++ti) { const int tok = tok0 + ti; const int p0 = 16 * g + 2 * c;
        const unsigned ee = *(const unsigned*)((const unsigned short*)(F.ws + WS_EIDX) + (size_t)tok * 128 + p0); const unsigned e0 = ee & 0xffffu, e1 = ee >> 16;
        const f32x2 gt = *(const f32x2*)((const float*)(F.ws + WS_GATE) + (size_t)tok * 128 + p0);
        const f32x2 sd = *(const LAS f32x2*)(PARTS + ti * 128 + p0);
        const float rs = pg8::row_rstd((const float*)(F.ws + WS_SSP), tok);
        ACTS[ti * 64 + 8 * g + c] = cvtpk(gelu_tanh(sd.x * rs * DSC[e0]) * gt.x * USC[e0], gelu_tanh(sd.y * rs * DSC[e1]) * gt.y * USC[e1]); }
    }
    {
      auto tbl = [&](int q) -> const unsigned char* { return F.ws + WS_PUP8 + (size_t)((xcc + (unsigned)(q >> 4)) & 7u) * 16384 * 128; };
      auto slc = [&](int q) -> int { return (int)((xcc + (unsigned)(q >> 4)) & 7u); };
      PeerIds E0, E1; PeerRows RA, RB;
      peer_load_ids(F, tok0, g, E0); peer_load_ids(F, tok0 + 1, g, E1);
      peer_load_rowsC_lds(F, tbl(0), lo, slc(0), tok0, ACTS, g, c, E0, RA);
#pragma unroll 1
      for (int q = 0; q < 128; q += 2) {
        const int q2 = q + 2 < 128 ? q + 2 : q, q3 = q + 3 < 128 ? q + 3 : q + 1;
        peer_load_rowsC_lds(F, tbl(q + 1), lo, slc(q + 1), tok0 + ((q + 1) & 15), ACTS + ((q + 1) & 15) * 64, g, c, E1, RB);
        peer_load_ids(F, tok0 + (q2 & 15), g, E0);
        peer_compute<1>(F, slc(q), tok0 + (q & 15), g, c, RA);
        peer_load_rowsC_lds(F, tbl(q2), lo, slc(q2), tok0 + (q2 & 15), ACTS + (q2 & 15) * 64, g, c, E0, RA);
        peer_load_ids(F, tok0 + (q3 & 15), g, E1);
        peer_compute<1>(F, slc(q + 1), tok0 + ((q + 1) & 15), g, c, RB);
      }
    }
    asm volatile("s_waitcnt vmcnt(0)" ::: "memory");
    __builtin_amdgcn_fence(__ATOMIC_ACQUIRE, "agent");
#pragma unroll 1
    for (int ti = 0; ti < 16; ++ti) final_norm_token(F, tok0 + ti);
  }
}
DI void peer_act_pass(const Ctx& F0) {
  const Ctx F = fresh(F0);
  const float* PT = (const float*)(F.ws + WS_PART); const u32x2* EI = (const u32x2*)(F.ws + WS_EIDX); const f32x4* GT = (const f32x4*)(F.ws + WS_GATE);
  const float* DSC = (const float*)(F.ws + WS_DSC); const float* USC = (const float*)(F.ws + WS_USC); u32x2* AH = (u32x2*)(F.ws + WS_ACTH);
  for (size_t i = (size_t)blockIdx.x * NTHREADS + F.tid; i < (size_t)NTOK * 32; i += (size_t)F.G * NTHREADS) {
    f32x4 s = {0.f, 0.f, 0.f, 0.f};
#pragma unroll
    for (int x = 0; x < 8; ++x) s += *(const f32x4*)(PT + (size_t)x * NTOK * 128 + 4 * i);
    const u32x2 ee = EI[i]; const unsigned e0 = ee.x & 0xffffu, e1 = ee.x >> 16, e2 = ee.y & 0xffffu, e3 = ee.y >> 16; const f32x4 gt = GT[i];
    const float rs = pg8::row_rstd((const float*)(F.ws + WS_SSP), (int)(i >> 5));
    u32x2 o; o.x = cvtpk(gelu_tanh(s.x * rs * DSC[e0]) * gt.x * USC[e0], gelu_tanh(s.y * rs * DSC[e1]) * gt.y * USC[e1]);
    o.y = cvtpk(gelu_tanh(s.z * rs * DSC[e2]) * gt.z * USC[e2], gelu_tanh(s.w * rs * DSC[e3]) * gt.w * USC[e3]);
    AH[i] = o;
  }
}
DI void renorm_pass(const Ctx& F0, const float* g) {
  const Ctx F = fresh(F0);
#pragma unroll 1
  for (int m = F.gw; m < NTOK; m += F.NGW) rms_row_bf16(F.H + (size_t)m * DM, g, (bf16_t*)(F.ws + WS_HN) + (size_t)m * DM, F.lane);
}
DI void final_norm_token(const Ctx& F, const int tok) {
  const int lane = F.lane; const bf16_t* hrow = (const bf16_t*)(F.ws + WS_HN) + (size_t)tok * DM; float* orow = F.H + (size_t)tok * DM; const float* gf = F.in[I_NFIN];
  f32x4 v[4]; float ss = 0.f;
#pragma unroll
  for (int j = 0; j < 4; ++j) { const u32x2 hb = ((const u32x2*)hrow)[lane + 64 * j]; v[j] = (f32x4){bflo(hb.x), bfhi(hb.x), bflo(hb.y), bfhi(hb.y)}; ss += v[j].x * v[j].x + v[j].y * v[j].y + v[j].z * v[j].z + v[j].w * v[j].w; }
  const float r = rsqrtf(wave_sum(ss) * (1.f / DM) + EPS);
#pragma unroll
  for (int j = 0; j < 4; ++j) ((f32x4*)orow)[lane + 64 * j] = v[j] * r * ((const f32x4*)gf)[lane + 64 * j];
}

#define XB_TMO      128
#define XB_XCNT(j)  (256  + 64 * (j))
#define XB_XSUB(j)  (1280 + 64 * (j))
#define XB_XGEN(j)  (2304 + 64 * (j))
#define XB_TOP      3328
#define XB_TOPGEN   3392
#define XCD_BAR_WORDS 3456
#define XB_SPIN_CAP (1u << 22)
DI unsigned xb_ld(unsigned* p)              { return __hip_atomic_load(p, __ATOMIC_RELAXED, __HIP_MEMORY_SCOPE_AGENT); }
DI unsigned xb_add(unsigned* p, unsigned v) { return __hip_atomic_fetch_add(p, v, __ATOMIC_RELAXED, __HIP_MEMORY_SCOPE_AGENT); }
DI unsigned xb_xcc_id() { return (unsigned)__builtin_amdgcn_s_getreg((3 << 11) | 20) & 0xFu; }
#define XB_SPIN(cond, bar) do { unsigned _sp = 0; while (cond) { __builtin_amdgcn_s_sleep(1); \
    if ((++_sp & 255u) == 0u) { if (xb_ld(&(bar)[XB_TMO])) break; if (_sp > XB_SPIN_CAP) { atomicAdd(&(bar)[XB_TMO], 1u); break; } } } } while (0)
struct XcdBarrier { unsigned* bar; unsigned x; volatile LAS unsigned* st; };
DI XcdBarrier xcd_barrier_post(unsigned* bar, volatile LAS unsigned* st) {
  XcdBarrier b; b.bar = bar; b.x = xb_xcc_id(); b.st = st;
  if (threadIdx.x == 0) (void)xb_add(&bar[XB_XCNT(b.x)], 1u);
  return b;
}
DI void xcd_barrier_complete(unsigned* bar, unsigned x, unsigned& nloc, unsigned& nx) {
  const unsigned G = gridDim.x * gridDim.y * gridDim.z;
  unsigned sum, cnt, mine, sp = 0u;
  for (;;) {
    sum = 0u; cnt = 0u; mine = 0u;
#pragma unroll
    for (unsigned j = 0; j < 16; ++j) { const unsigned c = xb_ld(&bar[XB_XCNT(j)]); sum += c; cnt += (c > 0u) ? 1u : 0u; mine = (j == x) ? c : mine; }
    if (sum == G) break;
    __builtin_amdgcn_s_sleep(1);
    if ((++sp & 255u) == 0u) { if (xb_ld(&bar[XB_TMO])) break; if (sp > XB_SPIN_CAP) { atomicAdd(&bar[XB_TMO], 1u); break; } }
  }
  nloc = mine > 0u ? mine : 1u; nx = cnt > 0u ? cnt : 1u;
}
DI void xcd_barrier(const XcdBarrier& b) {
  asm volatile("s_waitcnt vmcnt(0)" ::: "memory");
  __syncthreads();
  if (threadIdx.x == 0) {
    unsigned* bar = b.bar;
    __builtin_amdgcn_s_waitcnt(0);
    unsigned nloc = b.st[0], nx = b.st[1];
    if (nloc == 0u) { xcd_barrier_complete(bar, b.x, nloc, nx); b.st[0] = nloc; b.st[1] = nx; }
    const unsigned old = xb_add(&bar[XB_XSUB(b.x)], 1u);
    const unsigned gen = old / nloc;
    if (old + 1u == (gen + 1u) * nloc) {
      __builtin_amdgcn_fence(__ATOMIC_RELEASE, "agent");
      asm volatile("s_waitcnt vmcnt(0)" ::: "memory");
      const unsigned og = xb_add(&bar[XB_TOP], 1u);
      const unsigned tg = og / nx;
      if (og + 1u == (tg + 1u) * nx) xb_add(&bar[XB_TOPGEN], 1u);
      else XB_SPIN(xb_ld(&bar[XB_TOPGEN]) == tg, bar);
      __builtin_amdgcn_fence(__ATOMIC_ACQUIRE, "agent");
      xb_add(&bar[XB_XGEN(b.x)], 1u);
      asm volatile("s_waitcnt vmcnt(0)" ::: "memory");
    } else {
      XB_SPIN(xb_ld(&bar[XB_XGEN(b.x)]) == gen, bar);
      __builtin_amdgcn_fence(__ATOMIC_ACQUIRE, "agent");
      asm volatile("s_waitcnt vmcnt(0)" ::: "memory");
    }
  }
  __syncthreads();
}
constexpr int CW_BAR = 4096, CW_QA = 16384, CW_QC = 16384 + 1024, CW_QN = 16384 + 2048;

__global__ void __launch_bounds__(NTHREADS, 2) mega(Params p) {
  extern __shared__ __attribute__((aligned(16))) unsigned char lds_raw[];
  cg::grid_group grid = cg::this_grid();
  Ctx F;
  F.lds = (LAS unsigned char*)lds_raw;
  F.tid = threadIdx.x; F.lane = F.tid & 63; F.wave = __builtin_amdgcn_readfirstlane(F.tid >> 6);
  F.G = gridDim.x; F.gw = blockIdx.x * NWAVES + F.wave; F.NGW = F.G * NWAVES;
  F.in = p.in; F.H = p.out; F.ws = p.ws;
  unsigned char* ws = p.ws;
  const int bx = blockIdx.x;
  if (F.tid < 8) ((LAS unsigned*)(F.lds + LDSCTL_OFF))[F.tid] = 0u;
  __syncthreads();
  const XcdBarrier bar = xcd_barrier_post((unsigned*)(ws + WS_CTL) + CW_BAR, (volatile LAS unsigned*)(F.lds + LDSCTL_OFF));
#define GRID_BAR() xcd_barrier(bar)

  prologue(F);
  if (p.pad0 == 0x5eed) grid.sync();
  GRID_BAR();
  {
    pg8::PlainOrder S; S.init(ws + WS_HN, ws + WS_WIN, NTOK, ZP, DM, DM, F.G, bx);
    pg8::EpiBf16 E{(bf16_t*)(ws + WS_Z), ZP, 0};
    pg8::gemm_phase(F.lds, DM, DM, DM, S, E);
  }
  GRID_BAR();
  gla_phase<0>(F);
#if EN_NSA
  for (int cu = (bx + 128) % F.G; cu < 256; cu += F.G) nsa_compress_unit(F, cu);
#endif
  GRID_BAR();
  gla_scan(F);
#if EN_XATTN
  {
    pg8::MemProjOrder S{(const char*)(ws + WS_MEMN), (const char*)(ws + WS_XWK), (const char*)(ws + WS_XWV), F.G, (bx + 192) % F.G};
    pg8::EpiBf16 E{(bf16_t*)(ws + WS_KX), DM, 0};
    pg8::gemm_phase(F.lds, DM, DM, DM, S, E);
  }
#endif
#if EN_NSA
  {
    unsigned* qn = (unsigned*)(ws + WS_CTL) + CW_QN;
    volatile LAS int* slot = (volatile LAS int*)(F.lds + LDSCTL_OFF + 16);
    const unsigned xcc = xb_xcc_id() & 7u;
    int tab_g = -1;
    for (int s8 = 0; s8 < 8; ++s8) {
      const int bg = (int)((xcc + (unsigned)s8) & 7u);
      for (;;) {
        __syncthreads();
        if (F.tid == 0) *slot = (int)atomicAdd(qn + 64 * bg, 1u);
        __syncthreads();
        const int u = *slot;
        if (u >= 128) break;
        nsa_unit(F, bg, 127 - u, tab_g);
      }
    }
  }
#else
  for (int m = F.gw; m < NTOK; m += F.NGW) { u32x4* o = (u32x4*)((bf16_t*)(ws + WS_OCAT) + (size_t)m * DM + 512) + F.lane; *o = (u32x4){0, 0, 0, 0}; }
#endif
  GRID_BAR();
#if EN_XATTN
  {
    pg8::FoldOrder S{(const char*)(ws + WS_KX), (const char*)(ws + WS_XWQ), (const char*)(ws + WS_XWO), (const char*)(ws + WS_VXT), F.G, bx};
    pg8::EpiBf16 E{(bf16_t*)(ws + WS_MT), DM, 0};
    pg8::gemm_phase(F.lds, 256, DM, DM, S, E);
  }
#endif
  gla_phase<1>(F);
  GRID_BAR();
  {
    pg8::PlainOrder S; S.init(ws + WS_OCAT, ws + WS_WOUT, NTOK, DM, DM, DM, F.G, bx);
    pg8::EpiRes E{p.in[I_X], (bf16_t*)(ws + WS_HN), (float*)(ws + WS_SSP)};
    pg8::gemm_phase(F.lds, DM, DM, DM, S, E);
  }
  GRID_BAR();
#if EN_XATTN
  {
    pg8::XaBatchOrder S{(const char*)(ws + WS_HN), (const char*)(ws + WS_MT), F.G, bx};
    pg8::EpiSoftmax E{(bf16_t*)(ws + WS_XP), (const float*)(ws + WS_SSP), (LAS float*)(F.lds + 131072)};
    pg8::gemm_phase(F.lds, DM, DM, DM, S, E);
  }
  GRID_BAR();
  {
    pg8::XaBatchOrder S{(const char*)(ws + WS_XP), (const char*)(ws + WS_VWT), F.G, bx};
    pg8::EpiRes E{nullptr, (bf16_t*)(ws + WS_HN), (float*)(ws + WS_SSP)};
    pg8::gemm_phase(F.lds, DM, DM, DM, S, E);
  }
  GRID_BAR();
#endif
#if EN_PEER
  {
    pg8::PlainOrder S; S.init(ws + WS_HN, ws + WS_PWQ, NTOK, DM, DM, DM, F.G, bx);
    pg8::EpiBf16RS E{(bf16_t*)(ws + WS_QP), (const float*)(ws + WS_SSP)};
    pg8::gemm_phase(F.lds, DM, DM, DM, S, E);
  }
  GRID_BAR();
  for (int u = bx; u < 256; u += F.G) peer_select_unit(F, u);
  GRID_BAR();
  peer_fused_phase(F);
#else
  { const Ctx Ff = fresh(F);
#pragma unroll 1
    for (int m = Ff.gw; m < NTOK; m += Ff.NGW) final_norm_token(Ff, m); }
#endif
}

extern "C" void kernel_launch(void* const* d_in, const int* in_sizes, int n_in, void* d_out, int out_size, void* d_ws, size_t ws_size, hipStream_t stream) {
  static int grid_blocks = 0;
  if (!grid_blocks) {
    int dev = 0, cus = 0, per_cu = 0;
    (void)hipGetDevice(&dev);
    (void)hipDeviceGetAttribute(&cus, hipDeviceAttributeMultiprocessorCount, dev);
    (void)hipFuncSetAttribute((const void*)mega, hipFuncAttributeMaxDynamicSharedMemorySize, LDS_BYTES);
    (void)hipOccupancyMaxActiveBlocksPerMultiprocessor(&per_cu, (const void*)mega, NTHREADS, LDS_BYTES);
    if (per_cu < 1) { fprintf(stderr, "kernel_launch: occupancy query says %d blocks per CU\n", per_cu); per_cu = 1; }
    grid_blocks = cus;
    if (n_in != 27 || ws_size < WS_END) { fprintf(stderr, "kernel_launch: n_in %d ws %zu (need %zu)\n", n_in, ws_size, (size_t)WS_END); }
    fprintf(stderr, "kernel_launch: grid %d x %d, per_cu %d, ws %zu MiB\n", grid_blocks, NTHREADS, per_cu, ws_size >> 20);
  }
  (void)hipMemsetAsync((char*)d_ws + WS_CTL, 0, 1 * MiB, stream);
  Params p{};
  for (int i = 0; i < 27 && i < n_in; ++i) p.in[i] = (const float*)d_in[i];
  p.out = (float*)d_out; p.ws = (unsigned char*)d_ws;
  void* args[] = {&p};
  hipError_t e = hipLaunchCooperativeKernel((void*)mega, dim3(grid_blocks), dim3(NTHREADS), args, LDS_BYTES, stream);
  if (e != hipSuccess) fprintf(stderr, "cooperative launch failed: %s (grid %d)\n", hipGetErrorString(e), grid_blocks);
}
```

```cpp
#include <hip/hip_runtime.h>
#include <hip/hip_cooperative_groups.h>
#include <cstdio>
#include <cstdint>
namespace cg = cooperative_groups;

#ifndef EN_NSA
#define EN_NSA 1
#endif
#ifndef EN_SLC
#define EN_SLC 1.f
#endif
#ifndef EN_WIN
#define EN_WIN 1.f
#endif
#ifndef EN_XATTN
#define EN_XATTN 1
#endif
#ifndef EN_PEER
#define EN_PEER 1
#endif

#define LAS __attribute__((address_space(3)))
#define DI __device__ __forceinline__
typedef unsigned short bf16_t;
typedef short bf16x8 __attribute__((ext_vector_type(8)));
typedef short s16x4 __attribute__((ext_vector_type(4)));
typedef float f32x2 __attribute__((ext_vector_type(2)));
typedef float f32x4 __attribute__((ext_vector_type(4)));
typedef float f32x16 __attribute__((ext_vector_type(16)));
typedef unsigned u32x2 __attribute__((ext_vector_type(2)));
typedef unsigned u32x4 __attribute__((ext_vector_type(4)));
typedef __bf16 bf16x2_t __attribute__((ext_vector_type(2)));
typedef short v4i16_t __attribute__((ext_vector_type(4)));

constexpr int NB = 4, T = 8192, NTOK = NB * T, DM = 1024;
constexpr int ZP = 3072;
constexpr int C_GQ = 0, C_GK = 256, C_GV = 512, C_GR = 1024, C_GLR = 1536, C_NQ = 1552, C_KC = 2064, C_VC = 2192,
              C_KS = 2320, C_VS = 2448, C_KW = 2576, C_VW = 2704, C_NG = 2832, IN_COLS = 2856;
constexpr float EPS = 1e-6f;
constexpr int NTHREADS = 512, NWAVES = 8;
constexpr int LDS_BYTES = 147456;
constexpr int LDSCTL_OFF = 139264;

constexpr size_t MiB = 1u << 20;
constexpr size_t WS_CTL = 0;
constexpr size_t WS_XL = 256 * 1024;
constexpr size_t WS_BUCK = 1 * MiB;
constexpr size_t WS_C1 = 1 * MiB + 16 * 1024;
constexpr size_t WS_W2T = 1 * MiB + 32 * 1024;
constexpr size_t WS_SK = 1 * MiB + 128 * 1024;
constexpr size_t WS_DL = 1 * MiB + 512 * 1024;
constexpr size_t WS_KCMP = 2 * MiB;
constexpr size_t WS_VCMP = 2 * MiB + 512 * 1024;
constexpr size_t WS_W1T = 3 * MiB;
constexpr size_t WS_WIN = 4 * MiB;
constexpr size_t WS_WOUT = 10 * MiB, WS_XWQ = 12 * MiB, WS_XWK = 14 * MiB, WS_XWV = 16 * MiB, WS_XWO = 18 * MiB, WS_PWQ = 20 * MiB;
constexpr size_t WS_MEMN = 22 * MiB, WS_KX = 24 * MiB, WS_VXT = 26 * MiB;
constexpr size_t WS_PDOWN8 = 32 * MiB, WS_PUP8 = 48 * MiB;
constexpr size_t WS_DSC = 1 * MiB + 64 * 1024, WS_USC = 1 * MiB + 384 * 1024;
constexpr size_t WS_SSP = 28 * MiB;
constexpr size_t WS_PART = 256 * MiB;
constexpr size_t WS_HN = 96 * MiB;
constexpr size_t WS_GU = 96 * MiB;
constexpr size_t WS_Z = 160 * MiB;
constexpr size_t WS_QX = 160 * MiB, WS_XP = 224 * MiB, WS_OX = 288 * MiB;
constexpr size_t WS_QP = 160 * MiB, WS_EIDX = 224 * MiB, WS_ACTH = 232 * MiB, WS_GATE = 240 * MiB;
constexpr size_t WS_OCAT = 352 * MiB;
constexpr size_t WS_GS = 416 * MiB;
constexpr size_t WS_MT = 448 * MiB;
constexpr size_t WS_VWT = 456 * MiB;
constexpr size_t WS_GQ = 464 * MiB, WS_GK = 480 * MiB;
constexpr size_t WS_END = 496 * MiB;

DI unsigned f2bf(float f) { unsigned u = __builtin_bit_cast(unsigned, f); return (u + 0x7fffu + ((u >> 16) & 1u)) >> 16; }
DI float bf2f(unsigned short b) { return __builtin_bit_cast(float, (unsigned)b << 16); }
DI float bflo(unsigned w) { return __builtin_bit_cast(float, w << 16); }
DI float bfhi(unsigned w) { return __builtin_bit_cast(float, w & 0xffff0000u); }
DI unsigned cvtpk(float lo, float hi) { f32x2 v = {lo, hi}; bf16x2_t b = __builtin_convertvector(v, bf16x2_t); return __builtin_bit_cast(unsigned, b); }
DI float wave_sum(float v) {
#pragma unroll
  for (int o = 1; o < 64; o <<= 1) v += __shfl_xor(v, o);
  return v;
}
DI int crow(int r, int hi) { return (r & 3) + 8 * (r >> 2) + 4 * hi; }
DI s16x4 vtr(const LAS unsigned char* p) { return __builtin_bit_cast(s16x4, __builtin_amdgcn_ds_read_tr16_b64_v4i16((LAS v4i16_t*)p)); }
DI bf16x8 cat8(s16x4 a, s16x4 b) { return __builtin_shufflevector(a, b, 0, 1, 2, 3, 4, 5, 6, 7); }
#define MFMA32(a, b, c) __builtin_amdgcn_mfma_f32_32x32x16_bf16((a), (b), (c), 0, 0, 0)
DI bf16x8 pack8(const f32x16& x, int s) {
  u32x4 p; p[0] = cvtpk(x[8 * s], x[8 * s + 1]); p[1] = cvtpk(x[8 * s + 2], x[8 * s + 3]); p[2] = cvtpk(x[8 * s + 4], x[8 * s + 5]); p[3] = cvtpk(x[8 * s + 6], x[8 * s + 7]);
  return __builtin_bit_cast(bf16x8, p);
}
DI float gelu_tanh(float x) {
  const float y = 0.7978845608028654f * (x + 0.044715f * x * x * x);
  const float e = __expf(2.f * y);
  const float th = 1.f - 2.f / (1.f + e);
  return 0.5f * x * (1.f + th);
}
DI float sigmoidf_(float x) { return 1.f / (1.f + __expf(-x)); }

DI void sort16_desc(int (&x)[16]) {
#define CE_(a, b) { const int h_ = max(x[a], x[b]); const int l_ = min(x[a], x[b]); x[a] = h_; x[b] = l_; }
  CE_(0,1); CE_(2,3); CE_(0,2); CE_(1,3); CE_(1,2); CE_(4,5); CE_(6,7); CE_(4,6); CE_(5,7); CE_(5,6); CE_(0,4); CE_(2,6); CE_(2,4); CE_(1,5); CE_(3,7); CE_(3,5); CE_(1,2); CE_(3,4); CE_(5,6); CE_(8,9); CE_(10,11); CE_(8,10); CE_(9,11); CE_(9,10); CE_(12,13); CE_(14,15); CE_(12,14); CE_(13,15); CE_(13,14); CE_(8,12); CE_(10,14); CE_(10,12); CE_(9,13); CE_(11,15); CE_(11,13); CE_(9,10); CE_(11,12); CE_(13,14); CE_(0,8); CE_(4,12); CE_(4,8); CE_(2,10); CE_(6,14); CE_(6,10); CE_(2,4); CE_(6,8); CE_(10,12); CE_(1,9); CE_(5,13); CE_(5,9); CE_(3,11); CE_(7,15); CE_(7,11); CE_(3,5); CE_(7,9); CE_(11,13); CE_(1,2); CE_(3,4); CE_(5,6); CE_(7,8); CE_(9,10); CE_(11,12); CE_(13,14);
#undef CE_
}
DI void merge16_top(int (&a)[16], const int (&b)[16]) {
  int c[16];
#pragma unroll
  for (int i = 0; i < 16; ++i) c[i] = max(a[i], b[15 - i]);
#pragma unroll
  for (int st = 8; st >= 1; st >>= 1)
#pragma unroll
    for (int i = 0; i < 16; ++i) if ((i & st) == 0) { const int x = c[i], y = c[i + st]; c[i] = max(x, y); c[i + st] = min(x, y); }
#pragma unroll
  for (int i = 0; i < 16; ++i) a[i] = c[i];
}

struct Params {
  const float* in[27];
  float* out;
  unsigned char* ws;
  int pad0, pad1;
};
enum { I_X = 0, I_MEM, I_RELB, I_NMIX, I_WIN, I_GW2, I_GB, I_GON, I_POSK, I_POSV, I_CKW1, I_CKW2, I_CVW1, I_CVW2, I_WOUT, I_NXA, I_NMEM,
       I_XWQ, I_XWK, I_XWV, I_XWO, I_NFFN, I_PWQ, I_PSK, I_PDOWN, I_PUP, I_NFIN };

namespace pg8 {
constexpr int BM = 256, BK = 64, HALF = 128, HTB = HALF * BK * 2, STAGE_BYTES = 8 * HTB;
DI int lds_byte(int r, int c) { const int st = (r >> 4) * 2 + (c >> 5), rr = r & 15, cc = c & 31, ob = rr * 64 + cc * 2; return st * 1024 + (ob ^ (((ob >> 9) & 1) << 5)); }
DI void stage_rc(int b, int& R, int& C) { const int st = b / 1024, sb = b % 1024, swz = sb ^ (((sb >> 9) & 1) << 5); R = (st >> 1) * 16 + swz / 64; C = (st & 1) * 32 + (swz % 64) / 2; }
DI int perm32(int rho) { const int n = rho >> 4, i = rho & 15; return 8 * (i >> 2) + 4 * n + (i & 3); }
struct Unit { const char* a; const char* b; int pm, pn; };
DI const char* uni_ptr(const char* p) { const unsigned long long v = (unsigned long long)p; const unsigned lo = __builtin_amdgcn_readfirstlane((unsigned)v), hi = __builtin_amdgcn_readfirstlane((unsigned)(v >> 32)); return (const char*)(((unsigned long long)hi << 32) | lo); }

template <class Epi, class Sched>
DI void gemm_phase(LAS unsigned char* lds, const int K, const int lda, const int ldb, const Sched& S, const Epi& E) {
  constexpr bool ALIGN_EPI = true;
  int tid_ = threadIdx.x; asm volatile("" : "+v"(tid_));
  const int tid = tid_, wid = __builtin_amdgcn_readfirstlane(tid >> 6), lane = tid & 63, wr = wid >> 2, wc = wid & 3, fr = lane & 15, fq = lane >> 4;
  const int nt = K / BK;
  unsigned voffA[2], voffB[2];
#pragma unroll
  for (int i = 0; i < 2; ++i) { int R, C; stage_rc(tid * 16 + i * 8192, R, C); const int Rb = Epi::PERM ? ((R & ~31) + perm32(R & 31)) : R;
    voffA[i] = (unsigned)(R * lda + C) * 2u; voffB[i] = (unsigned)(Rb * ldb + C) * 2u; }
  const size_t kstep = (size_t)(BK * 2);
  const size_t hstepA = (size_t)HALF * lda * 2, hstepB = (size_t)HALF * ldb * 2;
  const unsigned ldsw = (unsigned)wid * 1024u;
  const int aoff = lds_byte(wr * 64 + fr, fq * 8), boff = lds_byte(wc * 32 + fr, fq * 8);
#define PG8_SA(b, h) (((b) * 2 + (h)) * HTB)
#define PG8_SB(b, h) ((4 + (b) * 2 + (h)) * HTB)
#define PG8_STAGE(bufoff, gbase, voff) do { _Pragma("unroll") for (int _i = 0; _i < 2; ++_i) \
        __builtin_amdgcn_global_load_lds((const unsigned*)((const char*)(gbase) + (voff)[_i]), (LAS unsigned*)(lds + (bufoff) + ldsw + _i * 8192), 16, 0, 0); } while (0)
#define PG8_LDA(dst, b, h) do { _Pragma("unroll") for (int m = 0; m < 4; ++m) _Pragma("unroll") for (int k = 0; k < 2; ++k) dst[m][k] = *(const LAS bf16x8*)(lds + PG8_SA(b, h) + aoff + m * 2048 + k * 1024); } while (0)
#define PG8_LDB(dst, b, h) do { _Pragma("unroll") for (int n = 0; n < 2; ++n) _Pragma("unroll") for (int k = 0; k < 2; ++k) dst[n][k] = *(const LAS bf16x8*)(lds + PG8_SB(b, h) + boff + n * 2048 + k * 1024); } while (0)
#define PG8_MMA(ai, bj, At, Bt) do { __builtin_amdgcn_s_setprio(1); _Pragma("unroll") for (int m = 0; m < 4; ++m) _Pragma("unroll") for (int n = 0; n < 2; ++n) _Pragma("unroll") for (int k = 0; k < 2; ++k) \
        acc[ai][bj][m][n] = __builtin_amdgcn_mfma_f32_16x16x32_bf16(Bt[n][k], At[m][k], acc[ai][bj][m][n], 0, 0, 0); __builtin_amdgcn_s_setprio(0); } while (0)
#define PG8_WAIT_V(n) asm volatile("s_waitcnt vmcnt(" #n ")" ::: "memory")
#define PG8_WAIT_L(n) asm volatile("s_waitcnt lgkmcnt(" #n ")" ::: "memory")
#define PG8_BAR __builtin_amdgcn_s_barrier()
#define PG8_SCHED __builtin_amdgcn_sched_barrier(0)
  __syncthreads();
  Unit cur, nxt; int ui = 0;
  if (!S.next(0, cur)) return;
  f32x4 acc[2][2][4][2];
#pragma unroll
  for (int a = 0; a < 2; ++a)
#pragma unroll
    for (int b = 0; b < 2; ++b)
#pragma unroll
      for (int m = 0; m < 4; ++m)
#pragma unroll
        for (int n = 0; n < 2; ++n) acc[a][b][m][n] = (f32x4){0.f, 0.f, 0.f, 0.f};
  bf16x8 At[4][2], B0[2][2], B1[2][2];
  const char* cA = uni_ptr(cur.a); const char* cB = uni_ptr(cur.b);
  PG8_STAGE(PG8_SB(0, 0), cB, voffB); PG8_STAGE(PG8_SB(0, 1), cB + hstepB, voffB); PG8_STAGE(PG8_SA(0, 0), cA, voffA); PG8_STAGE(PG8_SA(0, 1), cA + hstepA, voffA);
  if (wr == 1) PG8_BAR;
  PG8_WAIT_V(2); PG8_BAR;
  PG8_STAGE(PG8_SB(1, 0), cB + kstep, voffB); PG8_STAGE(PG8_SA(1, 0), cA + kstep, voffA); PG8_STAGE(PG8_SB(1, 1), cB + hstepB + kstep, voffB);
  PG8_WAIT_V(6); PG8_BAR;
  for (;;) {
    const bool has_next = S.next(ui + 1, nxt);
    const char* nA = has_next ? uni_ptr(nxt.a) : cA; const char* nB = has_next ? uni_ptr(nxt.b) : cB;
#pragma unroll 1
    for (int t = 0; t < nt; t += 2) {
      const bool last = (t == nt - 2);
      const char* a1 = cA + (size_t)(t + 1) * kstep;
      const char* a2 = last ? nA : cA + (size_t)(t + 2) * kstep; const char* b2 = last ? nB : cB + (size_t)(t + 2) * kstep;
      const char* a3 = a2 + kstep; const char* b3 = b2 + kstep;
      PG8_LDB(B0, 0, 0); PG8_LDB(B1, 0, 1); PG8_SCHED; PG8_LDA(At, 0, 0); PG8_STAGE(PG8_SA(1, 1), a1 + hstepA, voffA);
      PG8_WAIT_V(8); PG8_WAIT_L(0); PG8_BAR; PG8_MMA(0, 0, At, B0); PG8_MMA(0, 1, At, B1); PG8_BAR; PG8_SCHED;
      PG8_LDA(At, 0, 1); PG8_STAGE(PG8_SB(0, 0), b2, voffB); PG8_STAGE(PG8_SB(0, 1), b2 + hstepB, voffB); PG8_STAGE(PG8_SA(0, 0), a2, voffA);
      PG8_WAIT_V(8); PG8_WAIT_L(0); PG8_BAR; PG8_MMA(1, 0, At, B0); PG8_MMA(1, 1, At, B1); PG8_BAR; PG8_SCHED;
      PG8_LDB(B0, 1, 0); PG8_LDB(B1, 1, 1); PG8_SCHED; PG8_LDA(At, 1, 0); PG8_STAGE(PG8_SA(0, 1), a2 + hstepA, voffA);
      PG8_WAIT_V(8); PG8_WAIT_L(0); PG8_BAR; PG8_MMA(0, 0, At, B0); PG8_MMA(0, 1, At, B1); PG8_BAR; PG8_SCHED;
      PG8_LDA(At, 1, 1); PG8_STAGE(PG8_SB(1, 0), b3, voffB); PG8_STAGE(PG8_SB(1, 1), b3 + hstepB, voffB); PG8_STAGE(PG8_SA(1, 0), a3, voffA);
      PG8_WAIT_V(8); PG8_WAIT_L(0); PG8_BAR; PG8_MMA(1, 0, At, B0); PG8_MMA(1, 1, At, B1); PG8_BAR; PG8_SCHED;
    }
    if constexpr (ALIGN_EPI) { if (wr == 0) PG8_BAR; }
    E(acc, cur, wr, wc, fr, fq);
    if (!has_next) break;
#pragma unroll
    for (int a = 0; a < 2; ++a)
#pragma unroll
      for (int b = 0; b < 2; ++b)
#pragma unroll
        for (int m = 0; m < 4; ++m)
#pragma unroll
          for (int n = 0; n < 2; ++n) acc[a][b][m][n] = (f32x4){0.f, 0.f, 0.f, 0.f};
    cur = nxt; cA = nA; cB = nB; ++ui;
    if constexpr (ALIGN_EPI) { if (wr == 1) PG8_BAR; }
  }
  PG8_WAIT_V(0);
  if constexpr (!ALIGN_EPI) { if (wr == 0) PG8_BAR; }
  PG8_BAR;
#undef PG8_SA
#undef PG8_SB
#undef PG8_STAGE
#undef PG8_LDA
#undef PG8_LDB
#undef PG8_MMA
#undef PG8_WAIT_V
#undef PG8_WAIT_L
#undef PG8_BAR
#undef PG8_SCHED
}

struct EpiBf16 {
  static constexpr bool PERM = true;
  bf16_t* O; int ldc; int coloff;
  DI void operator()(const f32x4 (&acc)[2][2][4][2], const Unit& u, int wr, int wc, int fr, int fq) const {
    const int row0 = u.pm * BM + wr * 64 + fr; const int col0 = coloff + u.pn * BM + wc * 32 + 8 * fq;
#pragma unroll
    for (int ai = 0; ai < 2; ++ai)
#pragma unroll
      for (int m = 0; m < 4; ++m) { bf16_t* rowp = O + (size_t)(row0 + ai * HALF + m * 16) * ldc + col0;
#pragma unroll
        for (int bj = 0; bj < 2; ++bj) { const f32x4 v0 = acc[ai][bj][m][0], v1 = acc[ai][bj][m][1];
          u32x4 w; w.x = cvtpk(v0[0], v0[1]); w.y = cvtpk(v0[2], v0[3]); w.z = cvtpk(v1[0], v1[1]); w.w = cvtpk(v1[2], v1[3]);
          *(u32x4*)(rowp + bj * HALF) = w; } }
  }
};
struct EpiRes {
  static constexpr bool PERM = false;
  const float* ResF; bf16_t* HB; float* SSP;
  DI void operator()(const f32x4 (&acc)[2][2][4][2], const Unit& u, int wr, int wc, int fr, int fq) const {
    const int row0 = u.pm * BM + wr * 64 + fr; const int col0 = u.pn * BM + wc * 32 + 4 * fq;
#pragma unroll
    for (int ai = 0; ai < 2; ++ai)
#pragma unroll
      for (int m = 0; m < 4; ++m) { const int row = row0 + ai * HALF + m * 16; const size_t off = (size_t)row * DM + col0; float ss = 0.f;
#pragma unroll
        for (int bj = 0; bj < 2; ++bj)
#pragma unroll
          for (int n = 0; n < 2; ++n) { f32x4 r;
            if (ResF) r = *(const f32x4*)(ResF + off + bj * HALF + n * 16);
            else { const u32x2 rb = *(const u32x2*)(HB + off + bj * HALF + n * 16); r = (f32x4){bflo(rb.x), bfhi(rb.x), bflo(rb.y), bfhi(rb.y)}; }
            const f32x4 o = r + acc[ai][bj][m][n];
            u32x2 w; w.x = cvtpk(o[0], o[1]); w.y = cvtpk(o[2], o[3]); *(u32x2*)(HB + off + bj * HALF + n * 16) = w;
            const float q0 = bflo(w.x), q1 = bfhi(w.x), q2 = bflo(w.y), q3 = bfhi(w.y);
            ss += (q0 * q0 + q1 * q1) + (q2 * q2 + q3 * q3); }
        ss += __shfl_xor(ss, 16); ss += __shfl_xor(ss, 32);
        if (fq == 0) SSP[(size_t)row * 16 + u.pn * 4 + wc] = ss; }
  }
};
DI float row_rstd(const float* SSP, int row) {
  const f32x4* p = (const f32x4*)(SSP + (size_t)row * 16); const f32x4 a = p[0], b = p[1], c = p[2], d = p[3];
  const float s = ((a[0] + a[1]) + (a[2] + a[3])) + ((b[0] + b[1]) + (b[2] + b[3])) + ((c[0] + c[1]) + (c[2] + c[3])) + ((d[0] + d[1]) + (d[2] + d[3]));
  return rsqrtf(s * (1.f / DM) + EPS);
}
struct EpiBf16RS {
  static constexpr bool PERM = true;
  bf16_t* O; const float* SSP;
  DI void operator()(const f32x4 (&acc)[2][2][4][2], const Unit& u, int wr, int wc, int fr, int fq) const {
    const int row0 = u.pm * BM + wr * 64 + fr; const int col0 = u.pn * BM + wc * 32 + 8 * fq;
#pragma unroll
    for (int ai = 0; ai < 2; ++ai)
#pragma unroll
      for (int m = 0; m < 4; ++m) { const int row = row0 + ai * HALF + m * 16; bf16_t* rowp = O + (size_t)row * DM + col0; const float rs = row_rstd(SSP, row);
#pragma unroll
        for (int bj = 0; bj < 2; ++bj) { const f32x4 v0 = acc[ai][bj][m][0] * rs, v1 = acc[ai][bj][m][1] * rs;
          u32x4 w; w.x = cvtpk(v0[0], v0[1]); w.y = cvtpk(v0[2], v0[3]); w.z = cvtpk(v1[0], v1[1]); w.w = cvtpk(v1[2], v1[3]);
          *(u32x4*)(rowp + bj * HALF) = w; } }
  }
};
struct EpiSoftmax {
  static constexpr bool PERM = true;
  bf16_t* P; const float* SSP; LAS float* xch;
  DI void operator()(f32x4 (&acc)[2][2][4][2], const Unit& u, int wr, int wc, int fr, int fq) const {
    const int row0 = u.pm * BM + wr * 64 + fr; const int col0 = u.pn * BM + wc * 32 + 8 * fq;
#pragma unroll
    for (int ai = 0; ai < 2; ++ai)
#pragma unroll
      for (int m = 0; m < 4; ++m) { const int row = row0 + ai * HALF + m * 16; const float rs = row_rstd(SSP, row) * 1.4426950408889634f; float s = 0.f;
#pragma unroll
        for (int bj = 0; bj < 2; ++bj)
#pragma unroll
          for (int n = 0; n < 2; ++n) { f32x4 v = acc[ai][bj][m][n] * rs;
#pragma unroll
            for (int q = 0; q < 4; ++q) v[q] = __builtin_amdgcn_exp2f(v[q]);
            acc[ai][bj][m][n] = v; s += (v[0] + v[1]) + (v[2] + v[3]); }
        s += __shfl_xor(s, 16); s += __shfl_xor(s, 32);
        if (fq == 0) xch[(wr * 64 + ai * HALF + m * 16 + fr) * 4 + wc] = s; }
    asm volatile("s_waitcnt lgkmcnt(0)" ::: "memory"); __builtin_amdgcn_s_barrier(); asm volatile("" ::: "memory");
#pragma unroll
    for (int ai = 0; ai < 2; ++ai)
#pragma unroll
      for (int m = 0; m < 4; ++m) { const int rl = wr * 64 + ai * HALF + m * 16 + fr; const f32x4 ps = *(const LAS f32x4*)(xch + rl * 4); const float inv = 1.f / ((ps[0] + ps[1]) + (ps[2] + ps[3]));
        bf16_t* rowp = P + (size_t)(row0 + ai * HALF + m * 16) * DM + col0;
#pragma unroll
        for (int bj = 0; bj < 2; ++bj) { const f32x4 v0 = acc[ai][bj][m][0] * inv, v1 = acc[ai][bj][m][1] * inv;
          u32x4 w; w.x = cvtpk(v0[0], v0[1]); w.y = cvtpk(v0[2], v0[3]); w.z = cvtpk(v1[0], v1[1]); w.w = cvtpk(v1[2], v1[3]);
          *(u32x4*)(rowp + bj * HALF) = w; } }
    asm volatile("s_waitcnt lgkmcnt(0)" ::: "memory"); __builtin_amdgcn_s_barrier(); asm volatile("" ::: "memory");
  }
};

struct PlainOrder {
  const char* A; const char* Bt; size_t tstepA, tstepB; int nM, nN, nwg, G, c;
  DI void init(const void* A_, const void* Bt_, int M, int N, int lda, int ldb, int G_, int c_) { A = (const char*)A_; Bt = (const char*)Bt_; tstepA = (size_t)BM * lda * 2; tstepB = (size_t)BM * ldb * 2; nM = M / BM; nN = N / BM; nwg = nM * nN; G = G_; c = c_; }
  DI bool next(int i, Unit& u) const {
    const long L = (long)i * G + c; if (L >= nwg) return false;
    int wgid = (int)L; { const int q = nwg / 8, r = nwg % 8, xcd = wgid % 8, off = wgid / 8; wgid = (xcd < r ? xcd * (q + 1) : r * (q + 1) + (xcd - r) * q) + off; }
    constexpr int WGM = 8;
    const int nig = WGM * nN, gid = wgid / nig, fm = gid * WGM, gsz = (nM - fm) < WGM ? (nM - fm) : WGM;
    u.pm = fm + ((wgid % nig) % gsz); u.pn = (wgid % nig) / gsz; u.a = A + (size_t)u.pm * tstepA; u.b = Bt + (size_t)u.pn * tstepB; return true;
  }
};
struct XaBatchOrder {
  const char* A; const char* Bb; int G, c;
  DI bool next(int i, Unit& u) const { const int L = i * G + c; if (L >= 512) return false; u.pm = L >> 2; u.pn = L & 3; const int b = u.pm >> 5;
    u.a = A + (size_t)u.pm * 256 * DM * 2; u.b = Bb + ((size_t)(b * 1024 + u.pn * 256) * DM) * 2; return true; }
};
struct FoldOrder {
  const char* KX; const char* WQO; const char* WOT; const char* VX; int G, c;
  DI bool next(int i, Unit& u) const { const int L = i * G + c; if (L >= 128) return false; const int t = L >> 6, b = (L >> 4) & 3, h = (L >> 2) & 3, q = L & 3;
    if (t == 0) { u.pm = b * 4 + h; u.pn = q; u.a = KX + ((size_t)(b * 256) * DM + h * 256) * 2; u.b = WQO + ((size_t)(q * 256) * DM + h * 256) * 2; }
    else { u.pm = 16 + b * 4 + q; u.pn = h; u.a = WOT + ((size_t)(q * 256) * DM + h * 256) * 2; u.b = VX + ((size_t)(b * 256) * DM + h * 256) * 2; }
    return true; }
};
struct MemProjOrder {
  const char* MEMN; const char* WKT; const char* WVT; int G, c;
  DI bool next(int i, Unit& u) const { const int L = i * G + c; if (L >= 32) return false; const int t = L >> 4, m = (L >> 2) & 3, n = L & 3;
    u.pm = t * 4 + m; u.pn = n; u.a = MEMN + (size_t)(m * 256) * DM * 2; u.b = (t ? WVT : WKT) + (size_t)(n * 256) * DM * 2; return true; }
};
}

struct Ctx {
  LAS unsigned char* lds;
  int tid, lane, wave, G, gw, NGW;
  const float* const* in;
  float* H;
  unsigned char* ws;
};
DI Ctx fresh(const Ctx& F) { Ctx R = F; int t = threadIdx.x; asm volatile("" : "+v"(t)); R.tid = t; R.lane = t & 63; R.wave = __builtin_amdgcn_readfirstlane(t >> 6); R.gw = blockIdx.x * NWAVES + R.wave; return R; }

DI void transpose_item(const float* W, int K, int Nsrc, int ldw, bf16_t* WT, int nblk, LAS float* scr, int item, int lane, int mode, const float* kgain = nullptr) {
  const int kb = item / nblk, nb = item % nblk, k0 = 64 * kb, n0 = 32 * nb;
  const int ncol = n0 + (lane & 31);
  float sc = 1.f;
  if (mode == 1) { if (ncol < 256) sc = 0.125f; else if (ncol >= C_NQ && ncol < C_NQ + 512) sc = 0.125f * 1.4426950408889634f; }
  if (mode == 2) sc = 0.0625f;
  float tv[32];
#pragma unroll
  for (int i = 0; i < 32; ++i) { const int kk = 2 * i + (lane >> 5); tv[i] = ncol < Nsrc ? W[(size_t)(k0 + kk) * ldw + ncol] : 0.f; }
#pragma unroll
  for (int i = 0; i < 32; ++i) { const int kk = 2 * i + (lane >> 5); const float gk = kgain ? kgain[k0 + kk] : 1.f; scr[kk * 33 + (lane & 31)] = tv[i] * (sc * gk); }
  asm volatile("s_waitcnt lgkmcnt(0)" ::: "memory");
  const int c = lane & 7;
#pragma unroll
  for (int j = 0; j < 4; ++j) { const int n = (lane >> 3) + 8 * j; const LAS float* s = scr + (8 * c) * 33 + n;
    u32x4 o; o.x = cvtpk(s[0 * 33], s[1 * 33]); o.y = cvtpk(s[2 * 33], s[3 * 33]); o.z = cvtpk(s[4 * 33], s[5 * 33]); o.w = cvtpk(s[6 * 33], s[7 * 33]);
    *(u32x4*)(WT + (size_t)(n0 + n) * K + k0 + 8 * c) = o; }
  asm volatile("s_waitcnt lgkmcnt(0)" ::: "memory");
}
DI void rms_row_bf16(const float* xrow, const float* g, bf16_t* orow, int lane) {
  const f32x4* xr = (const f32x4*)xrow + lane;
  f32x4 v[4]; float s = 0.f;
#pragma unroll
  for (int j = 0; j < 4; ++j) { v[j] = xr[64 * j]; s += (v[j].x * v[j].x + v[j].y * v[j].y) + (v[j].z * v[j].z + v[j].w * v[j].w); }
  const float r = rsqrtf(wave_sum(s) * (1.f / DM) + EPS);
  u32x2* o8 = (u32x2*)orow + lane;
#pragma unroll
  for (int j = 0; j < 4; ++j) { const f32x4 gg = ((const f32x4*)g)[lane + 64 * j]; u32x2 w; w.x = cvtpk(v[j].x * r * gg.x, v[j].y * r * gg.y); w.y = cvtpk(v[j].z * r * gg.z, v[j].w * r * gg.w); o8[64 * j] = w; }
}
DI void cvt_row_fp8(const float* xrow, unsigned char* orow, float* inv_scale, int lane, const float* cgain = nullptr) {
  const f32x4* xr = (const f32x4*)xrow + lane; unsigned* o4 = (unsigned*)orow + lane;
  f32x4 v[4]; float mx = 0.f;
#pragma unroll
  for (int j = 0; j < 4; ++j) { v[j] = xr[64 * j]; if (cgain) v[j] = v[j] * ((const f32x4*)cgain)[lane + 64 * j]; mx = fmaxf(mx, fmaxf(fmaxf(fabsf(v[j].x), fabsf(v[j].y)), fmaxf(fabsf(v[j].z), fabsf(v[j].w)))); }
#pragma unroll
  for (int o = 1; o < 64; o <<= 1) mx = fmaxf(mx, __shfl_xor(mx, o));
  const float sc = mx > 0.f ? 256.f / mx : 1.f;
#pragma unroll
  for (int j = 0; j < 4; ++j) { int w = 0; w = __builtin_amdgcn_cvt_pk_fp8_f32(v[j].x * sc, v[j].y * sc, w, false); w = __builtin_amdgcn_cvt_pk_fp8_f32(v[j].z * sc, v[j].w * sc, w, true); o4[64 * j] = (unsigned)w; }
  if (lane == 0) *inv_scale = mx > 0.f ? mx * (1.f / 256.f) : 1.f;
}
DI void cvt_row_bf16(const float* xrow, bf16_t* orow, int lane) {
  const f32x4* xr = (const f32x4*)xrow + lane; u32x2* o8 = (u32x2*)orow + lane;
#pragma unroll
  for (int j = 0; j < 4; ++j) { const f32x4 v = xr[64 * j]; u32x2 w; w.x = cvtpk(v.x, v.y); w.y = cvtpk(v.z, v.w); o8[64 * j] = w; }
}

DI void rows4_load(f32x4 (&v)[4][4], const float* x, const int (&rows)[4], int lane) {
#pragma unroll
  for (int q = 0; q < 4; ++q) { const f32x4* xr = (const f32x4*)(x + (size_t)rows[q] * DM) + lane;
#pragma unroll
    for (int j = 0; j < 4; ++j) v[q][j] = xr[64 * j]; }
}
DI void rms_rows4_bf16(f32x4 (&v)[4][4], const float* g, bf16_t* o, const int (&rows)[4], int lane) {
#pragma unroll
  for (int q = 0; q < 4; ++q) { float s = 0.f;
#pragma unroll
    for (int j = 0; j < 4; ++j) s += (v[q][j].x * v[q][j].x + v[q][j].y * v[q][j].y) + (v[q][j].z * v[q][j].z + v[q][j].w * v[q][j].w);
    const float r = rsqrtf(wave_sum(s) * (1.f / DM) + EPS);
    u32x2* o8 = (u32x2*)(o + (size_t)rows[q] * DM) + lane;
#pragma unroll
    for (int j = 0; j < 4; ++j) { const f32x4 gg = ((const f32x4*)g)[lane + 64 * j]; u32x2 w; w.x = cvtpk(v[q][j].x * r * gg.x, v[q][j].y * r * gg.y); w.y = cvtpk(v[q][j].z * r * gg.z, v[q][j].w * r * gg.w); o8[64 * j] = w; } }
}
DI void cvt_rows4_fp8(f32x4 (&v)[4][4], unsigned char* o, float* inv_scale, const int (&rows)[4], int lane, const float* cgain) {
#pragma unroll
  for (int q = 0; q < 4; ++q) { float mx = 0.f;
#pragma unroll
    for (int j = 0; j < 4; ++j) { if (cgain) v[q][j] = v[q][j] * ((const f32x4*)cgain)[lane + 64 * j]; mx = fmaxf(mx, fmaxf(fmaxf(fabsf(v[q][j].x), fabsf(v[q][j].y)), fmaxf(fabsf(v[q][j].z), fabsf(v[q][j].w)))); }
#pragma unroll
    for (int o_ = 1; o_ < 64; o_ <<= 1) mx = fmaxf(mx, __shfl_xor(mx, o_));
    const float sc = mx > 0.f ? 256.f / mx : 1.f;
#pragma unroll
    for (int j = 0; j < 4; ++j) { int w = 0; w = __builtin_amdgcn_cvt_pk_fp8_f32(v[q][j].x * sc, v[q][j].y * sc, w, false); w = __builtin_amdgcn_cvt_pk_fp8_f32(v[q][j].z * sc, v[q][j].w * sc, w, true);
      const int col = 4 * (lane + 64 * j); *(unsigned*)(o + ((size_t)(col >> 7) * 16384 + rows[q]) * 128 + (col & 127)) = (unsigned)w; }
    if (lane == 0) inv_scale[rows[q]] = mx > 0.f ? mx * (1.f / 256.f) : 1.f; }
}
struct BigItem { const float* src; int kind; int rows[4]; };

DI void prologue(const Ctx& F0) {
  const Ctx F = fresh(F0);
  LAS float* scr = (LAS float*)(F.lds + F.wave * 16384);
  unsigned char* ws = F.ws;
  auto do_transposes = [&]() {
  constexpr int I_IN = 16 * 96, I_SQ = 16 * 32, I_W1 = 32 * 4, I_W2 = 2 * 2;
  constexpr int NT_ITEMS = I_IN + 5 * I_SQ + 2 * I_W1 + 2 * I_W2;
  for (int it = F.gw; it < NT_ITEMS; it += F.NGW) {
    int r = it;
    if (r < I_IN) { transpose_item(F.in[I_WIN], 1024, IN_COLS, IN_COLS, (bf16_t*)(ws + WS_WIN), 96, scr, r, F.lane, 1); continue; } r -= I_IN;
    if (r < I_SQ) { transpose_item(F.in[I_WOUT], 1024, 1024, 1024, (bf16_t*)(ws + WS_WOUT), 32, scr, r, F.lane, 0); continue; } r -= I_SQ;
    if (r < I_SQ) { transpose_item(F.in[I_XWK], 1024, 1024, 1024, (bf16_t*)(ws + WS_XWK), 32, scr, r, F.lane, 0); continue; } r -= I_SQ;
    if (r < I_SQ) { transpose_item(F.in[I_XWV], 1024, 1024, 1024, (bf16_t*)(ws + WS_XWV), 32, scr, r, F.lane, 0); continue; } r -= I_SQ;
    if (r < I_SQ) { transpose_item(F.in[I_XWO], 1024, 1024, 1024, (bf16_t*)(ws + WS_XWO), 32, scr, r, F.lane, 0); continue; } r -= I_SQ;
    if (r < I_SQ) { transpose_item(F.in[I_PWQ], 1024, 1024, 1024, (bf16_t*)(ws + WS_PWQ), 32, scr, r, F.lane, 0, F.in[I_NFFN]); continue; } r -= I_SQ;
    if (r < I_W1) { transpose_item(F.in[I_CKW1], 2048, 128, 128, (bf16_t*)(ws + WS_W1T), 4, scr, r, F.lane, 0); continue; } r -= I_W1;
    if (r < I_W1) { transpose_item(F.in[I_CVW1], 2048, 128, 128, (bf16_t*)(ws + WS_W1T) + 128 * 2048, 4, scr, r, F.lane, 0); continue; } r -= I_W1;
    if (r < I_W2) { transpose_item(F.in[I_CKW2], 128, 64, 64, (bf16_t*)(ws + WS_W2T), 2, scr, r, F.lane, 0); continue; } r -= I_W2;
    transpose_item(F.in[I_CVW2], 128, 64, 64, (bf16_t*)(ws + WS_W2T) + 64 * 128, 2, scr, r, F.lane, 0);
  }
  };
  auto do_bigrows = [&]() {
  {
    const int step = 4 * F.NGW, nx = (NTOK + step - 1) / step, nt = (16384 + step - 1) / step, J = nx + 2 * nt;
    auto item = [&](int j, BigItem& I) -> bool {
      int r0, nmax;
      if (j < nx) { I.src = F.in[I_X]; I.kind = 0; r0 = F.gw + j * step; nmax = NTOK; }
      else { const int jj = j - nx; I.kind = 1 + (jj & 1); I.src = F.in[(jj & 1) ? I_PUP : I_PDOWN]; r0 = F.gw + (jj >> 1) * step; nmax = 16384; }
      if (r0 >= nmax) return false;
#pragma unroll
      for (int q = 0; q < 4; ++q) I.rows[q] = min(r0 + q * F.NGW, nmax - 1);
      return true; };
    auto proc = [&](f32x4 (&v)[4][4], const BigItem& I) {
      if (I.kind == 0) rms_rows4_bf16(v, F.in[I_NMIX], (bf16_t*)(ws + WS_HN), I.rows, F.lane);
      else if (I.kind == 1) cvt_rows4_fp8(v, ws + WS_PDOWN8, (float*)(ws + WS_DSC), I.rows, F.lane, F.in[I_NFFN]);
      else cvt_rows4_fp8(v, ws + WS_PUP8, (float*)(ws + WS_USC), I.rows, F.lane, nullptr); };
    f32x4 VA[4][4], VB[4][4]; BigItem IA, IB;
    bool ha = item(0, IA); if (ha) rows4_load(VA, IA.src, IA.rows, F.lane);
#pragma unroll 1
    for (int j = 0; j < J; j += 2) {
      const bool hb = (j + 1 < J) && item(j + 1, IB); if (hb) rows4_load(VB, IB.src, IB.rows, F.lane);
      if (ha) proc(VA, IA);
      ha = (j + 2 < J) && item(j + 2, IA); if (ha) rows4_load(VA, IA.src, IA.rows, F.lane);
      if (hb) proc(VB, IB);
    }
  }
  };
  if (F.wave & 1) { do_bigrows(); do_transposes(); } else { do_transposes(); do_bigrows(); }
  constexpr int R_MEM = 1024, R_WQ = 1024, R_SK = 128, R_C1 = 256, R_BK = 8;
  constexpr int NR_ITEMS = R_MEM + R_WQ + R_SK + R_C1 + R_BK;
  for (int it = F.gw; it < NR_ITEMS; it += F.NGW) {
    int r = it;
    if (r < R_MEM) { rms_row_bf16(F.in[I_MEM] + (size_t)r * DM, F.in[I_NMEM], (bf16_t*)(ws + WS_MEMN) + (size_t)r * DM, F.lane); continue; } r -= R_MEM;
    if (r < R_WQ) {
      const float sck = F.in[I_NXA][r] * 0.0625f; const f32x4* xr = (const f32x4*)(F.in[I_XWQ] + (size_t)r * DM) + F.lane; u32x2* o8 = (u32x2*)((bf16_t*)(ws + WS_XWQ) + (size_t)r * DM) + F.lane;
#pragma unroll
      for (int j = 0; j < 4; ++j) { const f32x4 v = xr[64 * j] * sck; u32x2 w; w.x = cvtpk(v.x, v.y); w.y = cvtpk(v.z, v.w); o8[64 * j] = w; }
      continue; } r -= R_WQ;
    if (r < R_SK) { cvt_row_bf16(F.in[I_PSK] + (size_t)r * 1024, (bf16_t*)(ws + WS_SK) + (size_t)r * 1024, F.lane); continue; } r -= R_SK;
    if (r < R_C1) {
      const int kv = r >> 7, hid = r & 127; const float* pos = F.in[kv ? I_POSV : I_POSK]; const float* w1 = F.in[kv ? I_CVW1 : I_CKW1];
      float s = 0.f;
      for (int i = F.lane; i < 2048; i += 64) s += pos[i] * w1[(size_t)i * 128 + hid];
      s = wave_sum(s);
      if (F.lane == 0) ((float*)(ws + WS_C1))[kv * 128 + hid] = s;
      continue; } r -= R_C1;
    {
      unsigned char* bk = ws + WS_BUCK;
      for (int i = F.lane; i < 1024; i += 64) { const int d = r * 1024 + i;
        int b = d;
        if (d >= 16) { b = 16; const int thr[15] = {22, 30, 40, 54, 73, 99, 134, 182, 246, 332, 450, 609, 825, 1117, 1513};
#pragma unroll
          for (int k = 0; k < 15; ++k) b += (d >= thr[k]) ? 1 : 0; }
        bk[d] = (unsigned char)b; }
    }
  }
}

constexpr int GL_LA = 0, GL_SEG = 16384, GL_GLR = 18432, GL_W2 = 22528, GL_BIAS = 26624, GL_QT = 27648, GL_KT = 35840, GL_KTT = 44032, GL_V = 52224, GL_O = 68608;
constexpr int G0_STRIDE = 68608;
constexpr int G1_QT = 0, G1_KT = 8192, G1_V = 16384, G1_O = 32768, G1_STRIDE = 66560;
template <int MODE>
DI void gla_pair(const Ctx& F, const int ua, const int ub) {
  const int tid = F.tid, lane = F.lane, w = F.wave;
  const bf16_t* Z = (const bf16_t*)(F.ws + WS_Z);
  const int t = tid >> 3, c8 = tid & 7;
  const int r32 = lane & 31, hi = lane >> 5, i16 = lane & 15, g16 = lane >> 4;
  const int un[2] = {ua, ub};
  __syncthreads();
  if constexpr (MODE == 0) {
    u32x4 q8[2], k8[2];
#pragma unroll
    for (int s = 0; s < 2; ++s) {
      const int unit = un[s], c = unit & 127, h = (unit >> 7) & 3, b = unit >> 9; const size_t m0 = (size_t)b * T + (size_t)c * 64;
      LAS unsigned char* L = F.lds + s * G0_STRIDE;
      const bf16_t* zrow = Z + (m0 + t) * ZP;
      q8[s] = *(const u32x4*)(zrow + C_GQ + h * 64 + c8 * 8); k8[s] = *(const u32x4*)(zrow + C_GK + h * 64 + c8 * 8);
      const u32x4 v0 = *(const u32x4*)(zrow + C_GV + h * 128 + c8 * 8), v1 = *(const u32x4*)(zrow + C_GV + h * 128 + 64 + c8 * 8);
      *(LAS u32x4*)(L + GL_V + t * 256 + c8 * 16) = v0; *(LAS u32x4*)(L + GL_V + t * 256 + 128 + c8 * 16) = v1;
      if (tid < 128) { const int tt = tid >> 1, hf = tid & 1; const u32x4 g = *(const u32x4*)(Z + (m0 + tt) * ZP + C_GLR + hf * 8);
        LAS float* o = (LAS float*)(L + GL_GLR) + tt * 16 + hf * 8; o[0] = bflo(g.x); o[1] = bfhi(g.x); o[2] = bflo(g.y); o[3] = bfhi(g.y); o[4] = bflo(g.z); o[5] = bfhi(g.z); o[6] = bflo(g.w); o[7] = bfhi(g.w); }
      if (tid < 256) { const int r = tid >> 4, c4 = tid & 15; *(LAS f32x4*)((LAS float*)(L + GL_W2) + r * 64 + c4 * 4) = *(const f32x4*)(F.in[I_GW2] + r * 256 + h * 64 + c4 * 4); }
      if (tid < 64) ((LAS float*)(L + GL_BIAS))[tid] = F.in[I_GB][h * 64 + tid];
    }
    __syncthreads();
#pragma unroll
    for (int s = 0; s < 2; ++s) {
      LAS unsigned char* L = F.lds + s * G0_STRIDE;
      LAS float* LA = (LAS float*)(L + GL_LA); const LAS float* GLR = (const LAS float*)(L + GL_GLR); const LAS float* W2 = (const LAS float*)(L + GL_W2); const LAS float* BIAS = (const LAS float*)(L + GL_BIAS);
      float z[8];
#pragma unroll
      for (int j = 0; j < 8; ++j) z[j] = BIAS[c8 * 8 + j];
#pragma unroll
      for (int r = 0; r < 16; ++r) { const float g = GLR[t * 16 + r];
#pragma unroll
        for (int j = 0; j < 8; ++j) z[j] += g * W2[r * 64 + c8 * 8 + j]; }
#pragma unroll
      for (int j = 0; j < 8; ++j) { const float zz = z[j]; const float ls = fminf(zz, 0.f) - __logf(1.f + __expf(-fabsf(zz))); LA[t * 64 + c8 * 8 + j] = ls * (1.f / 16.f); }
    }
    __syncthreads();
    {
      const int d = tid & 63, seg = tid >> 6; float v[2][8];
#pragma unroll
      for (int s = 0; s < 2; ++s) { LAS unsigned char* L = F.lds + s * G0_STRIDE; const LAS float* LA = (const LAS float*)(L + GL_LA); float run = 0.f;
#pragma unroll
        for (int i = 0; i < 8; ++i) { run += LA[(seg * 8 + i) * 64 + d]; v[s][i] = run; }
        ((LAS float*)(L + GL_SEG))[seg * 64 + d] = run; }
      __syncthreads();
#pragma unroll
      for (int s = 0; s < 2; ++s) { LAS unsigned char* L = F.lds + s * G0_STRIDE; LAS float* LA = (LAS float*)(L + GL_LA); const LAS float* SEG = (const LAS float*)(L + GL_SEG); float off = 0.f;
#pragma unroll
        for (int q = 0; q < 8; ++q) off += (q < seg) ? SEG[q * 64 + d] : 0.f;
#pragma unroll
        for (int i = 0; i < 8; ++i) LA[(seg * 8 + i) * 64 + d] = v[s][i] + off; }
    }
    __syncthreads();
#pragma unroll
    for (int s = 0; s < 2; ++s) {
      const int unit = un[s]; LAS unsigned char* L = F.lds + s * G0_STRIDE; const LAS float* LA = (const LAS float*)(L + GL_LA);
      float bb[8];
#pragma unroll
      for (int j = 0; j < 8; ++j) bb[j] = LA[t * 64 + c8 * 8 + j];
      const unsigned qw[4] = {q8[s].x, q8[s].y, q8[s].z, q8[s].w}, kw[4] = {k8[s].x, k8[s].y, k8[s].z, k8[s].w};
      u32x4 qo, ko; unsigned kk16[8];
#pragma unroll
      for (int p = 0; p < 4; ++p) {
        const float e0 = __expf(bb[2 * p]), e1 = __expf(bb[2 * p + 1]);
        const unsigned qp = cvtpk(bflo(qw[p]) * e0, bfhi(qw[p]) * e1), kp = cvtpk(bflo(kw[p]) / e0, bfhi(kw[p]) / e1);
        qo[p] = qp; ko[p] = kp; kk16[2 * p] = kp & 0xffffu; kk16[2 * p + 1] = kp >> 16;
      }
      *(u32x4*)((bf16_t*)(F.ws + WS_GQ) + (size_t)unit * 4096 + t * 64 + c8 * 8) = qo;
      *(u32x4*)((bf16_t*)(F.ws + WS_GK) + (size_t)unit * 4096 + t * 64 + c8 * 8) = ko;
#pragma unroll
      for (int j = 0; j < 8; ++j) { const int d = c8 * 8 + j; *(LAS unsigned short*)(L + GL_KTT + d * 128 + (((t >> 3) ^ (d & 7)) << 4) + (t & 7) * 2) = (unsigned short)kk16[j]; }
    }
    __syncthreads();
#pragma unroll
    for (int s = 0; s < 2; ++s) {
      const int unit = un[s]; LAS unsigned char* L = F.lds + s * G0_STRIDE;
      const int dvt = w >> 1, dt = w & 1; f32x16 acc = {}; const int dcol = 32 * dt + r32;
#pragma unroll
      for (int ks = 0; ks < 4; ++ks) {
        const LAS unsigned char* vp = L + GL_V + (16 * ks + 8 * hi + (i16 >> 2)) * 256 + (32 * dvt + 16 * (g16 & 1) + 4 * (i16 & 3)) * 2;
        const bf16x8 a = cat8(vtr(vp), vtr(vp + 4 * 256));
        const bf16x8 bfr = *(const LAS bf16x8*)(L + GL_KTT + dcol * 128 + (((2 * ks + hi) ^ (dcol & 7)) << 4));
        acc = MFMA32(a, bfr, acc);
      }
      float* U = (float*)(F.ws + WS_GU) + (size_t)unit * 8192;
#pragma unroll
      for (int r = 0; r < 16; ++r) U[(32 * dvt + crow(r, hi)) * 64 + dcol] = acc[r];
      if (tid < 64) ((float*)(F.ws + WS_DL))[unit * 64 + tid] = __expf(((const LAS float*)(L + GL_LA))[63 * 64 + tid]);
    }
  } else {
    u32x4 gr0[2], gr1[2]; bf16x8 sf[2][4];
#pragma unroll
    for (int s = 0; s < 2; ++s) {
      const int unit = un[s], c = unit & 127, h = (unit >> 7) & 3, b = unit >> 9; const size_t m0 = (size_t)b * T + (size_t)c * 64;
      LAS unsigned char* L = F.lds + s * G1_STRIDE;
      const bf16_t* zrow = Z + (m0 + t) * ZP;
      const u32x4 qo = *(const u32x4*)((const bf16_t*)(F.ws + WS_GQ) + (size_t)unit * 4096 + t * 64 + c8 * 8);
      const u32x4 ko = *(const u32x4*)((const bf16_t*)(F.ws + WS_GK) + (size_t)unit * 4096 + t * 64 + c8 * 8);
      const u32x4 v0 = *(const u32x4*)(zrow + C_GV + h * 128 + c8 * 8), v1 = *(const u32x4*)(zrow + C_GV + h * 128 + 64 + c8 * 8);
      const int seg = tid & 7;
      gr0[s] = *(const u32x4*)(zrow + C_GR + h * 128 + seg * 16); gr1[s] = *(const u32x4*)(zrow + C_GR + h * 128 + seg * 16 + 8);
      const bf16_t* S = (const bf16_t*)(F.ws + WS_GS) + (size_t)unit * 8192;
#pragma unroll
      for (int kd = 0; kd < 4; ++kd) sf[s][kd] = *(const bf16x8*)(S + (32 * (w >> 1) + r32) * 64 + 16 * kd + 8 * hi);
      const int swz = (c8 ^ (t & 7)) << 4;
      *(LAS u32x4*)(L + G1_QT + t * 128 + swz) = qo; *(LAS u32x4*)(L + G1_KT + t * 128 + swz) = ko;
      *(LAS u32x4*)(L + G1_V + t * 256 + c8 * 16) = v0; *(LAS u32x4*)(L + G1_V + t * 256 + 128 + c8 * 16) = v1;
    }
    __syncthreads();
#pragma unroll
    for (int s = 0; s < 2; ++s) {
      const int unit = un[s], c = unit & 127; LAS unsigned char* L = F.lds + s * G1_STRIDE;
      const int dvt = w >> 1, tt = w & 1; f32x16 o = {}; const int tcol = 32 * tt + r32;
      for (int st = 0; st <= tt; ++st) {
        f32x16 x = {}; const int srow = 32 * st + r32;
#pragma unroll
        for (int kd = 0; kd < 4; ++kd) {
          const bf16x8 a = *(const LAS bf16x8*)(L + G1_KT + srow * 128 + (((2 * kd + hi) ^ (srow & 7)) << 4));
          const bf16x8 bfr = *(const LAS bf16x8*)(L + G1_QT + tcol * 128 + (((2 * kd + hi) ^ (tcol & 7)) << 4));
          x = MFMA32(a, bfr, x);
        }
        if (st == tt) {
#pragma unroll
          for (int r = 0; r < 16; ++r) if (crow(r, hi) > r32) x[r] = 0.f;
        }
#pragma unroll
        for (int ks2 = 0; ks2 < 2; ++ks2) {
          const LAS unsigned char* vp = L + G1_V + (32 * st + 16 * ks2 + 4 * hi + (i16 >> 2)) * 256 + (32 * dvt + 16 * (g16 & 1) + 4 * (i16 & 3)) * 2;
          const bf16x8 a = cat8(vtr(vp), vtr(vp + 8 * 256));
          o = MFMA32(a, pack8(x, ks2), o);
        }
      }
      if (c > 0) {
#pragma unroll
        for (int kd = 0; kd < 4; ++kd) {
          const bf16x8 bfr = *(const LAS bf16x8*)(L + G1_QT + tcol * 128 + (((2 * kd + hi) ^ (tcol & 7)) << 4));
          o = MFMA32(sf[s][kd], bfr, o);
        }
      }
      LAS float* OL = (LAS float*)(L + G1_O);
#pragma unroll
      for (int r = 0; r < 16; ++r) OL[tcol * 129 + 32 * dvt + crow(r, hi)] = o[r];
    }
    __syncthreads();
#pragma unroll
    for (int s = 0; s < 2; ++s) {
      const int unit = un[s], c = unit & 127, h = (unit >> 7) & 3, b = unit >> 9; const size_t m0 = (size_t)b * T + (size_t)c * 64;
      const LAS float* OL = (const LAS float*)(F.lds + s * G1_STRIDE + G1_O);
      const int seg = tid & 7; float v[16]; float ss = 0.f;
#pragma unroll
      for (int j = 0; j < 16; ++j) { v[j] = OL[t * 129 + seg * 16 + j]; ss += v[j] * v[j]; }
      ss += __shfl_xor(ss, 1); ss += __shfl_xor(ss, 2); ss += __shfl_xor(ss, 4);
      const float rs = rsqrtf(ss * (1.f / 128.f) + EPS);
      const unsigned gw_[8] = {gr0[s].x, gr0[s].y, gr0[s].z, gr0[s].w, gr1[s].x, gr1[s].y, gr1[s].z, gr1[s].w};
      const float* on = F.in[I_GON] + seg * 16;
      unsigned ow[8];
#pragma unroll
      for (int p = 0; p < 8; ++p) { const float ga = bflo(gw_[p]), gb = bfhi(gw_[p]);
        const float oa = v[2 * p] * rs * on[2 * p] * (ga * sigmoidf_(ga)), ob = v[2 * p + 1] * rs * on[2 * p + 1] * (gb * sigmoidf_(gb)); ow[p] = cvtpk(oa, ob); }
      bf16_t* dst = (bf16_t*)(F.ws + WS_OCAT) + (m0 + t) * DM + h * 128 + seg * 16;
      *(u32x4*)dst = (u32x4){ow[0], ow[1], ow[2], ow[3]}; *(u32x4*)(dst + 8) = (u32x4){ow[4], ow[5], ow[6], ow[7]};
    }
  }
}
template <int MODE>
DI void gla_phase(const Ctx& F0) {
  const Ctx F = fresh(F0);
  const int bx = blockIdx.x, G = F.G;
  const int nu = bx < 2048 ? (2048 - bx + G - 1) / G : 0;
#pragma unroll 1
  for (int i = 0; i < nu; i += 2) gla_pair<MODE>(F, bx + i * G, bx + (i + 1 < nu ? i + 1 : i) * G);
}
DI void gla_scan(const Ctx& F0) {
  const Ctx F = fresh(F0);
  const float* U = (const float*)(F.ws + WS_GU); const float* DL = (const float*)(F.ws + WS_DL); bf16_t* GS = (bf16_t*)(F.ws + WS_GS);
  for (int e = blockIdx.x * NTHREADS + F.tid; e < 16 * 8192; e += F.G * NTHREADS) {
    const int bh = e >> 13, rem = e & 8191, d = e & 63;
    float S = 0.f;
#pragma unroll 8
    for (int c = 0; c < 128; ++c) { const size_t unit = (size_t)bh * 128 + c;
      GS[unit * 8192 + rem] = (bf16_t)f2bf(S);
      S = DL[unit * 64 + d] * (S + U[unit * 8192 + rem]); }
  }
}

DI void nsa_compress_unit(const Ctx& F0, const int wt) {
  const Ctx F = fresh(F0);
  const int lane = F.lane, w = F.wave, r32 = lane & 31, hi = lane >> 5;
  const int kv = wt >> 7, nt = wt & 127, bg = nt >> 4, n0 = (nt & 15) * 32, b = bg >> 1, g = bg & 1;
  const bf16_t* Z = (const bf16_t*)(F.ws + WS_Z);
  const bf16_t* W1T = (const bf16_t*)(F.ws + WS_W1T) + (size_t)kv * 128 * 2048;
  const bf16_t* W2T = (const bf16_t*)(F.ws + WS_W2T) + (size_t)kv * 64 * 128;
  const float* C1 = (const float*)(F.ws + WS_C1) + kv * 128;
  const int col0 = (kv ? C_VC : C_KC) + g * 64;
  const int n = n0 + r32;
  LAS float* RED = (LAS float*)F.lds;
  __syncthreads();
  f32x16 acc[4] = {};
#pragma unroll
  for (int ll = 0; ll < 4; ++ll) {
    const int l = 4 * w + ll;
    int trow = 16 * n + l; trow = trow > T - 1 ? T - 1 : trow;
    const bf16_t* src = Z + ((size_t)b * T + trow) * ZP + col0 + 8 * hi;
#pragma unroll
    for (int q = 0; q < 4; ++q) {
      const int ks = 4 * l + q;
      const bf16x8 bfr = *(const bf16x8*)(src + 16 * q);
#pragma unroll
      for (int ht = 0; ht < 4; ++ht) { const bf16x8 a = *(const bf16x8*)(W1T + (size_t)(32 * ht + r32) * 2048 + 16 * ks + 8 * hi); acc[ht] = MFMA32(a, bfr, acc[ht]); }
    }
  }
#pragma unroll
  for (int ht = 0; ht < 4; ++ht)
#pragma unroll
    for (int r = 0; r < 16; ++r) RED[w * 4096 + (ht * 16 + r) * 64 + lane] = acc[ht][r];
  __syncthreads();
  if (w == 0) {
    bf16x8 pb[4][2];
#pragma unroll
    for (int ht = 0; ht < 4; ++ht) {
#pragma unroll
      for (int r = 0; r < 16; ++r) { float sm = 0.f;
#pragma unroll
        for (int ww = 0; ww < 8; ++ww) sm += RED[ww * 4096 + (ht * 16 + r) * 64 + lane];
        acc[ht][r] = gelu_tanh(sm + C1[32 * ht + crow(r, hi)]); }
      pb[ht][0] = pack8(acc[ht], 0); pb[ht][1] = pack8(acc[ht], 1);
    }
    bf16_t* OUT = (bf16_t*)(F.ws + (kv ? WS_VCMP : WS_KCMP)) + ((size_t)bg * 512 + n) * 64;
#pragma unroll
    for (int dt = 0; dt < 2; ++dt) {
      f32x16 o = {};
#pragma unroll
      for (int ht = 0; ht < 4; ++ht)
#pragma unroll
        for (int ks2 = 0; ks2 < 2; ++ks2) {
          const bf16_t* wp = W2T + (size_t)(32 * dt + r32) * 128 + 32 * ht + 16 * ks2 + 4 * hi;
          const u32x2 lo = *(const u32x2*)wp, hi2 = *(const u32x2*)(wp + 8);
          const u32x4 aw = {lo.x, lo.y, hi2.x, hi2.y};
          o = MFMA32(__builtin_bit_cast(bf16x8, aw), pb[ht][ks2], o);
        }
#pragma unroll
      for (int rr = 0; rr < 4; ++rr) { u32x2 wv; wv.x = cvtpk(o[4 * rr], o[4 * rr + 1]); wv.y = cvtpk(o[4 * rr + 2], o[4 * rr + 3]); *(u32x2*)(OUT + 32 * dt + 8 * rr + 4 * hi) = wv; }
    }
  }
  __syncthreads();
}

constexpr int NS_K = 0, NS_V = 32768, NS_IMP = 65536, NS_MASK = 99328, NS_BUCK = 100352, NS_BIAS = 108544, NS_THR = 109056, NS_WB = 109184;
constexpr int IMP_P = 132;
constexpr int NS_X3 = NS_IMP;
struct TileSrc { const bf16_t* k; const bf16_t* v; int pitch; };
DI void ns_load(u32x4& kr, u32x4& vr, const TileSrc& s, int row0, int tid) {
  const int key = tid >> 3, c8 = tid & 7;
  kr = *(const u32x4*)(s.k + (size_t)(row0 + key) * s.pitch + c8 * 8);
  vr = *(const u32x4*)(s.v + (size_t)(row0 + key) * s.pitch + c8 * 8);
}
DI void ns_store(LAS unsigned char* L, int buf, const u32x4& kr, const u32x4& vr, int tid) {
  const int key = tid >> 3, c8 = tid & 7;
  *(LAS u32x4*)(L + NS_K + buf * 8192 + key * 128 + ((c8 ^ ((key >> 1) & 7)) << 4)) = kr;
  *(LAS u32x4*)(L + NS_V + buf * 8192 + key * 128 + ((c8 * 16) ^ (((key >> 1) & 1) << 6))) = vr;
}
DI void ns_qk(f32x16& p0, f32x16& p1, const LAS unsigned char* Kb, const bf16x8 (&qf)[4], int r32, int hi) {
  p0 = (f32x16){}; p1 = (f32x16){};
#pragma unroll
  for (int ks = 0; ks < 4; ++ks) {
    const bf16x8 a0 = *(const LAS bf16x8*)(Kb + r32 * 128 + (((2 * ks + hi) ^ ((r32 >> 1) & 7)) << 4));
    const bf16x8 a1 = *(const LAS bf16x8*)(Kb + (32 + r32) * 128 + (((2 * ks + hi) ^ ((r32 >> 1) & 7)) << 4));
    p0 = MFMA32(a0, qf[ks], p0); p1 = MFMA32(a1, qf[ks], p1);
  }
}
DI void ns_pv(f32x16 (&o)[2], const LAS unsigned char* Vb, const f32x16& p0, const f32x16& p1, int lane) {
  const int hi = lane >> 5, i16 = lane & 15, g16 = lane >> 4;
#pragma unroll
  for (int ks = 0; ks < 4; ++ks) {
    const bf16x8 pb = pack8(ks < 2 ? p0 : p1, ks & 1);
#pragma unroll
    for (int dt = 0; dt < 2; ++dt) {
      const int vrow = 16 * ks + 4 * hi + (i16 >> 2);
      const LAS unsigned char* vp = Vb + vrow * 128 + (((32 * dt + 16 * (g16 & 1) + 4 * (i16 & 3)) * 2) ^ (((vrow >> 1) & 1) << 6));
      o[dt] = MFMA32(cat8(vtr(vp), vtr(vp + 8 * 128)), pb, o[dt]);
    }
  }
}
DI void ns_dma(LAS unsigned char* L, int kslot_off, int vslot_off, const TileSrc& s, int row0, int lane, int w) {
  const int row = 8 * w + (lane >> 3), pc = lane & 7;
  const bf16_t* kp = s.k + (size_t)(row0 + row) * s.pitch + ((pc ^ ((row >> 1) & 7)) << 3);
  const bf16_t* vp = s.v + (size_t)(row0 + row) * s.pitch + ((pc ^ (((row >> 1) & 1) << 2)) << 3);
  __builtin_amdgcn_global_load_lds((const unsigned*)kp, (LAS unsigned*)(L + kslot_off + w * 1024), 16, 0, 0);
  __builtin_amdgcn_global_load_lds((const unsigned*)vp, (LAS unsigned*)(L + vslot_off + w * 1024), 16, 0, 0);
}
DI float ns_bias(const LAS unsigned char* L, int hd, int dist) {
  const int dc = dist < 0 ? 0 : dist;
  const int bk = *(const LAS unsigned char*)(L + NS_BUCK + dc);
  return ((const LAS float*)(L + NS_BIAS))[bk * 4 + hd];
}
DI float ex2(float x) { return __builtin_amdgcn_exp2f(x); }

DI void nsa_unit(const Ctx& F0, const int bg, const int tile, int& tab_g) {
  const Ctx F = fresh(F0);
  const int tid = F.tid, lane = F.lane, w = F.wave, r32 = lane & 31, hi = lane >> 5;
  const int b = bg >> 1, g = bg & 1, t0 = tile * 64, cur = tile;
  LAS unsigned char* L = F.lds;
  const bf16_t* Z = (const bf16_t*)(F.ws + WS_Z);
  const int tokl = r32 >> 2, hd = r32 & 3, head = g * 4 + hd;
  const int t = t0 + 8 * w + tokl;
  const size_t mrow = (size_t)b * T + t;
  __syncthreads();
  if (tab_g != g) {
  for (int i = tid; i < 2048; i += NTHREADS) ((LAS unsigned*)(L + NS_BUCK))[i] = ((const unsigned*)(F.ws + WS_BUCK))[i];
  if (tid < 128) ((LAS float*)(L + NS_BIAS))[tid] = F.in[I_RELB][(tid >> 2) * 8 + g * 4 + (tid & 3)] * 1.4426950408889634f;
  if (tid < 32) { const int thr[32] = {0, 1, 2, 3, 4, 5, 6, 7, 8, 9, 10, 11, 12, 13, 14, 15, 16, 22, 30, 40, 54, 73, 99, 134, 182, 246, 332, 450, 609, 825, 1117, 1513};
    int v = 0;
#pragma unroll
    for (int k = 0; k < 32; ++k) v = (tid == k) ? thr[k] : v;
    ((LAS int*)(L + NS_THR))[tid] = v; }
  __syncthreads();
  for (int i = tid; i < 4 * 576; i += NTHREADS) { const int hh = i / 576, d = i - hh * 576; ((LAS float*)(L + NS_WB))[hh * 577 + d] = ((const LAS float*)(L + NS_BIAS))[(int)*(const LAS unsigned char*)(L + NS_BUCK + d) * 4 + hh]; }
  tab_g = g; }
  bf16x8 qf[4];
#pragma unroll
  for (int ks = 0; ks < 4; ++ks) qf[ks] = *(const bf16x8*)(Z + mrow * ZP + C_NQ + head * 64 + 16 * ks + 8 * hi);
  float gate[3];
#pragma unroll
  for (int i = 0; i < 3; ++i) gate[i] = sigmoidf_(bf2f(Z[mrow * ZP + C_NG + head * 3 + i]));
  f32x16 tot[2] = {};
  u32x4 kr, vr;

  const int nmax = (t0 + 32) >> 4;
  const int nct = (nmax >> 6) + 1;
  TileSrc sc; sc.k = (const bf16_t*)(F.ws + WS_KCMP) + (size_t)bg * 512 * 64; sc.v = (const bf16_t*)(F.ws + WS_VCMP) + (size_t)bg * 512 * 64; sc.pitch = 64;
  float m_c = -1e30f, l_c = 0.f;
  u32x4 kr2 = {}, vr2 = {};
  ns_load(kr, vr, sc, 0, tid); ns_store(L, 0, kr, vr, tid); ns_load(kr, vr, sc, nct > 1 ? 64 : 0, tid); __syncthreads();
  auto step1 = [&](const int ci, u32x4& kA, u32x4& vA, u32x4& kB, u32x4& vB) {
    ns_load(kB, vB, sc, 64 * (ci + 2 < nct ? ci + 2 : nct - 1), tid);
    f32x16 p0, p1; ns_qk(p0, p1, L + NS_K + (ci & 1) * 8192, qf, r32, hi);
    float mt = -1e30f, kb = 0.f;
    if (t0 + 8 * w - 31 - 16 * (64 * ci + 63) >= 1513) {
      const float b31 = ((const LAS float*)(L + NS_BIAS))[31 * 4 + hd];
      float ma = -1e30f, mb = -1e30f;
#pragma unroll
      for (int r = 0; r < 16; r += 2) { ma = fmaxf(fmaxf(ma, p0[r]), p1[r]); mb = fmaxf(fmaxf(mb, p0[r + 1]), p1[r + 1]); }
      kb = b31; mt = fmaxf(ma, mb) + b31;
    } else {
#pragma unroll
    for (int hf = 0; hf < 2; ++hf)
#pragma unroll
      for (int r = 0; r < 16; ++r) { const int n = 64 * ci + 32 * hf + crow(r, hi); const int dist = t - 16 * n - 31;
        float s = (hf ? p1[r] : p0[r]) + ns_bias(L, hd, dist); s = dist >= 0 ? s : -INFINITY; if (hf) p1[r] = s; else p0[r] = s; mt = fmaxf(mt, s); }
    }
    const float mn = fmaxf(m_c, mt); float sum = 0.f; const float kc = kb - mn;
#pragma unroll
    for (int r = 0; r < 16; ++r) sum += ex2(p0[r] + kc) + ex2(p1[r] + kc);
    l_c = l_c * ex2(m_c - mn) + sum; m_c = mn;
    ns_store(L, (ci + 1) & 1, kA, vA, tid);
    __syncthreads();
  };
  for (int ci = 0; ci < nct; ci += 2) { step1(ci, kr, vr, kr2, vr2); if (ci + 1 < nct) step1(ci + 1, kr2, vr2, kr, vr); }
  { const float mo = __shfl_xor(m_c, 32), lo = __shfl_xor(l_c, 32); const float mn = fmaxf(m_c, mo); l_c = l_c * ex2(m_c - mn) + lo * ex2(mo - mn); m_c = mn; }
  const float inv_lc = l_c > 0.f ? 1.f / l_c : 0.f;
  {
    f32x16 oc[2] = {};
    float carry = 0.f;
    LAS float* IMP = (LAS float*)(L + NS_IMP);
    ns_load(kr, vr, sc, 0, tid); ns_store(L, 0, kr, vr, tid); ns_load(kr, vr, sc, nct > 1 ? 64 : 0, tid); __syncthreads();
    auto step2 = [&](const int ci, u32x4& kA, u32x4& vA, u32x4& kB, u32x4& vB) {
      ns_load(kB, vB, sc, 64 * (ci + 2 < nct ? ci + 2 : nct - 1), tid);
      f32x16 p0, p1; ns_qk(p0, p1, L + NS_K + (ci & 1) * 8192, qf, r32, hi);
      if (t0 + 8 * w - 31 - 16 * (64 * ci + 63) >= 1513) {
        const float bm = ((const LAS float*)(L + NS_BIAS))[31 * 4 + hd] - m_c;
#pragma unroll
        for (int r = 0; r < 16; ++r) { p0[r] = ex2(p0[r] + bm) * inv_lc; p1[r] = ex2(p1[r] + bm) * inv_lc; }
      } else {
#pragma unroll
      for (int hf = 0; hf < 2; ++hf)
#pragma unroll
        for (int r = 0; r < 16; ++r) { const int n = 64 * ci + 32 * hf + crow(r, hi); const int dist = t - 16 * n - 31;
          const float s = (hf ? p1[r] : p0[r]) + ns_bias(L, hd, dist); const float p = dist >= 0 ? ex2(s - m_c) * inv_lc : 0.f; if (hf) p1[r] = p; else p0[r] = p; }
      }
      ns_pv(oc, L + NS_V + (ci & 1) * 8192, p0, p1, lane);
      float x[2][4];
#pragma unroll
      for (int rr = 0; rr < 4; ++rr) { x[0][rr] = __shfl_xor(p0[4 * rr + 3], 32); x[1][rr] = __shfl_xor(p1[4 * rr + 3], 32); }
#pragma unroll
      for (int hf = 0; hf < 2; ++hf)
#pragma unroll
        for (int rr = 0; rr < 4; ++rr) {
          const f32x16& pp = hf ? p1 : p0;
          float part = pp[4 * rr] + pp[4 * rr + 1] + pp[4 * rr + 2] + 0.5f * pp[4 * rr + 3];
          const float prev_lo = rr > 0 ? x[hf][rr > 0 ? rr - 1 : 0] : (hf ? x[0][3] : carry);
          const float cross = hi ? x[hf][rr] : prev_lo;
          part += 0.5f * cross;
          part += __shfl_xor(part, 1); part += __shfl_xor(part, 2);
          if (hd == 0) IMP[(8 * w + tokl) * IMP_P + 16 * ci + 8 * hf + 2 * rr + hi] = part;
        }
      carry = x[1][3];
      ns_store(L, (ci + 1) & 1, kA, vA, tid);
      __syncthreads();
    };
    for (int ci = 0; ci < nct; ci += 2) { step2(ci, kr, vr, kr2, vr2); if (ci + 1 < nct) step2(ci + 1, kr2, vr2, kr, vr); }
#pragma unroll
    for (int dt = 0; dt < 2; ++dt)
#pragma unroll
      for (int r = 0; r < 16; ++r) tot[dt][r] = gate[0] * oc[dt][r];
  }
  {
    const int tk = 8 * w + (lane >> 3), seg = lane & 7;
    unsigned m0 = 0, m1 = 0, m2 = 0, m3 = 0;
    auto setbit = [&](int j) { const unsigned bit = 1u << (j & 31); const int wd = j >> 5; m0 |= wd == 0 ? bit : 0u; m1 |= wd == 1 ? bit : 0u; m2 |= wd == 2 ? bit : 0u; m3 |= wd == 3 ? bit : 0u; };
    if (cur <= 15) { m0 = (2u << cur) - 1u; }
    else {
      const LAS float* IMP = (const LAS float*)(L + NS_IMP) + tk * IMP_P + 16 * seg;
      int top[16];
#pragma unroll
      for (int i = 0; i < 16; ++i) { const int j = 16 * seg + i; const int key = (int)((__float_as_uint(IMP[i]) & ~127u) | (unsigned)(127 - j)); top[i] = (j >= 1 && j <= cur - 2) ? key : -1; }
      sort16_desc(top);
#pragma unroll
      for (int o = 1; o < 8; o <<= 1) { int oth[16];
#pragma unroll
        for (int i = 0; i < 16; ++i) oth[i] = __shfl_xor(top[i], o);
        merge16_top(top, oth); }
      setbit(0); setbit(cur); setbit(cur - 1);
#pragma unroll
      for (int i = 0; i < 13; ++i) setbit(127 - (top[i] & 127));
    }
    if (seg == 0) *(LAS u32x4*)(L + NS_MASK + tk * 16) = (u32x4){m0, m1, m2, m3};
  }
  __syncthreads();
  const u32x4 mk = *(const LAS u32x4*)(L + NS_MASK + (8 * w + tokl) * 16);

  {
    TileSrc ss; ss.k = Z + (size_t)b * T * ZP + C_KS + g * 64; ss.v = Z + (size_t)b * T * ZP + C_VS + g * 64; ss.pitch = ZP;
    float m_s = -1e30f, l_s = 0.f; f32x16 os[2] = {};
    const int npair = (cur >> 1) + 1;
    auto selbit = [&](int j) -> bool { const unsigned wsel = (j >> 5) == 0 ? mk.x : ((j >> 5) == 1 ? mk.y : ((j >> 5) == 2 ? mk.z : mk.w)); return ((wsel >> (j & 31)) & 1u) != 0u; };
    auto bias_mask = [&](f32x16& p0, f32x16& p1, const int j, const bool sel, float& cb) -> float {
      float mt = -1e30f; cb = 0.f;
      const int dmin = t0 + 8 * w - (64 * j + 63), dmax = t0 + 8 * w + 7 - 64 * j;
      if (dmin >= 246) {
        const int blo = *(const LAS unsigned char*)(L + NS_BUCK + dmin), bhi = *(const LAS unsigned char*)(L + NS_BUCK + dmax);
        float b_lo = ((const LAS float*)(L + NS_BIAS))[blo * 4 + hd], b_hi = ((const LAS float*)(L + NS_BIAS))[bhi * 4 + hd];
        b_lo = sel ? b_lo : -INFINITY; b_hi = sel ? b_hi : -INFINITY;
        if (blo == bhi) {
          float ma = -1e30f, mb = -1e30f;
#pragma unroll
          for (int r = 0; r < 16; r += 2) { ma = fmaxf(fmaxf(ma, p0[r]), p1[r]); mb = fmaxf(fmaxf(mb, p0[r + 1]), p1[r + 1]); }
          cb = b_lo; mt = fmaxf(ma, mb) + b_lo;
        } else {
          const int thr = ((const LAS int*)(L + NS_THR))[bhi]; const int db = t - 64 * j - 4 * hi;
#pragma unroll
          for (int r = 0; r < 16; ++r) { const int d0 = db - ((r & 3) + 8 * (r >> 2));
            p0[r] += (d0 >= thr) ? b_hi : b_lo; p1[r] += (d0 - 32 >= thr) ? b_hi : b_lo; mt = fmaxf(mt, fmaxf(p0[r], p1[r])); }
        }
      } else {
#pragma unroll
        for (int hf = 0; hf < 2; ++hf)
#pragma unroll
          for (int r = 0; r < 16; ++r) { const int dist = t - (64 * j + 32 * hf + crow(r, hi));
            float sv = (hf ? p1[r] : p0[r]) + ns_bias(L, hd, dist); sv = (sel && dist >= 0) ? sv : -INFINITY; if (hf) p1[r] = sv; else p0[r] = sv; mt = fmaxf(mt, sv); }
      }
      return mt;
    };
    auto new_max = [&](float mt) {
      mt = fmaxf(mt, __shfl_xor(mt, 32));
      if (__any(mt > m_s)) {
        const float mn = fmaxf(m_s, mt), al = ex2(m_s - mn); l_s *= al; m_s = mn;
#pragma unroll
        for (int dt = 0; dt < 2; ++dt)
#pragma unroll
          for (int r = 0; r < 16; ++r) os[dt][r] *= al;
      }
    };
    auto expsum = [&](f32x16& p0, f32x16& p1, const float cb) { float sum = 0.f; const float kc = cb - m_s;
#pragma unroll
      for (int r = 0; r < 16; ++r) { p0[r] = ex2(p0[r] + kc); p1[r] = ex2(p1[r] + kc); sum += p0[r] + p1[r]; }
      l_s += sum; };
    auto kslot = [&](int pp, int idx) -> int { const int q = pp % 3; return (q == 2 ? NS_X3 : NS_K + q * 16384) + idx * 8192; };
    auto vslot = [&](int pp, int idx) -> int { const int q = pp % 3; return (q == 2 ? NS_X3 + 16384 : NS_V + q * 16384) + idx * 8192; };
    auto issue = [&](int pp) { const int ja = 2 * pp <= cur ? 2 * pp : cur, jb = 2 * pp + 1 <= cur ? 2 * pp + 1 : cur;
      ns_dma(L, kslot(pp, 0), vslot(pp, 0), ss, 64 * ja, lane, w); ns_dma(L, kslot(pp, 1), vslot(pp, 1), ss, 64 * jb, lane, w); };
    issue(0); issue(1);
    for (int pp = 0; pp < npair; ++pp) {
      const int ja = 2 * pp, jb = ja + 1;
      asm volatile("s_waitcnt vmcnt(4) ; NSA_SLC_WAIT" ::: "memory");
      __builtin_amdgcn_s_barrier();
      asm volatile("" ::: "memory");
      issue(pp + 2);
      const int ka = kslot(pp, 0), kb = kslot(pp, 1), va = vslot(pp, 0), vb = vslot(pp, 1);
      const bool sela = selbit(ja), selb = (jb <= cur) && selbit(jb);
      const bool needa = __any(sela), needb = __any(selb);
      if (needa && needb) {
        f32x16 pa0, pa1, pb0, pb1;
        ns_qk(pa0, pa1, L + ka, qf, r32, hi); ns_qk(pb0, pb1, L + kb, qf, r32, hi);
        float cba, cbb;
        const float mta = bias_mask(pa0, pa1, ja, sela, cba), mtb = bias_mask(pb0, pb1, jb, selb, cbb);
        new_max(fmaxf(mta, mtb));
        expsum(pa0, pa1, cba); ns_pv(os, L + va, pa0, pa1, lane);
        expsum(pb0, pb1, cbb); ns_pv(os, L + vb, pb0, pb1, lane);
      } else if (needa || needb) {
        const int j1 = needa ? ja : jb, k1 = needa ? ka : kb, v1 = needa ? va : vb; const bool sel1 = needa ? sela : selb;
        f32x16 p0, p1; ns_qk(p0, p1, L + k1, qf, r32, hi);
        float cb1;
        new_max(bias_mask(p0, p1, j1, sel1, cb1));
        expsum(p0, p1, cb1); ns_pv(os, L + v1, p0, p1, lane);
      }
      asm volatile("s_waitcnt lgkmcnt(0)" ::: "memory");
    }
    asm volatile("s_waitcnt vmcnt(0)" ::: "memory");
    __syncthreads();
    l_s += __shfl_xor(l_s, 32);
    const float sc_ = gate[1] / l_s;
#pragma unroll
    for (int dt = 0; dt < 2; ++dt)
#pragma unroll
      for (int r = 0; r < 16; ++r) tot[dt][r] += EN_SLC * sc_ * os[dt][r];
  }
  {
    TileSrc sw; sw.k = Z + (size_t)b * T * ZP + C_KW + g * 64; sw.v = Z + (size_t)b * T * ZP + C_VW + g * 64; sw.pitch = ZP;
    const int j0 = cur >= 8 ? cur - 8 : 0;
    float m_w = -1e30f, l_w = 0.f; f32x16 ow[2] = {};
    ns_load(kr, vr, sw, 64 * j0, tid); ns_store(L, 0, kr, vr, tid); ns_load(kr, vr, sw, 64 * (j0 < cur ? j0 + 1 : j0), tid); __syncthreads();
    auto step = [&](const int j, u32x4& kA, u32x4& vA, u32x4& kB, u32x4& vB) {
      const int bi = (j - j0) & 1;
      ns_load(kB, vB, sw, 64 * (j + 2 <= cur ? j + 2 : cur), tid);
      f32x16 p0, p1; ns_qk(p0, p1, L + NS_K + bi * 8192, qf, r32, hi);
      float mt = -1e30f;
      { const LAS float* WB = (const LAS float*)(L + NS_WB) + hd * 577; const int db = t - 64 * j - 4 * hi;
#pragma unroll
        for (int r = 0; r < 16; ++r) { const unsigned d0 = (unsigned)(db - ((r & 3) + 8 * (r >> 2))), d1 = d0 - 32u;
          const float s0 = p0[r] + WB[d0 < 575u ? d0 : 575u], s1 = p1[r] + WB[d1 < 575u ? d1 : 575u];
          p0[r] = d0 < 512u ? s0 : -INFINITY; p1[r] = d1 < 512u ? s1 : -INFINITY; mt = fmaxf(mt, fmaxf(p0[r], p1[r])); } }
      mt = fmaxf(mt, __shfl_xor(mt, 32));
      if (__any(mt > m_w)) {
        const float mn = fmaxf(m_w, mt), al = ex2(m_w - mn); l_w *= al; m_w = mn;
#pragma unroll
        for (int dt = 0; dt < 2; ++dt)
#pragma unroll
          for (int r = 0; r < 16; ++r) ow[dt][r] *= al;
      }
      { float sum = 0.f;
#pragma unroll
        for (int r = 0; r < 16; ++r) { p0[r] = ex2(p0[r] - m_w); p1[r] = ex2(p1[r] - m_w); sum += p0[r] + p1[r]; }
        l_w += sum; }
      ns_pv(ow, L + NS_V + bi * 8192, p0, p1, lane);
      ns_store(L, bi ^ 1, kA, vA, tid);
      __syncthreads();
    };
    for (int j = j0; j <= cur; j += 2) { step(j, kr, vr, kr2, vr2); if (j + 1 <= cur) step(j + 1, kr2, vr2, kr, vr); }
    l_w += __shfl_xor(l_w, 32);
    const float sc_ = gate[2] / l_w;
#pragma unroll
    for (int dt = 0; dt < 2; ++dt)
#pragma unroll
      for (int r = 0; r < 16; ++r) tot[dt][r] += EN_WIN * sc_ * ow[dt][r];
  }
  bf16_t* dst = (bf16_t*)(F.ws + WS_OCAT) + mrow * DM + 512 + head * 64;
#pragma unroll
  for (int dt = 0; dt < 2; ++dt)
#pragma unroll
    for (int rr = 0; rr < 4; ++rr) { u32x2 wv; wv.x = cvtpk(tot[dt][4 * rr], tot[dt][4 * rr + 1]); wv.y = cvtpk(tot[dt][4 * rr + 2], tot[dt][4 * rr + 3]); *(u32x2*)(dst + 32 * dt + 8 * rr + 4 * hi) = wv; }
}

DI int ordkey(float f) { const int s = __builtin_bit_cast(int, f); return s ^ ((s >> 31) & 0x7fffffff); }
DI float unordkey(int k) { const int s = k ^ ((k >> 31) & 0x7fffffff); return __builtin_bit_cast(float, s); }
DI void ins16(int (&top)[16], int v) {
#pragma unroll
  for (int i = 0; i < 16; ++i) { const int h = max(top[i], v); v = min(top[i], v); top[i] = h; }
}
DI void merge_pair(int (&a)[16]) {
  int c[16];
#pragma unroll
  for (int i = 0; i < 16; ++i) c[i] = max(a[i], __shfl_xor(a[15 - i], 32));
#pragma unroll
  for (int st = 8; st >= 1; st >>= 1)
#pragma unroll
    for (int i = 0; i < 16; ++i) if ((i & st) == 0) { const int x = c[i], y = c[i + st]; c[i] = max(x, y); c[i + st] = min(x, y); }
#pragma unroll
  for (int i = 0; i < 16; ++i) a[i] = c[i];
}
DI void peer_key_tile(int (&g)[16], const bf16_t* SKhp, const bf16x8 (&qf)[4], int kt, int r32, int hi) {
  f32x16 acc = {};
#pragma unroll
  for (int ks = 0; ks < 4; ++ks) { const bf16x8 a = *(const bf16x8*)(SKhp + (size_t)(32 * kt + r32) * 64 + 16 * ks + 8 * hi); acc = MFMA32(a, qf[ks], acc); }
#pragma unroll
  for (int r = 0; r < 16; ++r) { const int kidx = 32 * kt + crow(r, hi); g[r] = (ordkey(acc[r]) & ~127) | (127 - kidx); }
  sort16_desc(g);
}
DI void peer_half_topk(int (&lst)[16], const bf16_t* SKhp, const bf16_t* qrow, int r32, int hi) {
  bf16x8 qf[4];
#pragma unroll
  for (int ks = 0; ks < 4; ++ks) qf[ks] = *(const bf16x8*)(qrow + 16 * ks + 8 * hi);
  int g1[16];
  peer_key_tile(lst, SKhp, qf, 0, r32, hi); peer_key_tile(g1, SKhp, qf, 1, r32, hi); merge16_top(lst, g1);
  { int g2[16]; peer_key_tile(g1, SKhp, qf, 2, r32, hi); peer_key_tile(g2, SKhp, qf, 3, r32, hi); merge16_top(g1, g2); }
  merge16_top(lst, g1);
  merge_pair(lst);
}
constexpr int PS_IDX = 0;
DI void peer_select_unit(const Ctx& F0, const int u) {
  const Ctx F = fresh(F0);
  const int lane = F.lane, w = F.wave, r32 = lane & 31, hi = lane >> 5;
  const int tok = (u >> 1) * 256 + 32 * w + r32, hg = u & 1;
  const bf16_t* QP = (const bf16_t*)(F.ws + WS_QP) + (size_t)tok * DM;
  const bf16_t* SK = (const bf16_t*)(F.ws + WS_SK);
  LAS unsigned char* IDX = F.lds + PS_IDX + F.tid * 32;
  unsigned short* EI = (unsigned short*)(F.ws + WS_EIDX) + (size_t)tok * 128; float* GT = (float*)(F.ws + WS_GATE) + (size_t)tok * 128;
  __syncthreads();
  for (int pair = 0; pair < 2; ++pair) {
    const int hA = 4 * hg + 2 * pair;
    int l00[16], l01[16], l10[16], l11[16];
    peer_half_topk(l00, SK + (size_t)((hA * 2 + 0) * 128) * 64, QP + hA * 128, r32, hi);
    peer_half_topk(l01, SK + (size_t)((hA * 2 + 1) * 128) * 64, QP + hA * 128 + 64, r32, hi);
    peer_half_topk(l10, SK + (size_t)(((hA + 1) * 2 + 0) * 128) * 64, QP + (hA + 1) * 128, r32, hi);
    peer_half_topk(l11, SK + (size_t)(((hA + 1) * 2 + 1) * 128) * 64, QP + (hA + 1) * 128 + 64, r32, hi);
    const int hsel = hA + hi;
    float fa[16], fb[16];
#pragma unroll
    for (int i = 0; i < 16; ++i) { const int ka = hi ? l10[i] : l00[i], kb = hi ? l11[i] : l01[i];
      fa[i] = unordkey(ka & ~127); fb[i] = unordkey(kb & ~127); IDX[i] = (unsigned char)(127 - (ka & 127)); IDX[16 + i] = (unsigned char)(127 - (kb & 127)); }
    auto cand = [&](int i, int j) -> int { return (ordkey(fa[i] + fb[j]) & ~255) | (255 - (i * 16 + j)); };
    const int NEG = (int)0x80000000;
    int top[16], c1[16];
#pragma unroll
    for (int j = 0; j < 16; ++j) top[j] = cand(0, j);
    { int k = 0;
#pragma unroll
      for (int j = 0; j < 8; ++j) c1[k++] = cand(1, j);
#pragma unroll
      for (int j = 0; j < 5; ++j) c1[k++] = cand(2, j);
      c1[13] = NEG; c1[14] = NEG; c1[15] = NEG; }
    sort16_desc(c1); merge16_top(top, c1);
    c1[0] = cand(3, 0); c1[1] = cand(3, 1); c1[2] = cand(3, 2); c1[3] = cand(3, 3); c1[4] = cand(4, 0); c1[5] = cand(4, 1); c1[6] = cand(4, 2);
    c1[7] = cand(5, 0); c1[8] = cand(5, 1); c1[9] = cand(6, 0); c1[10] = cand(6, 1); c1[11] = cand(7, 0); c1[12] = cand(7, 1); c1[13] = NEG; c1[14] = NEG; c1[15] = NEG;
    sort16_desc(c1); merge16_top(top, c1);
#pragma unroll
    for (int i = 0; i < 8; ++i) { c1[i] = cand(8 + i, 0); c1[8 + i] = NEG; }
    merge16_top(top, c1);
    float sc[16]; float mx = -INFINITY;
#pragma unroll
    for (int k = 0; k < 16; ++k) { sc[k] = unordkey(top[k] & ~255); mx = fmaxf(mx, sc[k]); }
    float sum = 0.f;
#pragma unroll
    for (int k = 0; k < 16; ++k) { sc[k] = __expf(sc[k] - mx); sum += sc[k]; }
    const float inv = 1.f / sum;
    asm volatile("s_waitcnt lgkmcnt(0)" ::: "memory");
#pragma unroll
    for (int k = 0; k < 16; ++k) { const int cid = 255 - (top[k] & 255); const int e = (int)IDX[cid >> 4] * 128 + (int)IDX[16 + (cid & 15)];
      EI[hsel * 16 + k] = (unsigned short)e; GT[hsel * 16 + k] = sc[k] * inv; }
  }
}

DI void fp8x16_to_f32(const u32x4& w, float (&f)[16]) {
#pragma unroll
  for (int q = 0; q < 4; ++q) { const f32x2 lo = __builtin_amdgcn_cvt_pk_f32_fp8((int)w[q], false), hi = __builtin_amdgcn_cvt_pk_f32_fp8((int)w[q], true); f[4 * q] = lo.x; f[4 * q + 1] = lo.y; f[4 * q + 2] = hi.x; f[4 * q + 3] = hi.y; }
}
DI void treduce16(const float (&v)[16], int sel, int s, float (&w2)[2]) {
  float w8[8], w4[4];
  { const bool up = (sel & 4) != 0;
#pragma unroll
    for (int i = 0; i < 8; ++i) { const float keep = up ? v[i + 8] : v[i], send = up ? v[i] : v[i + 8]; w8[i] = keep + __shfl_xor(send, 4 * s); } }
  { const bool up = (sel & 2) != 0;
#pragma unroll
    for (int i = 0; i < 4; ++i) { const float keep = up ? w8[i + 4] : w8[i], send = up ? w8[i] : w8[i + 4]; w4[i] = keep + __shfl_xor(send, 2 * s); } }
  { const bool up = (sel & 1) != 0;
#pragma unroll
    for (int i = 0; i < 2; ++i) { const float keep = up ? w4[i + 2] : w4[i], send = up ? w4[i] : w4[i + 2]; w2[i] = keep + __shfl_xor(send, s); } }
}
struct PeerIds { unsigned ep[8]; };
struct PeerRows { u32x4 d[16]; unsigned ap[8]; u32x4 xa, xb; unsigned h; };
DI void peer_load_ids(const Ctx& F, int tok, int g, PeerIds& I) {
  const unsigned short* EI = (const unsigned short*)(F.ws + WS_EIDX) + (size_t)tok * 128 + 16 * g;
  const u32x4 a = *(const u32x4*)EI, b = *(const u32x4*)(EI + 8); I.ep[0] = a.x; I.ep[1] = a.y; I.ep[2] = a.z; I.ep[3] = a.w; I.ep[4] = b.x; I.ep[5] = b.y; I.ep[6] = b.z; I.ep[7] = b.w;
}
DI unsigned peer_eid(const PeerIds& I, int i) { return (i & 1) ? (I.ep[i >> 1] >> 16) : (I.ep[i >> 1] & 0xffffu); }
DI float peer_act(const PeerRows& R, int i) { return (i & 1) ? bfhi(R.ap[i >> 1]) : bflo(R.ap[i >> 1]); }
template <int PASS> DI void peer_load_rows(const Ctx& F, const unsigned char* TB, unsigned lo, int slice, int tok, int g, int c, const PeerIds& I, PeerRows& R) {
#pragma unroll
  for (int i = 0; i < 16; ++i) R.d[i] = *(const u32x4*)(TB + ((peer_eid(I, i) << 7) | lo));
  if (PASS == 0) { const bf16_t* xn = (const bf16_t*)(F.ws + WS_HN) + (size_t)tok * DM + 128 * slice + 16 * c; R.xa = *(const u32x4*)xn; R.xb = *(const u32x4*)(xn + 8); }
  else { const bf16_t* AC = (const bf16_t*)(F.ws + WS_ACTH) + (size_t)tok * 128 + 16 * g;
    const u32x4 a = *(const u32x4*)AC, b = *(const u32x4*)(AC + 8); R.ap[0] = a.x; R.ap[1] = a.y; R.ap[2] = a.z; R.ap[3] = a.w; R.ap[4] = b.x; R.ap[5] = b.y; R.ap[6] = b.z; R.ap[7] = b.w;
    R.h = *(const unsigned*)((const bf16_t*)(F.ws + WS_HN) + (size_t)tok * DM + 128 * slice + 16 * c + 2 * g); }
}
template <int PASS> DI void peer_compute(const Ctx& F, int slice, int tok, int g, int c, const PeerRows& R) {
  float acc[16]; float w2[2];
  if (PASS == 0) {
    float x[16];
    { const unsigned xw[8] = {R.xa.x, R.xa.y, R.xa.z, R.xa.w, R.xb.x, R.xb.y, R.xb.z, R.xb.w};
#pragma unroll
      for (int q = 0; q < 8; ++q) { x[2 * q] = bflo(xw[q]); x[2 * q + 1] = bfhi(xw[q]); } }
    float dep = 0.f;
#pragma unroll
    for (int i = 0; i < 16; ++i) { u32x4 w = R.d[i]; asm volatile("" : "+v"(w.x), "+v"(w.y), "+v"(w.z), "+v"(w.w) : "v"(dep));
      float f[16]; fp8x16_to_f32(w, f); float a = 0.f, b = 0.f;
#pragma unroll
      for (int j = 0; j < 8; ++j) { a += f[2 * j] * x[2 * j]; b += f[2 * j + 1] * x[2 * j + 1]; }
      acc[i] = a + b; dep = acc[i]; }
    treduce16(acc, c, 1, w2);
    *(f32x2*)((float*)(F.ws + WS_PART) + ((size_t)slice * NTOK + tok) * 128 + 16 * g + 2 * c) = (f32x2){w2[0], w2[1]};
  } else {
#pragma unroll
    for (int j = 0; j < 16; ++j) acc[j] = 0.f;
#pragma unroll
    for (int i = 0; i < 16; ++i) { u32x4 w = R.d[i]; asm volatile("" : "+v"(w.x), "+v"(w.y), "+v"(w.z), "+v"(w.w) : "v"(acc[15]));
      float f[16]; fp8x16_to_f32(w, f);
      const float ai = peer_act(R, i);
#pragma unroll
      for (int j = 0; j < 16; ++j) acc[j] += ai * f[j]; }
    treduce16(acc, g, 8, w2);
    *(unsigned*)((bf16_t*)(F.ws + WS_HN) + (size_t)tok * DM + 128 * slice + 16 * c + 2 * g) = cvtpk(bflo(R.h) + w2[0], bfhi(R.h) + w2[1]);
  }
}
constexpr int PEER_NBIG = (NTOK * 3 / 4) / 32, PEER_NSMALL = (NTOK / 4) / 8;
template <int PASS>
DI void peer_sliced_pass(const Ctx& F0, unsigned* cnt) {
  const Ctx F = fresh(F0);
  const int lane = F.lane, g = lane >> 3, c = lane & 7;
  const unsigned xcc = (unsigned)__builtin_amdgcn_s_getreg((3 << 11) | 20) & 7u;
  for (int s = 0; s < 8; ++s) {
    const int slice = (int)((xcc + (unsigned)s) & 7u);
    const unsigned char* TB = F.ws + (PASS == 0 ? WS_PDOWN8 : WS_PUP8) + (size_t)slice * 16384 * 128; const unsigned lo = (unsigned)(16 * c);
    for (;;) {
      unsigned ch = 0;
      if (lane == 0) ch = atomicAdd(cnt + 64 * slice, 1u);
      const int chunk = __builtin_amdgcn_readfirstlane((int)ch);
      if (chunk >= PEER_NBIG + PEER_NSMALL) break;
      const int tok0 = chunk < PEER_NBIG ? chunk * 32 : PEER_NBIG * 32 + (chunk - PEER_NBIG) * 8;
      const int nch = chunk < PEER_NBIG ? 32 : 8;
      PeerIds E0, E1; PeerRows RA, RB;
      peer_load_ids(F, tok0, g, E0);
      peer_load_ids(F, tok0 + 1, g, E1);
      peer_load_rows<PASS>(F, TB, lo, slice, tok0, g, c, E0, RA);
#pragma unroll 1
      for (int i = 0; i < nch; i += 2) {
        const int t0 = tok0 + i, t1 = t0 + 1, t2 = (i + 2 < nch) ? t0 + 2 : t0, t3 = (i + 3 < nch) ? t0 + 3 : t1;
        peer_load_rows<PASS>(F, TB, lo, slice, t1, g, c, E1, RB);
        peer_load_ids(F, t2, g, E0);
        peer_compute<PASS>(F, slice, t0, g, c, RA);
        peer_load_rows<PASS>(F, TB, lo, slice, t2, g, c, E0, RA);
        peer_load_ids(F, t3, g, E1);
        peer_compute<PASS>(F, slice, t1, g, c, RB);
      }
    }
  }
}
DI void peer_computeA_lds(LAS float* part_row, int g, int c, const PeerRows& R) {
  float acc[16]; float w2[2]; float x[16];
  { const unsigned xw[8] = {R.xa.x, R.xa.y, R.xa.z, R.xa.w, R.xb.x, R.xb.y, R.xb.z, R.xb.w};
#pragma unroll
    for (int q = 0; q < 8; ++q) { x[2 * q] = bflo(xw[q]); x[2 * q + 1] = bfhi(xw[q]); } }
  float dep = 0.f;
#pragma unroll
  for (int i = 0; i < 16; ++i) { u32x4 w = R.d[i]; asm volatile("" : "+v"(w.x), "+v"(w.y), "+v"(w.z), "+v"(w.w) : "v"(dep));
    float f[16]; fp8x16_to_f32(w, f); float a = 0.f, b = 0.f;
#pragma unroll
    for (int j = 0; j < 8; ++j) { a += f[2 * j] * x[2 * j]; b += f[2 * j + 1] * x[2 * j + 1]; }
    acc[i] = a + b; dep = acc[i]; }
  treduce16(acc, c, 1, w2);
  LAS f32x2* pp = (LAS f32x2*)(part_row + 16 * g + 2 * c);
  const f32x2 o = *pp; *pp = (f32x2){o.x + w2[0], o.y + w2[1]};
}
DI void peer_load_rowsC_lds(const Ctx& F, const unsigned char* TB, unsigned lo, int slice, int tok, const LAS unsigned* act_row, int g, int c, const PeerIds& I, PeerRows& R) {
#pragma unroll
  for (int i = 0; i < 16; ++i) R.d[i] = *(const u32x4*)(TB + ((peer_eid(I, i) << 7) | lo));
#pragma unroll
  for (int k = 0; k < 8; ++k) R.ap[k] = act_row[8 * g + k];
  R.h = *(const unsigned*)((const bf16_t*)(F.ws + WS_HN) + (size_t)tok * DM + 128 * slice + 16 * c + 2 * g);
}
DI void final_norm_token(const Ctx& F, const int tok);
DI int peer_grab(LAS unsigned* cnt, int lane) { unsigned v = 0; if (lane == 0) v = __hip_atomic_fetch_add(cnt, 2u, __ATOMIC_RELAXED, __HIP_MEMORY_SCOPE_WORKGROUP); return __builtin_amdgcn_readfirstlane((int)v); }
constexpr int PEER_NS = 8 * 128, PEER_CNT = LDSCTL_OFF + 512, PEER_PROG = LDSCTL_OFF + 1024, PEER_ACTS = 65536;
DI unsigned peer_xcc() { return (unsigned)__builtin_amdgcn_s_getreg((3 << 11) | 20) & 7u; }
DI void peer_passA(const Ctx& F0, const int tb0) {
  const Ctx F = fresh(F0);
  const int lane = F.lane, g = lane >> 3, c = lane & 7;
  const unsigned xcc = peer_xcc(), lo = (unsigned)(16 * c);
  LAS float* PARTS = (LAS float*)F.lds; LAS unsigned* CNT = (LAS unsigned*)(F.lds + PEER_CNT); volatile LAS unsigned* PROG = (volatile LAS unsigned*)(F.lds + PEER_PROG);
  auto slc = [&](int q) -> int { return (int)((xcc + (unsigned)(q >> 7)) & 7u); };
  auto tbl = [&](int q) -> const unsigned char* { return F.ws + WS_PDOWN8 + (size_t)slc(q) * 16384 * 128; };
  auto compute = [&](int q, const PeerRows& R) { const int tb = q & 127, sidx = q >> 7;
    if (sidx > 0) { while (PROG[tb] < (unsigned)sidx) __builtin_amdgcn_s_sleep(1); }
    asm volatile("" ::: "memory");
    peer_computeA_lds(PARTS + tb * 128, g, c, R);
    asm volatile("s_waitcnt lgkmcnt(0)" ::: "memory");
    if (lane == 0) PROG[tb] = (unsigned)(sidx + 1); };
  PeerIds E0, E1; PeerRows RA, RB;
  int qa = peer_grab(CNT, lane);
  { const int a_ = qa < PEER_NS ? qa : PEER_NS - 2;
    peer_load_ids(F, tb0 + (a_ & 127), g, E0); peer_load_ids(F, tb0 + ((a_ + 1) & 127), g, E1);
    peer_load_rows<0>(F, tbl(a_), lo, slc(a_), tb0 + (a_ & 127), g, c, E0, RA); }
#pragma unroll 1
  while (qa < PEER_NS) {
    peer_load_rows<0>(F, tbl(qa + 1), lo, slc(qa + 1), tb0 + ((qa + 1) & 127), g, c, E1, RB);
    const int qn = peer_grab(CNT, lane), n_ = qn < PEER_NS ? qn : PEER_NS - 2;
    peer_load_ids(F, tb0 + (n_ & 127), g, E0);
    compute(qa, RA);
    peer_load_rows<0>(F, tbl(n_), lo, slc(n_), tb0 + (n_ & 127), g, c, E0, RA);
    peer_load_ids(F, tb0 + ((n_ + 1) & 127), g, E1);
    compute(qa + 1, RB);
    qa = qn;
  }
}
DI void peer_acts(const Ctx& F0, const int tb0) {
  const Ctx F = fresh(F0);
  const int lane = F.lane, g = lane >> 3, c = lane & 7, w = F.wave;
  const LAS float* PARTS = (const LAS float*)F.lds; LAS unsigned* ACTS = (LAS unsigned*)(F.lds + PEER_ACTS);
  const float* DSC = (const float*)(F.ws + WS_DSC); const float* USC = (const float*)(F.ws + WS_USC);
#pragma unroll 1
  for (int ti = 0; ti < 16; ++ti) { const int tb = 16 * w + ti, tok = tb0 + tb; const int p0 = 16 * g + 2 * c;
    const unsigned ee = *(const unsigned*)((const unsigned short*)(F.ws + WS_EIDX) + (size_t)tok * 128 + p0); const unsigned e0 = ee & 0xffffu, e1 = ee >> 16;
    const f32x2 gt = *(const f32x2*)((const float*)(F.ws + WS_GATE) + (size_t)tok * 128 + p0);
    const f32x2 sd = *(const LAS f32x2*)(PARTS + tb * 128 + p0);
    const float rs = pg8::row_rstd((const float*)(F.ws + WS_SSP), tok);
    ACTS[tb * 64 + 8 * g + c] = cvtpk(gelu_tanh(sd.x * rs * DSC[e0]) * gt.x * USC[e0], gelu_tanh(sd.y * rs * DSC[e1]) * gt.y * USC[e1]); }
}
DI void peer_passC(const Ctx& F0, const int tb0) {
  const Ctx F = fresh(F0);
  const int lane = F.lane, g = lane >> 3, c = lane & 7;
  const unsigned xcc = peer_xcc(), lo = (unsigned)(16 * c);
  const LAS unsigned* ACTS = (const LAS unsigned*)(F.lds + PEER_ACTS); LAS unsigned* CNT = (LAS unsigned*)(F.lds + PEER_CNT) + 1;
  auto slc = [&](int q) -> int { return (int)((xcc + (unsigned)(q >> 7)) & 7u); };
  auto tbl = [&](int q) -> const unsigned char* { return F.ws + WS_PUP8 + (size_t)slc(q) * 16384 * 128; };
  PeerIds E0, E1; PeerRows RA, RB;
  int qa = peer_grab(CNT, lane);
  { const int a_ = qa < PEER_NS ? qa : PEER_NS - 2;
    peer_load_ids(F, tb0 + (a_ & 127), g, E0); peer_load_ids(F, tb0 + ((a_ + 1) & 127), g, E1);
    peer_load_rowsC_lds(F, tbl(a_), lo, slc(a_), tb0 + (a_ & 127), ACTS + (a_ & 127) * 64, g, c, E0, RA); }
#pragma unroll 1
  while (qa < PEER_NS) {
    peer_load_rowsC_lds(F, tbl(qa + 1), lo, slc(qa + 1), tb0 + ((qa + 1) & 127), ACTS + ((qa + 1) & 127) * 64, g, c, E1, RB);
    const int qn = peer_grab(CNT, lane), n_ = qn < PEER_NS ? qn : PEER_NS - 2;
    peer_load_ids(F, tb0 + (n_ & 127), g, E0);
    peer_compute<1>(F, slc(qa), tb0 + (qa & 127), g, c, RA);
    peer_load_rowsC_lds(F, tbl(n_), lo, slc(n_), tb0 + (n_ & 127), ACTS + (n_ & 127) * 64, g, c, E0, RA);
    peer_load_ids(F, tb0 + ((n_ + 1) & 127), g, E1);
    peer_compute<1>(F, slc(qa + 1), tb0 + ((qa + 1) & 127), g, c, RB);
    qa = qn;
  }
}
DI void peer_fused_phase(const Ctx& F0) {
#pragma unroll 1
  for (int tb0 = (int)blockIdx.x * 128; tb0 < NTOK; tb0 += (int)gridDim.x * 128) {
    { const Ctx F = fresh(F0); const int tid = F.tid;
      __syncthreads();
      float z0 = 0.f; asm volatile("" : "+v"(z0));
#pragma unroll
      for (int i = 0; i < 8; ++i) *(LAS f32x4*)((LAS float*)F.lds + 4 * (i * NTHREADS + tid)) = (f32x4){z0, z0, z0, z0};
      if (tid < 128) ((volatile LAS unsigned*)(F.lds + PEER_PROG))[tid] = 0u;
      if (tid < 2) ((LAS unsigned*)(F.lds + PEER_CNT))[tid] = 0u;
      __syncthreads(); }
    peer_passA(F0, tb0);
    __syncthreads();
    peer_acts(F0, tb0);
    __syncthreads();
    peer_passC(F0, tb0);
    asm volatile("s_waitcnt vmcnt(0)" ::: "memory");
    __syncthreads();
    __builtin_amdgcn_fence(__ATOMIC_ACQUIRE, "agent");
    { const Ctx F = fresh(F0);
#pragma unroll 1
      for (int ti = 0; ti < 16; ++ti) final_norm_token(F, tb0 + 16 * F.wave + ti); }
  }
}
DI void peer_act_pass(const Ctx& F0) {
  const Ctx F = fresh(F0);
  const float* PT = (const float*)(F.ws + WS_PART); const u32x2* EI = (const u32x2*)(F.ws + WS_EIDX); const f32x4* GT = (const f32x4*)(F.ws + WS_GATE);
  const float* DSC = (const float*)(F.ws + WS_DSC); const float* USC = (const float*)(F.ws + WS_USC); u32x2* AH = (u32x2*)(F.ws + WS_ACTH);
  for (size_t i = (size_t)blockIdx.x * NTHREADS + F.tid; i < (size_t)NTOK * 32; i += (size_t)F.G * NTHREADS) {
    f32x4 s = {0.f, 0.f, 0.f, 0.f};
#pragma unroll
    for (int x = 0; x < 8; ++x) s += *(const f32x4*)(PT + (size_t)x * NTOK * 128 + 4 * i);
    const u32x2 ee = EI[i]; const unsigned e0 = ee.x & 0xffffu, e1 = ee.x >> 16, e2 = ee.y & 0xffffu, e3 = ee.y >> 16; const f32x4 gt = GT[i];
    const float rs = pg8::row_rstd((const float*)(F.ws + WS_SSP), (int)(i >> 5));
    u32x2 o; o.x = cvtpk(gelu_tanh(s.x * rs * DSC[e0]) * gt.x * USC[e0], gelu_tanh(s.y * rs * DSC[e1]) * gt.y * USC[e1]);
    o.y = cvtpk(gelu_tanh(s.z * rs * DSC[e2]) * gt.z * USC[e2], gelu_tanh(s.w * rs * DSC[e3]) * gt.w * USC[e3]);
    AH[i] = o;
  }
}
DI void renorm_pass(const Ctx& F0, const float* g) {
  const Ctx F = fresh(F0);
#pragma unroll 1
  for (int m = F.gw; m < NTOK; m += F.NGW) rms_row_bf16(F.H + (size_t)m * DM, g, (bf16_t*)(F.ws + WS_HN) + (size_t)m * DM, F.lane);
}
DI void final_norm_token(const Ctx& F, const int tok) {
  const int lane = F.lane; const bf16_t* hrow = (const bf16_t*)(F.ws + WS_HN) + (size_t)tok * DM; float* orow = F.H + (size_t)tok * DM; const float* gf = F.in[I_NFIN];
  f32x4 v[4]; float ss = 0.f;
#pragma unroll
  for (int j = 0; j < 4; ++j) { const u32x2 hb = ((const u32x2*)hrow)[lane + 64 * j]; v[j] = (f32x4){bflo(hb.x), bfhi(hb.x), bflo(hb.y), bfhi(hb.y)}; ss += v[j].x * v[j].x + v[j].y * v[j].y + v[j].z * v[j].z + v[j].w * v[j].w; }
  const float r = rsqrtf(wave_sum(ss) * (1.f / DM) + EPS);
#pragma unroll
  for (int j = 0; j < 4; ++j) ((f32x4*)orow)[lane + 64 * j] = v[j] * r * ((const f32x4*)gf)[lane + 64 * j];
}

#define XB_TMO      128
#define XB_XCNT(j)  (256  + 64 * (j))
#define XB_XSUB(j)  (1280 + 64 * (j))
#define XB_XGEN(j)  (2304 + 64 * (j))
#define XB_TOP      3328
#define XB_TOPGEN   3392
#define XCD_BAR_WORDS 3456
#define XB_SPIN_CAP (1u << 22)
DI unsigned xb_ld(unsigned* p)              { return __hip_atomic_load(p, __ATOMIC_RELAXED, __HIP_MEMORY_SCOPE_AGENT); }
DI unsigned xb_add(unsigned* p, unsigned v) { return __hip_atomic_fetch_add(p, v, __ATOMIC_RELAXED, __HIP_MEMORY_SCOPE_AGENT); }
DI unsigned xb_xcc_id() { return (unsigned)__builtin_amdgcn_s_getreg((3 << 11) | 20) & 0xFu; }
#define XB_SPIN(cond, bar) do { unsigned _sp = 0; while (cond) { __builtin_amdgcn_s_sleep(1); \
    if ((++_sp & 255u) == 0u) { if (xb_ld(&(bar)[XB_TMO])) break; if (_sp > XB_SPIN_CAP) { atomicAdd(&(bar)[XB_TMO], 1u); break; } } } } while (0)
struct XcdBarrier { unsigned* bar; unsigned x; volatile LAS unsigned* st; };
DI XcdBarrier xcd_barrier_post(unsigned* bar, volatile LAS unsigned* st) {
  XcdBarrier b; b.bar = bar; b.x = xb_xcc_id(); b.st = st;
  if (threadIdx.x == 0) (void)xb_add(&bar[XB_XCNT(b.x)], 1u);
  return b;
}
DI void xcd_barrier_complete(unsigned* bar, unsigned x, unsigned& nloc, unsigned& nx) {
  const unsigned G = gridDim.x * gridDim.y * gridDim.z;
  unsigned sum, cnt, mine, sp = 0u;
  for (;;) {
    sum = 0u; cnt = 0u; mine = 0u;
#pragma unroll
    for (unsigned j = 0; j < 16; ++j) { const unsigned c = xb_ld(&bar[XB_XCNT(j)]); sum += c; cnt += (c > 0u) ? 1u : 0u; mine = (j == x) ? c : mine; }
    if (sum == G) break;
    __builtin_amdgcn_s_sleep(1);
    if ((++sp & 255u) == 0u) { if (xb_ld(&bar[XB_TMO])) break; if (sp > XB_SPIN_CAP) { atomicAdd(&bar[XB_TMO], 1u); break; } }
  }
  nloc = mine > 0u ? mine : 1u; nx = cnt > 0u ? cnt : 1u;
}
DI void xcd_barrier(const XcdBarrier& b) {
  asm volatile("s_waitcnt vmcnt(0)" ::: "memory");
  __syncthreads();
  if (threadIdx.x == 0) {
    unsigned* bar = b.bar;
    __builtin_amdgcn_s_waitcnt(0);
    unsigned nloc = b.st[0], nx = b.st[1];
    if (nloc == 0u) { xcd_barrier_complete(bar, b.x, nloc, nx); b.st[0] = nloc; b.st[1] = nx; }
    const unsigned old = xb_add(&bar[XB_XSUB(b.x)], 1u);
    const unsigned gen = old / nloc;
    if (old + 1u == (gen + 1u) * nloc) {
      __builtin_amdgcn_fence(__ATOMIC_RELEASE, "agent");
      asm volatile("s_waitcnt vmcnt(0)" ::: "memory");
      const unsigned og = xb_add(&bar[XB_TOP], 1u);
      const unsigned tg = og / nx;
      if (og + 1u == (tg + 1u) * nx) xb_add(&bar[XB_TOPGEN], 1u);
      else XB_SPIN(xb_ld(&bar[XB_TOPGEN]) == tg, bar);
      __builtin_amdgcn_fence(__ATOMIC_ACQUIRE, "agent");
      xb_add(&bar[XB_XGEN(b.x)], 1u);
      asm volatile("s_waitcnt vmcnt(0)" ::: "memory");
    } else {
      XB_SPIN(xb_ld(&bar[XB_XGEN(b.x)]) == gen, bar);
      __builtin_amdgcn_fence(__ATOMIC_ACQUIRE, "agent");
      asm volatile("s_waitcnt vmcnt(0)" ::: "memory");
    }
  }
  __syncthreads();
}
constexpr int CW_BAR = 4096, CW_QA = 16384, CW_QC = 16384 + 1024, CW_QN = 16384 + 2048;

__global__ void __launch_bounds__(NTHREADS, 2) mega(Params p) {
  extern __shared__ __attribute__((aligned(16))) unsigned char lds_raw[];
  cg::grid_group grid = cg::this_grid();
  Ctx F;
  F.lds = (LAS unsigned char*)lds_raw;
  F.tid = threadIdx.x; F.lane = F.tid & 63; F.wave = __builtin_amdgcn_readfirstlane(F.tid >> 6);
  F.G = gridDim.x; F.gw = blockIdx.x * NWAVES + F.wave; F.NGW = F.G * NWAVES;
  F.in = p.in; F.H = p.out; F.ws = p.ws;
  unsigned char* ws = p.ws;
  const int bx = blockIdx.x;
  if (F.tid < 8) ((LAS unsigned*)(F.lds + LDSCTL_OFF))[F.tid] = 0u;
  __syncthreads();
  const XcdBarrier bar = xcd_barrier_post((unsigned*)(ws + WS_CTL) + CW_BAR, (volatile LAS unsigned*)(F.lds + LDSCTL_OFF));
#define GRID_BAR() xcd_barrier(bar)

  prologue(F);
  if (p.pad0 == 0x5eed) grid.sync();
  GRID_BAR();
  {
    pg8::PlainOrder S; S.init(ws + WS_HN, ws + WS_WIN, NTOK, ZP, DM, DM, F.G, bx);
    pg8::EpiBf16 E{(bf16_t*)(ws + WS_Z), ZP, 0};
    pg8::gemm_phase(F.lds, DM, DM, DM, S, E);
  }
  GRID_BAR();
  gla_phase<0>(F);
#if EN_NSA
  for (int cu = (bx + 128) % F.G; cu < 256; cu += F.G) nsa_compress_unit(F, cu);
#endif
  GRID_BAR();
  gla_scan(F);
#if EN_XATTN
  {
    pg8::MemProjOrder S{(const char*)(ws + WS_MEMN), (const char*)(ws + WS_XWK), (const char*)(ws + WS_XWV), F.G, (bx + 192) % F.G};
    pg8::EpiBf16 E{(bf16_t*)(ws + WS_KX), DM, 0};
    pg8::gemm_phase(F.lds, DM, DM, DM, S, E);
  }
#endif
#if EN_NSA
  {
    unsigned* qn = (unsigned*)(ws + WS_CTL) + CW_QN;
    volatile LAS int* slot = (volatile LAS int*)(F.lds + LDSCTL_OFF + 16);
    const unsigned xcc = xb_xcc_id() & 7u;
    int tab_g = -1;
    for (int s8 = 0; s8 < 8; ++s8) {
      const int bg = (int)((xcc + (unsigned)s8) & 7u);
      for (;;) {
        __syncthreads();
        if (F.tid == 0) *slot = (int)atomicAdd(qn + 64 * bg, 1u);
        __syncthreads();
        const int u = *slot;
        if (u >= 128) break;
        nsa_unit(F, bg, 127 - u, tab_g);
      }
    }
  }
#else
  for (int m = F.gw; m < NTOK; m += F.NGW) { u32x4* o = (u32x4*)((bf16_t*)(ws + WS_OCAT) + (size_t)m * DM + 512) + F.lane; *o = (u32x4){0, 0, 0, 0}; }
#endif
  GRID_BAR();
#if EN_XATTN
  {
    pg8::FoldOrder S{(const char*)(ws + WS_KX), (const char*)(ws + WS_XWQ), (const char*)(ws + WS_XWO), (const char*)(ws + WS_VXT), F.G, bx};
    pg8::EpiBf16 E{(bf16_t*)(ws + WS_MT), DM, 0};
    pg8::gemm_phase(F.lds, 256, DM, DM, S, E);
  }
#endif
  gla_phase<1>(F);
  GRID_BAR();
  {
    pg8::PlainOrder S; S.init(ws + WS_OCAT, ws + WS_WOUT, NTOK, DM, DM, DM, F.G, bx);
    pg8::EpiRes E{p.in[I_X], (bf16_t*)(ws + WS_HN), (float*)(ws + WS_SSP)};
    pg8::gemm_phase(F.lds, DM, DM, DM, S, E);
  }
  GRID_BAR();
#if EN_XATTN
  {
    pg8::XaBatchOrder S{(const char*)(ws + WS_HN), (const char*)(ws + WS_MT), F.G, bx};
    pg8::EpiSoftmax E{(bf16_t*)(ws + WS_XP), (const float*)(ws + WS_SSP), (LAS float*)(F.lds + 131072)};
    pg8::gemm_phase(F.lds, DM, DM, DM, S, E);
  }
  GRID_BAR();
  {
    pg8::XaBatchOrder S{(const char*)(ws + WS_XP), (const char*)(ws + WS_VWT), F.G, bx};
    pg8::EpiRes E{nullptr, (bf16_t*)(ws + WS_HN), (float*)(ws + WS_SSP)};
    pg8::gemm_phase(F.lds, DM, DM, DM, S, E);
  }
  GRID_BAR();
#endif
#if EN_PEER
  {
    pg8::PlainOrder S; S.init(ws + WS_HN, ws + WS_PWQ, NTOK, DM, DM, DM, F.G, bx);
    pg8::EpiBf16RS E{(bf16_t*)(ws + WS_QP), (const float*)(ws + WS_SSP)};
    pg8::gemm_phase(F.lds, DM, DM, DM, S, E);
  }
  GRID_BAR();
  for (int u = bx; u < 256; u += F.G) peer_select_unit(F, u);
  GRID_BAR();
  peer_fused_phase(F);
#else
  { const Ctx Ff = fresh(F);
#pragma unroll 1
    for (int m = Ff.gw; m < NTOK; m += Ff.NGW) final_norm_token(Ff, m); }
#endif
}

extern "C" void kernel_launch(void* const* d_in, const int* in_sizes, int n_in, void* d_out, int out_size, void* d_ws, size_t ws_size, hipStream_t stream) {
  static int grid_blocks = 0;
  if (!grid_blocks) {
    int dev = 0, cus = 0, per_cu = 0;
    (void)hipGetDevice(&dev);
    (void)hipDeviceGetAttribute(&cus, hipDeviceAttributeMultiprocessorCount, dev);
    (void)hipFuncSetAttribute((const void*)mega, hipFuncAttributeMaxDynamicSharedMemorySize, LDS_BYTES);
    (void)hipOccupancyMaxActiveBlocksPerMultiprocessor(&per_cu, (const void*)mega, NTHREADS, LDS_BYTES);
    if (per_cu < 1) { fprintf(stderr, "kernel_launch: occupancy query says %d blocks per CU\n", per_cu); per_cu = 1; }
    grid_blocks = cus;
    if (n_in != 27 || ws_size < WS_END) { fprintf(stderr, "kernel_launch: n_in %d ws %zu (need %zu)\n", n_in, ws_size, (size_t)WS_END); }
    fprintf(stderr, "kernel_launch: grid %d x %d, per_cu %d, ws %zu MiB\n", grid_blocks, NTHREADS, per_cu, ws_size >> 20);
  }
  (void)hipMemsetAsync((char*)d_ws + WS_CTL, 0, 1 * MiB, stream);
  Params p{};
  for (int i = 0; i < 27 && i < n_in; ++i) p.in[i] = (const float*)d_in[i];
  p.out = (float*)d_out; p.ws = (unsigned char*)d_ws;
  void* args[] = {&p};
  hipError_t e = hipLaunchCooperativeKernel((void*)mega, dim3(grid_blocks), dim3(NTHREADS), args, LDS_BYTES, stream);
  if (e != hipSuccess) fprintf(stderr, "cooperative launch failed: %s (grid %d)\n", hipGetErrorString(e), grid_blocks);
}
```
